# Optimizing an MI355X kernel written in HIP

```python
import math
import jax
import jax.numpy as jnp
from jax import lax
import numpy as np

D_MODEL = 1024
BATCH = 4
SEQ = 8192
DEPTH = 2

GRID_W = 64
CTX_LEN = 256
HEAD_DIM = 64
NA_HEADS = 6
NA_WIN_H = 8
NA_WIN_W = 16
DIFF_HEADS = 4
DIFF_QK_DIM = 32
DIFF_V_DIM = 2 * DIFF_QK_DIM
GQA_Q_HEADS = 6
GQA_KV_HEADS = 2
GQA_GROUP = GQA_Q_HEADS // GQA_KV_HEADS
N_GROUPS = 4
EXPERTS_PER_GROUP = 4
N_EXPERTS = N_GROUPS * EXPERTS_PER_GROUP
TOP_K_IN_GROUP = 2
EXPERT_HIDDEN = 512
Q_BLOCK = 128
ROPE_THETA = 10000.0
EPS = 1e-6
W_A = NA_HEADS * HEAD_DIM
W_B = DIFF_HEADS * DIFF_V_DIM
W_C = GQA_Q_HEADS * HEAD_DIM
MIX_WIDTH = W_A + W_B + W_C
PROJ_SIZES = (W_A, W_A, W_A, 2 * DIFF_HEADS * DIFF_QK_DIM, 2 * DIFF_HEADS * DIFF_QK_DIM, W_B, W_C, GQA_KV_HEADS * HEAD_DIM, GQA_KV_HEADS * HEAD_DIM)
IN_WIDTH = sum(PROJ_SIZES)

kernel_name = 'hybrid_na_diff_gqa_hmoe_block'


def rms_norm(x, g):
    xf = x.astype(jnp.float32)
    y = xf * lax.rsqrt(jnp.mean(xf * xf, axis=-1, keepdims=True) + EPS)
    return (y * g.astype(jnp.float32)).astype(x.dtype)


def split_proj(p):
    outs, start = [], 0
    for w in PROJ_SIZES:
        outs.append(p[..., start:start + w])
        start += w
    return outs


def split_heads(t, n):
    b, s, w = t.shape
    return t.reshape(b, s, n, w // n).transpose(0, 2, 1, 3)


def merge_heads(t):
    b, h, s, d = t.shape
    return t.transpose(0, 2, 1, 3).reshape(b, s, h * d)


def diff_split(t):
    b, s, _ = t.shape
    t = t.reshape(b, s, DIFF_HEADS, 2, DIFF_QK_DIM).transpose(3, 0, 2, 1, 4)
    return t[0], t[1]


def axial_rope(n_tokens, dim):
    t = jnp.arange(n_tokens)
    row = (t // GRID_W).astype(jnp.float32)
    col = (t % GRID_W).astype(jnp.float32)
    quarter = dim // 4
    freqs = ROPE_THETA ** (-jnp.arange(quarter, dtype=jnp.float32) / quarter)
    ang = jnp.concatenate([row[:, None] * freqs, col[:, None] * freqs], axis=-1)
    return jnp.cos(ang), jnp.sin(ang)


def apply_rope(x, cos, sin):
    half = x.shape[-1] // 2
    xf = x.astype(jnp.float32)
    x1, x2 = xf[..., :half], xf[..., half:]
    return jnp.concatenate([x1 * cos - x2 * sin, x2 * cos + x1 * sin], axis=-1).astype(x.dtype)


def to_blocks(t):
    *lead, s, d = t.shape
    return jnp.moveaxis(t.reshape(*lead, s // Q_BLOCK, Q_BLOCK, d), -3, 0)


def from_blocks(t):
    t = jnp.moveaxis(t, 0, -3)
    *lead, nb, q, d = t.shape
    return t.reshape(*lead, nb * q, d)


def softmax_attend(q, k, v):
    logits = jnp.einsum('bhqd,bhkd->bhqk', q, k).astype(jnp.float32) * (q.shape[-1] ** -0.5)
    p = jax.nn.softmax(logits, axis=-1)
    return jnp.einsum('bhqk,bhkd->bhqd', p.astype(v.dtype), v)


def diff_attend(q1, q2, k1, k2, v, lam):
    scale = DIFF_QK_DIM ** -0.5
    p1 = jax.nn.softmax(jnp.einsum('bhqd,bhkd->bhqk', q1, k1).astype(jnp.float32) * scale, axis=-1)
    p2 = jax.nn.softmax(jnp.einsum('bhqd,bhkd->bhqk', q2, k2).astype(jnp.float32) * scale, axis=-1)
    a = p1 - lam * p2
    return jnp.einsum('bhqk,bhkd->bhqd', a.astype(v.dtype), v)


def gqa_attend(q, k, v):
    logits = jnp.einsum('bgrqd,bgkd->bgrqk', q, k).astype(jnp.float32) * (HEAD_DIM ** -0.5)
    p = jax.nn.softmax(logits, axis=-1)
    return jnp.einsum('bgrqk,bgkd->bgrqd', p.astype(v.dtype), v)


def neighbourhood_attention(q, k, v, k_ctx, v_ctx, rpb):
    b, h, s, d = q.shape
    rows = s // GRID_W
    kh = min(NA_WIN_H, rows)
    kw = NA_WIN_W
    qg = q.reshape(b, h, rows, GRID_W, d)
    kg = k.reshape(b, h, rows, GRID_W, d)
    vg = v.reshape(b, h, rows, GRID_W, d)
    cols = jnp.arange(GRID_W)
    col_idx = jnp.clip(cols - kw // 2, 0, GRID_W - kw)[:, None] + jnp.arange(kw)[None, :]
    dc = col_idx - cols[:, None] + (NA_WIN_W - 1)
    scale = d ** -0.5
    rpb32 = rpb.astype(jnp.float32)

    def row_block(r):
        r0 = jnp.clip(r - kh // 2, 0, rows - kh)
        k_rows = lax.dynamic_slice_in_dim(kg, r0, kh, axis=2)
        v_rows = lax.dynamic_slice_in_dim(vg, r0, kh, axis=2)
        k_win = k_rows[:, :, :, col_idx, :]
        v_win = v_rows[:, :, :, col_idx, :]
        q_r = lax.dynamic_index_in_dim(qg, r, axis=2, keepdims=False)
        dr = r0 + jnp.arange(kh) - r + (NA_WIN_H - 1)
        bias = rpb32[:, dr[:, None, None], dc[None, :, :]].transpose(0, 2, 1, 3)
        s_win = jnp.einsum('bhcd,bhicjd->bhcij', q_r, k_win).astype(jnp.float32) * scale + bias[None]
        s_ctx = jnp.einsum('bhcd,bhld->bhcl', q_r, k_ctx).astype(jnp.float32) * scale
        logits = jnp.concatenate([s_win.reshape(b, h, GRID_W, kh * kw), s_ctx], axis=-1)
        p = jax.nn.softmax(logits, axis=-1).astype(v.dtype)
        p_win = p[..., :kh * kw].reshape(b, h, GRID_W, kh, kw)
        return (jnp.einsum('bhcij,bhicjd->bhcd', p_win, v_win)
                + jnp.einsum('bhcl,bhld->bhcd', p[..., kh * kw:], v_ctx))

    out = lax.map(row_block, jnp.arange(rows))
    return out.transpose(1, 2, 0, 3, 4).reshape(b, h, s, d)


def token_mixers(h, hc, w_in, na_rpb, lq1, lk1, lq2, lk2, diff_subln, q_norm, k_norm, lam_init, ctx_out):
    b, s, _ = h.shape
    n_ctx = hc.shape[1]
    qa, ka, va, qb, kb, vb, qc, kc, vc = split_proj(h @ w_in)
    qa_c, ka_c, va_c, qb_c, kb_c, vb_c, qc_c, kc_c, vc_c = split_proj(hc @ w_in)
    cos_b, sin_b = axial_rope(s, DIFF_QK_DIM)
    cos_c, sin_c = axial_rope(s, HEAD_DIM)

    ka_ctx, va_ctx = split_heads(ka_c, NA_HEADS), split_heads(va_c, NA_HEADS)
    out_a = neighbourhood_attention(split_heads(qa, NA_HEADS), split_heads(ka, NA_HEADS),
                                    split_heads(va, NA_HEADS), ka_ctx, va_ctx, na_rpb)

    lam = (jnp.exp(jnp.sum(lq1.astype(jnp.float32) * lk1.astype(jnp.float32)))
           - jnp.exp(jnp.sum(lq2.astype(jnp.float32) * lk2.astype(jnp.float32))) + lam_init)
    q1, q2 = diff_split(qb)
    k1, k2 = diff_split(kb)
    k1c, k2c = diff_split(kb_c)
    vb_lat, vb_ctx = split_heads(vb, DIFF_HEADS), split_heads(vb_c, DIFF_HEADS)
    q1, q2, k1, k2 = [apply_rope(t, cos_b, sin_b) for t in (q1, q2, k1, k2)]
    k1_all = jnp.concatenate([k1c, k1], axis=2)
    k2_all = jnp.concatenate([k2c, k2], axis=2)
    vb_all = jnp.concatenate([vb_ctx, vb_lat], axis=2)
    out_b = from_blocks(lax.map(lambda qq: diff_attend(qq[0], qq[1], k1_all, k2_all, vb_all, lam),
                                (to_blocks(q1), to_blocks(q2))))
    out_b = rms_norm(out_b, diff_subln) * (1.0 - lam_init)

    q = apply_rope(rms_norm(split_heads(qc, GQA_Q_HEADS), q_norm), cos_c, sin_c)
    k = apply_rope(rms_norm(split_heads(kc, GQA_KV_HEADS), k_norm), cos_c, sin_c)
    kc_ctx = rms_norm(split_heads(kc_c, GQA_KV_HEADS), k_norm)
    vc_ctx = split_heads(vc_c, GQA_KV_HEADS)
    kc_all = jnp.concatenate([kc_ctx, k], axis=2)
    vc_all = jnp.concatenate([vc_ctx, split_heads(vc, GQA_KV_HEADS)], axis=2)
    qg = q.reshape(b, GQA_KV_HEADS, GQA_GROUP, s, HEAD_DIM)
    out_c = from_blocks(lax.map(lambda qq: gqa_attend(qq, kc_all, vc_all), to_blocks(qg)))
    out_c = out_c.reshape(b, GQA_Q_HEADS, s, HEAD_DIM)

    mixed = jnp.concatenate([merge_heads(out_a), merge_heads(out_b), merge_heads(out_c)], axis=-1)
    if not ctx_out:
        return mixed, None

    oa_c = softmax_attend(split_heads(qa_c, NA_HEADS), ka_ctx, va_ctx)
    q1c, q2c = diff_split(qb_c)
    ob_c = rms_norm(diff_attend(q1c, q2c, k1c, k2c, vb_ctx, lam), diff_subln) * (1.0 - lam_init)
    qg_c = rms_norm(split_heads(qc_c, GQA_Q_HEADS), q_norm).reshape(b, GQA_KV_HEADS, GQA_GROUP, n_ctx, HEAD_DIM)
    oc_c = gqa_attend(qg_c, kc_ctx, vc_ctx).reshape(b, GQA_Q_HEADS, n_ctx, HEAD_DIM)
    mixed_c = jnp.concatenate([merge_heads(oa_c), merge_heads(ob_c), merge_heads(oc_c)], axis=-1)
    return mixed, mixed_c


def hier_moe(h, wr_g, br_g, wr_e, br_e, w_gate, w_up, w_down):
    n = h.shape[0]
    g_logits = (h @ wr_g).astype(jnp.float32) + br_g.astype(jnp.float32)
    g_sel = jnp.argmax(g_logits, axis=-1)
    p_grp = jnp.take_along_axis(jax.nn.softmax(g_logits, axis=-1), g_sel[:, None], axis=-1)
    e_logits = ((h @ wr_e).astype(jnp.float32) + br_e.astype(jnp.float32)).reshape(n, N_GROUPS, EXPERTS_PER_GROUP)
    e_in = jnp.take_along_axis(e_logits, g_sel[:, None, None], axis=1)[:, 0]
    top_val, top_idx = lax.top_k(e_in, TOP_K_IN_GROUP)
    w_top = jax.nn.softmax(top_val, axis=-1) * p_grp
    expert_id = g_sel[:, None] * EXPERTS_PER_GROUP + top_idx
    combine = jnp.sum(jax.nn.one_hot(expert_id, N_EXPERTS, dtype=jnp.float32) * w_top[..., None], axis=1)
    y = jnp.zeros_like(h)
    for e in range(N_EXPERTS):
        hid = jax.nn.silu(h @ w_gate[e]) * (h @ w_up[e])
        y = y + (hid @ w_down[e]) * combine[:, e:e + 1].astype(h.dtype)
    return y


def setup_inputs(seed: int = 0) -> dict:
    key = jax.random.key(seed)
    ks = jax.random.split(key, 26)
    f32 = jnp.float32
    D = D_MODEL

    def nrm(k, shape, s):
        return jax.random.normal(k, shape, f32) * s

    return {
        'x': nrm(ks[0], (BATCH, SEQ, D), 1.0),
        'c': nrm(ks[1], (BATCH, D), 1.0),
        'ctx': nrm(ks[2], (BATCH, CTX_LEN, D), 1.0),
        'c_ctx': nrm(ks[3], (D,), 1.0),
        'w_mod': nrm(ks[4], (DEPTH, D, 6 * D), 0.5 * D ** -0.5),
        'b_mod': nrm(ks[5], (DEPTH, 6 * D), 0.02),
        'norm_attn': 1.0 + nrm(ks[6], (DEPTH, D), 0.05),
        'norm_ffn': 1.0 + nrm(ks[7], (DEPTH, D), 0.05),
        'w_in': nrm(ks[8], (DEPTH, D, IN_WIDTH), D ** -0.5),
        'w_out': nrm(ks[9], (DEPTH, MIX_WIDTH, D), MIX_WIDTH ** -0.5),
        'na_rpb': nrm(ks[10], (DEPTH, NA_HEADS, 2 * NA_WIN_H - 1, 2 * NA_WIN_W - 1), 0.02),
        'diff_lambda_q1': nrm(ks[11], (DEPTH, DIFF_QK_DIM), 0.1),
        'diff_lambda_k1': nrm(ks[12], (DEPTH, DIFF_QK_DIM), 0.1),
        'diff_lambda_q2': nrm(ks[13], (DEPTH, DIFF_QK_DIM), 0.1),
        'diff_lambda_k2': nrm(ks[14], (DEPTH, DIFF_QK_DIM), 0.1),
        'diff_subln': 1.0 + nrm(ks[15], (DEPTH, DIFF_V_DIM), 0.05),
        'gqa_q_norm': 1.0 + nrm(ks[16], (DEPTH, HEAD_DIM), 0.05),
        'gqa_k_norm': 1.0 + nrm(ks[17], (DEPTH, HEAD_DIM), 0.05),
        'router_group_w': nrm(ks[18], (DEPTH, D, N_GROUPS), D ** -0.5),
        'router_group_b': nrm(ks[19], (DEPTH, N_GROUPS), 0.01),
        'router_expert_w': nrm(ks[20], (DEPTH, D, N_EXPERTS), D ** -0.5),
        'router_expert_b': nrm(ks[21], (DEPTH, N_EXPERTS), 0.01),
        'w_gate': nrm(ks[22], (DEPTH, N_EXPERTS, D, EXPERT_HIDDEN), D ** -0.5),
        'w_up': nrm(ks[23], (DEPTH, N_EXPERTS, D, EXPERT_HIDDEN), D ** -0.5),
        'w_down': nrm(ks[24], (DEPTH, N_EXPERTS, EXPERT_HIDDEN, D), EXPERT_HIDDEN ** -0.5),
        'final_norm': 1.0 + nrm(ks[25], (D,), 0.05),
    }


def reference(x, c, ctx, c_ctx, w_mod, b_mod, norm_attn, norm_ffn, w_in, w_out, na_rpb,
              diff_lambda_q1, diff_lambda_k1, diff_lambda_q2, diff_lambda_k2, diff_subln,
              gqa_q_norm, gqa_k_norm, router_group_w, router_group_b, router_expert_w,
              router_expert_b, w_gate, w_up, w_down, final_norm):
    b, s, d = x.shape
    n_ctx = ctx.shape[1]
    xc = ctx
    for l in range(DEPTH):
        ctx_out = l < DEPTH - 1
        lam_init = 0.8 - 0.6 * math.exp(-0.3 * l)
        mod = jax.nn.silu(c) @ w_mod[l] + b_mod[l]
        mod_c = jax.nn.silu(c_ctx) @ w_mod[l] + b_mod[l]
        sh1, sc1, g1, sh2, sc2, g2 = jnp.split(mod[:, None, :], 6, axis=-1)
        csh1, csc1, cg1, csh2, csc2, cg2 = jnp.split(mod_c, 6, axis=-1)
        h = rms_norm(x, norm_attn[l]) * (1.0 + sc1) + sh1
        hc = rms_norm(xc, norm_attn[l]) * (1.0 + csc1) + csh1
        mixed, mixed_c = token_mixers(h, hc, w_in[l], na_rpb[l], diff_lambda_q1[l], diff_lambda_k1[l],
                                      diff_lambda_q2[l], diff_lambda_k2[l], diff_subln[l],
                                      gqa_q_norm[l], gqa_k_norm[l], lam_init, ctx_out)
        x = x + g1 * (mixed @ w_out[l])
        tokens = (rms_norm(x, norm_ffn[l]) * (1.0 + sc2) + sh2).reshape(b * s, d)
        if ctx_out:
            xc = xc + cg1 * (mixed_c @ w_out[l])
            hfc = rms_norm(xc, norm_ffn[l]) * (1.0 + csc2) + csh2
            tokens = jnp.concatenate([tokens, hfc.reshape(b * n_ctx, d)], axis=0)
        y = hier_moe(tokens, router_group_w[l], router_group_b[l], router_expert_w[l], router_expert_b[l],
                     w_gate[l], w_up[l], w_down[l])
        x = x + g2 * y[:b * s].reshape(b, s, d)
        if ctx_out:
            xc = xc + cg2 * y[b * s:].reshape(b, n_ctx, d)
    return rms_norm(x, final_norm)
```

```cpp
#include <hip/hip_runtime.h>
#include <stdint.h>
#include <stdio.h>

#define DI __device__ __forceinline__
#ifndef MFMA_GEMM
#define MFMA_GEMM 15
#endif
#ifndef DUP_PH
#define DUP_PH -1
#endif
#ifndef DUP_L
#define DUP_L 0
#endif
#ifndef MFMA_ATTN
#define MFMA_ATTN 1
#endif
#ifndef ATTN_PIPE
#define ATTN_PIPE 2
#endif
typedef unsigned short bf16_t;
typedef float f32x4 __attribute__((ext_vector_type(4)));
typedef unsigned u32x4 __attribute__((ext_vector_type(4)));
typedef unsigned u32x2 __attribute__((ext_vector_type(2)));

constexpr int D = 1024, NB = 4, SEQ = 8192, NLAT = NB * SEQ, CTXL = 256, NCTX = NB * CTXL, NT = NLAT + NCTX;
constexpr int KEYS = CTXL + SEQ;
constexpr int INW = 2560, QKW = 1792, VW = 768;
constexpr int NKH = 12;
constexpr int NBUCKET = 24, MAXTILES = 156, MAXSLOTS = MAXTILES * 256;
constexpr int NWG_THREADS = 512;
constexpr int LDS_BYTES = 163840;

constexpr size_t al256(size_t x) { return (x + 255) & ~(size_t)255; }
constexpr size_t WS_SYNC = 0;
constexpr size_t SYNC_BYTES = 65536;
constexpr size_t KMAX_OFF_WORDS = 4096 + 64;
constexpr size_t QMAX_OFF_WORDS = 4096 + 192;
constexpr size_t CNT_OFF_WORDS = 4096;
constexpr size_t WS_MOD = WS_SYNC + SYNC_BYTES;
constexpr size_t WS_ROPEB = WS_MOD + al256((size_t)2 * 5 * 6144 * 4);
constexpr size_t WS_ROPEC = WS_ROPEB + 128 * 8 * 2 * 4;
constexpr size_t WS_LAM = WS_ROPEC + 128 * 16 * 2 * 4;
constexpr size_t WS_TOKINFO = WS_LAM + 256;
constexpr size_t WS_TOKSLOT = WS_TOKINFO + (size_t)NT * 16;
constexpr size_t WS_SLOTTOK = WS_TOKSLOT + (size_t)NT * 4;
constexpr size_t WS_SLOTW = WS_SLOTTOK + (size_t)MAXSLOTS * 4;
constexpr size_t WS_XC = WS_SLOTW + (size_t)MAXSLOTS * 8;
constexpr size_t WS_WINT = WS_XC + (size_t)NCTX * D * 4;
constexpr size_t WS_WOUTT = WS_WINT + (size_t)2 * INW * D * 2;
constexpr size_t WS_WGU = WS_WOUTT + (size_t)2 * D * D * 2;
constexpr size_t WS_WDT = WS_WGU + (size_t)2 * 16 * 1024 * 1024 * 2;
constexpr size_t WS_ACT = WS_WDT + (size_t)2 * 16 * 1024 * 512 * 2;
constexpr size_t WS_BIG = WS_ACT + (size_t)MAXSLOTS * D * 2;
constexpr size_t BIG_PROJ = 0;
constexpr size_t BIG_KPOST = BIG_PROJ + (size_t)NT * QKW * 2;
constexpr size_t BIG_VT = BIG_KPOST + (size_t)NB * NKH * KEYS * 64 * 2;
constexpr size_t BIG_Y16 = (size_t)MAXSLOTS * D * 2;
constexpr size_t BIG_END = BIG_VT + (size_t)NB * NKH * KEYS * 64 * 2;
constexpr size_t WS_END = WS_BIG + BIG_END;
static_assert((size_t)MAXSLOTS * 2048 * 2 <= BIG_END && (size_t)NT * D * 4 <= BIG_END, "alias");
constexpr size_t WS_XB = WS_END;
constexpr int SPCAP = NT;
constexpr size_t WS_SPTOK = WS_XB + (size_t)NT * D * 2;
constexpr size_t WS_SPW = WS_SPTOK + (size_t)NBUCKET * SPCAP * 4;
constexpr size_t WS_RWT = WS_SPW + (size_t)NBUCKET * SPCAP * 8;
constexpr size_t WS_END2 = WS_RWT + (size_t)2 * 20 * 1024 * 4;
static_assert(WS_END2 <= (size_t)512 * 1024 * 1024, "workspace");

struct Params {
    const float* in[26];
    float* out;
    unsigned char* ws;
    int ph_lo, ph_hi;
};

DI float bf2f(bf16_t v) { return __uint_as_float((unsigned)v << 16); }
DI bf16_t f2bf(float f) { unsigned u = __float_as_uint(f); u += 0x7fffu + ((u >> 16) & 1u); return (bf16_t)(u >> 16); }
DI unsigned pack2(float a, float b) { return (unsigned)f2bf(a) | ((unsigned)f2bf(b) << 16); }
DI float dpp_row_sum(float s) {
    s += __int_as_float(__builtin_amdgcn_update_dpp(0, __float_as_int(s), 0xB1, 0xF, 0xF, false));
    s += __int_as_float(__builtin_amdgcn_update_dpp(0, __float_as_int(s), 0x4E, 0xF, 0xF, false));
    s += __int_as_float(__builtin_amdgcn_update_dpp(0, __float_as_int(s), 0x141, 0xF, 0xF, false));
    s += __int_as_float(__builtin_amdgcn_update_dpp(0, __float_as_int(s), 0x140, 0xF, 0xF, false));
    return s;
}
DI float swap32_sum(float a, float b) { const auto r = __builtin_amdgcn_permlane32_swap(__float_as_uint(a), __float_as_uint(b), false, false); return __uint_as_float(r[0]) + __uint_as_float(r[1]); }
DI float swap16_sum(float a, float b) { const auto r = __builtin_amdgcn_permlane16_swap(__float_as_uint(a), __float_as_uint(b), false, false); return __uint_as_float(r[0]) + __uint_as_float(r[1]); }
DI float wave_sum(float v) { const float a = swap32_sum(v, v); return dpp_row_sum(swap16_sum(a, a)); }
DI int clampi(int v, int lo, int hi) { return v < lo ? lo : (v > hi ? hi : v); }

#define XB_TMO      128
#define XB_XCNT(j)  (256  + 64 * (j))
#define XB_XSUB(j)  (1280 + 64 * (j))
#define XB_XGEN(j)  (2304 + 64 * (j))
#define XB_TOP      3328
#define XB_TOPGEN   3392
#define XCD_BAR_WORDS 3456
#define XB_SPIN_CAP (1u << 18)
typedef float f32x2 __attribute__((ext_vector_type(2)));
#define LAS __attribute__((address_space(3)))
#define GAS __attribute__((address_space(1)))
DI unsigned xb_ld(unsigned* p)              { return __hip_atomic_load(p, __ATOMIC_RELAXED, __HIP_MEMORY_SCOPE_AGENT); }
DI unsigned xb_add(unsigned* p, unsigned v) { return __hip_atomic_fetch_add(p, v, __ATOMIC_RELAXED, __HIP_MEMORY_SCOPE_AGENT); }
DI unsigned xb_xcc_id() { return (unsigned)__builtin_amdgcn_s_getreg((3 << 11) | 20) & 0xFu; }
#define XB_SPIN(cond, bar) do { unsigned _sp = 0; while (cond) { __builtin_amdgcn_s_sleep(1); \
    if ((++_sp & 255u) == 0u) { if (xb_ld(&(bar)[XB_TMO])) break; if (_sp > XB_SPIN_CAP) { atomicAdd(&(bar)[XB_TMO], 1u); break; } } } } while (0)
struct XcdBarrier { unsigned* bar; unsigned x; volatile LAS unsigned* st; };
DI XcdBarrier xcd_barrier_post(unsigned* bar, volatile LAS unsigned* st) {
    XcdBarrier b; b.bar = bar; b.x = xb_xcc_id(); b.st = st;
    if (threadIdx.x == 0) (void)xb_add(&bar[XB_XCNT(b.x)], 1u);
    return b;
}
DI void xcd_barrier_complete(unsigned* bar, unsigned x, unsigned& nloc, unsigned& nx) {
    const unsigned G = gridDim.x * gridDim.y * gridDim.z;
    unsigned sum, cnt, mine, sp = 0u;
    for (;;) {
        sum = 0u; cnt = 0u; mine = 0u;
#pragma unroll
        for (unsigned j = 0; j < 16; ++j) { const unsigned c = xb_ld(&bar[XB_XCNT(j)]); sum += c; cnt += (c > 0u) ? 1u : 0u; mine = (j == x) ? c : mine; }
        if (sum == G) break;
        __builtin_amdgcn_s_sleep(1);
        if ((++sp & 255u) == 0u) { if (xb_ld(&bar[XB_TMO])) break; if (sp > XB_SPIN_CAP) { atomicAdd(&bar[XB_TMO], 1u); break; } }
    }
    nloc = mine > 0u ? mine : 1u; nx = cnt > 0u ? cnt : 1u;
}
DI void xcd_barrier(const XcdBarrier& b) {
    asm volatile("s_waitcnt vmcnt(0)" ::: "memory");
    __syncthreads();
    if (threadIdx.x == 0) {
        unsigned* bar = b.bar;
        __builtin_amdgcn_s_waitcnt(0);
        unsigned nloc = b.st[0], nx = b.st[1];
        if (nloc == 0u) { xcd_barrier_complete(bar, b.x, nloc, nx); b.st[0] = nloc; b.st[1] = nx; }
        const unsigned old = xb_add(&bar[XB_XSUB(b.x)], 1u);
        const unsigned gen = old / nloc;
        if (old + 1u == (gen + 1u) * nloc) {
            __builtin_amdgcn_fence(__ATOMIC_RELEASE, "agent");
            asm volatile("s_waitcnt vmcnt(0)" ::: "memory");
            const unsigned og = xb_add(&bar[XB_TOP], 1u);
            const unsigned tg = og / nx;
            if (og + 1u == (tg + 1u) * nx) xb_add(&bar[XB_TOPGEN], 1u);
            else XB_SPIN(xb_ld(&bar[XB_TOPGEN]) == tg, bar);
            __builtin_amdgcn_fence(__ATOMIC_ACQUIRE, "agent");
            xb_add(&bar[XB_XGEN(b.x)], 1u);
            asm volatile("s_waitcnt vmcnt(0)" ::: "memory");
        } else {
            XB_SPIN(xb_ld(&bar[XB_XGEN(b.x)]) == gen, bar);
            __builtin_amdgcn_fence(__ATOMIC_ACQUIRE, "agent");
            asm volatile("s_waitcnt vmcnt(0)" ::: "memory");
        }
    }
    __syncthreads();
}

typedef const Params __attribute__((address_space(4)))* KParams;
DI const float* gin(KParams p, int i) { GAS const float* g = (GAS const float*)p->in[i]; asm volatile("" : "+s"(g)); return (const float*)g; }
DI float* gout(KParams p) { GAS float* g = (GAS float*)p->out; asm volatile("" : "+s"(g)); return (float*)g; }
struct Frame {
    KParams p; GAS unsigned char* ws; float* lds; int tid, wid, lane, wg, nwg;
    template <class T> DI T* wsp(size_t off) const { return (T*)(GAS T*)(ws + off); }
};
DI const float* mod_row(const Frame& F, int l, int mrow) { return F.wsp<float>(WS_MOD) + ((size_t)l * 5 + mrow) * 6144; }
DI int tok_modrow(int t) { return t < NLAT ? (t >> 13) : 4; }
DI int tok_batch(int t) { return t < NLAT ? (t >> 13) : ((t - NLAT) >> 8); }
DI int tok_key(int t) { return t < NLAT ? CTXL + (t & (SEQ - 1)) : ((t - NLAT) & (CTXL - 1)); }
DI bf16_t* xres_row(const Frame& F, int t) { return F.wsp<bf16_t>(WS_XB) + (size_t)t * D; }
DI const float* xin_row(const Frame& F, int t) { return t < NLAT ? gin(F.p, 0) + (size_t)t * D : gin(F.p, 2) + (size_t)(t - NLAT) * D; }
DI double lam_init_of(int l) { return l == 0 ? 0.8 - 0.6 : 0.8 - 0.6 * 0.74081822068171786607; }
DI void sincos_d(double a, double& s, double& c) {
    const double n = __builtin_rint(a * 0.63661977236758134308);
    const double r = (a - n * 1.57079632673412561417e+00) - n * 6.07710050650619224932e-11;
    const double r2 = r * r;
    double ts = 1.0, tc = 1.0;
#pragma unroll
    for (int k = 12; k >= 1; --k) { ts = 1.0 - ts * r2 * (1.0 / (double)((2 * k) * (2 * k + 1))); tc = 1.0 - tc * r2 * (1.0 / (double)((2 * k - 1) * (2 * k))); }
    const double sr = r * ts, cr = tc;
    const int q = ((int)n) & 3;
    s = q == 0 ? sr : (q == 1 ? cr : (q == 2 ? -sr : -cr));
    c = q == 0 ? cr : (q == 1 ? -sr : (q == 2 ? -cr : sr));
}
DI double exp_d(double x) { double t = 1.0;
#pragma unroll
    for (int k = 40; k >= 1; --k) t = 1.0 + t * x * (1.0 / (double)k);
    return t; }

DI int win_rowmap(int c) {
    int hs, e; bool isb = false;
    if (c < 384) { hs = c >> 6; e = c & 63; }
    else if (c < 768) { hs = 6 + ((c - 384) >> 6); e = c & 63; }
    else if (c < 1152) return QKW + (c - 768);
    else if (c < 1408) { hs = 12 + ((c - 1152) >> 6); e = (c - 1152) & 63; isb = true; }
    else if (c < 1664) { hs = 16 + ((c - 1408) >> 6); e = (c - 1408) & 63; isb = true; }
    else if (c < 1920) return QKW + 384 + (c - 1664);
    else if (c < 2304) { hs = 20 + ((c - 1920) >> 6); e = (c - 1920) & 63; }
    else if (c < 2432) { hs = 26 + ((c - 2304) >> 6); e = (c - 2304) & 63; }
    else return QKW + 640 + (c - 2432);
    int bj, fq; const int j = e & 7;
    if (!isb) { bj = e >> 5; fq = (e >> 3) & 3; } else { const int mp = e >> 5, i = e & 31; bj = i >> 4; fq = 2 * mp + ((i >> 3) & 1); }
    return 256 * (hs >> 2) + 128 * bj + 32 * (hs & 3) + 8 * fq + j;
}
DI void cvt_tile(const Frame& F, const float* src, int C, int k0, int n0, bf16_t* dst, int ldd, int mode) {
    float* t = F.lds;
    __syncthreads();
    { const int kk = F.tid >> 3, nn = (F.tid & 7) * 8;
      const float* s = src + (size_t)(k0 + kk) * C + n0 + nn;
      const f32x4 a = *(const f32x4*)s, b = *(const f32x4*)(s + 4);
      float* d = t + kk * 65 + nn;
      d[0] = a[0]; d[1] = a[1]; d[2] = a[2]; d[3] = a[3]; d[4] = b[0]; d[5] = b[1]; d[6] = b[2]; d[7] = b[3]; }
    __syncthreads();
    { const int nn = F.tid >> 3, kk0 = (F.tid & 7) * 8;
      u32x4 o;
#pragma unroll
      for (int j = 0; j < 4; ++j) o[j] = pack2(t[(kk0 + 2 * j) * 65 + nn], t[(kk0 + 2 * j + 1) * 65 + nn]);
      const int c = n0 + nn; const int orow = mode == 0 ? c : (mode == 1 ? win_rowmap(c) : (mode == 2 ? 2 * c : 2 * c + 1));
      *(u32x4*)(dst + (size_t)orow * ldd + k0 + kk0) = o; }
}
struct CvtJob { const float* src; bf16_t* dst; int C, k0, n0, ldd, mode; };
DI CvtJob cvt_job(const Frame& F, int ug) {
    const KParams Pp = F.p;
    const int T0 = 1280, T1 = T0 + 512, T2 = T1 + 4096, T3 = T2 + 4096;
    const int u = ug * 4;
    CvtJob J;
    if (u < T0) { const int l = u / 640, r = u % 640, kt = r / 40, nt = r % 40;
        J.src = gin(Pp, 8) + (size_t)l * D * INW; J.C = INW; J.k0 = kt * 64; J.n0 = nt * 64; J.dst = F.wsp<bf16_t>(WS_WINT) + (size_t)l * INW * D; J.ldd = D; J.mode = 1;
    } else if (u < T1) { const int v = u - T0, l = v / 256, r = v % 256, kt = r / 16, nt = r % 16;
        J.src = gin(Pp, 9) + (size_t)l * D * D; J.C = D; J.k0 = kt * 64; J.n0 = nt * 64; J.dst = F.wsp<bf16_t>(WS_WOUTT) + (size_t)l * D * D; J.ldd = D; J.mode = 0;
    } else if (u < T3) { const bool up = u >= T2; const int v = u - (up ? T2 : T1), le = v / 128, r = v % 128, kt = r / 8, nt = r % 8;
        J.src = (up ? gin(Pp, 23) : gin(Pp, 22)) + (size_t)le * D * 512; J.C = 512; J.k0 = kt * 64; J.n0 = nt * 64; J.dst = F.wsp<bf16_t>(WS_WGU) + (size_t)le * 1024 * 1024; J.ldd = D; J.mode = up ? 3 : 2;
    } else { const int v = u - T3, le = v / 128, r = v % 128, kt = r / 16, nt = r % 16;
        J.src = gin(Pp, 24) + (size_t)le * 512 * D; J.C = D; J.k0 = kt * 64; J.n0 = nt * 64; J.dst = F.wsp<bf16_t>(WS_WDT) + (size_t)le * 1024 * 512; J.ldd = 512; J.mode = 0;
    }
    return J;
}
DI void phase_prologue(const Frame& F) {
    const KParams Pp = F.p;
    {
        constexpr int NG = (1280 + 512 + 3 * 4096) / 4;
        float* t = F.lds;
        const int kk = F.tid >> 3, nn = (F.tid & 7) * 8;
        const int tn = F.tid >> 3, kk0 = (F.tid & 7) * 8;
        int ug = F.wg;
        CvtJob J = cvt_job(F, ug < NG ? ug : 0);
        f32x4 a[4], b[4];
#define CVT_ISSUE() { const float* sp = J.src + (size_t)(J.k0 + kk) * J.C + J.n0 + nn; \
        _Pragma("unroll") for (int q = 0; q < 4; ++q) { a[q] = *(const f32x4*)(sp + 64 * q); b[q] = *(const f32x4*)(sp + 64 * q + 4); } }
        if (ug < NG) CVT_ISSUE()
        while (ug < NG) {
            __syncthreads();
#pragma unroll
            for (int q = 0; q < 4; ++q) { float* d = t + q * (64 * 65) + kk * 65 + nn;
                d[0] = a[q][0]; d[1] = a[q][1]; d[2] = a[q][2]; d[3] = a[q][3]; d[4] = b[q][0]; d[5] = b[q][1]; d[6] = b[q][2]; d[7] = b[q][3]; }
            __syncthreads();
            const CvtJob Jc = J; const int un = ug + F.nwg;
            if (un < NG) { J = cvt_job(F, un); CVT_ISSUE() }
#pragma unroll
            for (int q = 0; q < 4; ++q) { const float* tq = t + q * (64 * 65);
                u32x4 o;
#pragma unroll
                for (int j = 0; j < 4; ++j) o[j] = pack2(tq[(kk0 + 2 * j) * 65 + tn], tq[(kk0 + 2 * j + 1) * 65 + tn]);
                const int c = Jc.n0 + 64 * q + tn; const int orow = Jc.mode == 0 ? c : (Jc.mode == 1 ? win_rowmap(c) : (Jc.mode == 2 ? 2 * c : 2 * c + 1));
                *(u32x4*)(Jc.dst + (size_t)orow * Jc.ldd + Jc.k0 + kk0) = o; }
            ug = un;
        }
#undef CVT_ISSUE
    }
    __syncthreads();
    {
        float* sc = F.lds;
        float* red = F.lds + 5 * 1024;
        { float cv[10];
#pragma unroll
          for (int it = 0; it < 10; ++it) { const int k = (F.tid + NWG_THREADS * it) & 1023; cv[it] = (it >> 1) < 4 ? gin(Pp, 1)[(it >> 1) * 1024 + k] : gin(Pp, 3)[k]; }
#pragma unroll
          for (int it = 0; it < 10; ++it) sc[F.tid + NWG_THREADS * it] = cv[it] / (1.f + expf(-cv[it])); }
        __syncthreads();
        for (int u = F.wg; u < 192; u += F.nwg) {
            const int l = u / 96, j0 = (u % 96) * 64, kg = F.tid >> 4, jq = (F.tid & 15) * 4;
            const float* w = gin(Pp, 4) + (size_t)l * D * 6144 + j0 + jq + (size_t)(kg * 32) * 6144;
            f32x4 acc[5];
#pragma unroll
            for (int r = 0; r < 5; ++r) acc[r] = (f32x4){0.f, 0.f, 0.f, 0.f};
#pragma unroll
            for (int kb = 0; kb < 32; kb += 8) {
                f32x4 wv[8];
#pragma unroll
                for (int e = 0; e < 8; ++e) wv[e] = *(const f32x4*)(w + (size_t)(kb + e) * 6144);
#pragma unroll
                for (int e = 0; e < 8; ++e) { const int k = kg * 32 + kb + e;
#pragma unroll
                    for (int r = 0; r < 5; ++r) acc[r] += wv[e] * sc[r * 1024 + k]; } }
#pragma unroll
            for (int r = 0; r < 5; ++r) *(f32x4*)(red + (kg * 5 + r) * 64 + jq) = acc[r];
            __syncthreads();
            if (F.tid < 320) { const int r = F.tid >> 6, jj = F.tid & 63; float s = 0; for (int g = 0; g < 32; ++g) s += red[(g * 5 + r) * 64 + jj]; F.wsp<float>(WS_MOD)[((size_t)l * 5 + r) * 6144 + j0 + jj] = s + gin(Pp, 5)[l * 6144 + j0 + jj]; }
            __syncthreads();
        }
    }
    for (int i = F.wg * NWG_THREADS + F.tid; i < 2 * 20480; i += F.nwg * NWG_THREADS) { const int l = i / 20480, r = i % 20480, j = r >> 10, k = r & 1023;
        F.wsp<float>(WS_RWT)[i] = j < 4 ? gin(Pp, 18)[(size_t)l * 4096 + k * 4 + j] : gin(Pp, 20)[(size_t)l * 16384 + k * 16 + (j - 4)]; }
    const bool rev = F.nwg >= 32; const int rwg = rev ? F.nwg - 1 - F.wg : F.wg, qoff = rev ? 8 : 0, lamwg = rev ? 24 : 0;
    for (int i = rwg * NWG_THREADS + F.tid; i < 128 * 8 + 128 * 16; i += F.nwg * NWG_THREADS) {
        const bool isb = i < 1024; const int v = isb ? i : i - 1024, pos = isb ? v >> 3 : v >> 4, j = isb ? v & 7 : v & 15;
        const double base = isb ? 0.31622776601683793320 : 0.56234132519034908039;
        double f = 1.0; for (int k = 0; k < j; ++k) f *= base;
        double sn, cs; sincos_d((double)pos * f, sn, cs);
        float* dst = isb ? F.wsp<float>(WS_ROPEB) : F.wsp<float>(WS_ROPEC);
        dst[v * 2] = (float)cs; dst[v * 2 + 1] = (float)sn;
    }
    for (int q = rwg - qoff; q >= 0 && q < 12; q += F.nwg) {
        float bm = F.tid < 465 ? fabsf(gin(Pp, 10)[(size_t)q * 465 + F.tid]) : 0.f;
#pragma unroll
        for (int of = 32; of; of >>= 1) bm = fmaxf(bm, __shfl_xor(bm, of));
        __syncthreads();
        if (F.lane == 0) F.lds[F.wid] = bm;
        __syncthreads();
        if (F.tid == 0) { float m = F.lds[0]; for (int i = 1; i < 8; ++i) m = fmaxf(m, F.lds[i]); F.wsp<float>(WS_LAM)[16 + q] = m * 1.4426950408889634f; }
        __syncthreads(); }
    if (F.wg == F.nwg - 1 && F.wid == 1) {
#pragma unroll
        for (int l = 0; l < 2; ++l) { float g = fabsf(gin(Pp, 16)[l * 64 + F.lane]);
#pragma unroll
            for (int of = 32; of; of >>= 1) g = fmaxf(g, __shfl_xor(g, of));
            if (F.lane == 0) F.wsp<float>(WS_LAM)[32 + l] = g; } }
    if (rwg == lamwg && F.wid == 0) {
#pragma unroll
        for (int l = 0; l < 2; ++l) { double s1 = 0.0, s2 = 0.0;
            if (F.lane < 32) { s1 = (double)gin(Pp, 11)[l * 32 + F.lane] * (double)gin(Pp, 12)[l * 32 + F.lane]; s2 = (double)gin(Pp, 13)[l * 32 + F.lane] * (double)gin(Pp, 14)[l * 32 + F.lane]; }
#pragma unroll
            for (int of = 16; of; of >>= 1) { s1 += __shfl_xor(s1, of); s2 += __shfl_xor(s2, of); }
            if (F.lane == 0) { const double li = lam_init_of(l); F.wsp<float>(WS_LAM)[l * 2] = (float)(exp_d(s1) - exp_d(s2) + li); F.wsp<float>(WS_LAM)[l * 2 + 1] = (float)li; } } }
}

DI f32x4 bf4_to_f32(u32x2 v) { return (f32x4){__uint_as_float(v[0] << 16), __uint_as_float(v[0] & 0xffff0000u), __uint_as_float(v[1] << 16), __uint_as_float(v[1] & 0xffff0000u)}; }
DI unsigned cvtpk_rne(float lo, float hi) { unsigned r; asm volatile("s_nop 0\n\tv_cvt_pk_bf16_f32 %0, %1, %2" : "=v"(r) : "v"(lo), "v"(hi)); return r; }
DI int build_tiles(const Frame& F, int l, int* tile_bucket, int* boff);
DI void phase_norm1(const Frame& F, int l) {
    const KParams Pp = F.p;
    const float* gain = gin(Pp, 6) + l * D;
    bf16_t* act = F.wsp<bf16_t>(WS_ACT);
    const bf16_t* y16 = F.wsp<bf16_t>(WS_BIG + BIG_Y16); const int4* tokinfo = F.wsp<int4>(WS_TOKINFO);
    int* tile_bucket = (int*)F.lds; int* boff = tile_bucket + MAXTILES;
    if (l != 0) build_tiles(F, l - 1, tile_bucket, boff);
    const int stride = F.nwg * 8;
    f32x4 rxf[2][4]; u32x2 rxb[2][4], ryb[2][4]; int nsl[2] = {0, 0};
#pragma unroll
    for (int r = 0; r < 2; ++r)
#pragma unroll
        for (int i = 0; i < 4; ++i) { rxf[r][i] = (f32x4){0.f, 0.f, 0.f, 0.f}; rxb[r][i] = (u32x2){0u, 0u}; ryb[r][i] = (u32x2){0u, 0u}; }
#define N1_SLOTS(T0) if (l != 0 && (T0) < NT) { const int2 i0_ = *(const int2*)(tokinfo + (T0)), i1_ = *(const int2*)(tokinfo + (T0) + 1); nsl[0] = boff[i0_.x] * 256 + i0_.y; nsl[1] = boff[i1_.x] * 256 + i1_.y; }
#define N1_ISSUE(T0) if ((T0) < NT) { \
        _Pragma("unroll") for (int r = 0; r < 2; ++r) { \
            if (l == 0) { const float* s_ = xin_row(F, (T0) + r); _Pragma("unroll") for (int i = 0; i < 4; ++i) rxf[r][i] = *(const f32x4*)(s_ + (i * 64 + F.lane) * 4); } \
            else { const bf16_t* s_ = xres_row(F, (T0) + r); const bf16_t* yr_ = y16 + (size_t)nsl[r] * D; \
                _Pragma("unroll") for (int i = 0; i < 4; ++i) { const int k = (i * 64 + F.lane) * 4; rxb[r][i] = *(const u32x2*)(s_ + k); ryb[r][i] = *(const u32x2*)(yr_ + k); } } } }
    const int tfirst = 2 * (F.wg * 8 + F.wid);
    N1_SLOTS(tfirst)
    N1_ISSUE(tfirst)
    N1_SLOTS(tfirst + 2 * stride)
    for (int t0 = tfirst; t0 < NT; t0 += 2 * stride) {
        const int tt[2] = {t0, t0 + 1};
        const float* m = mod_row(F, l, tok_modrow(t0));
        f32x4 v[2][4], g2v[4];
        if (l != 0) { const float* g2 = mod_row(F, l - 1, tok_modrow(t0)) + 5120;
#pragma unroll
            for (int i = 0; i < 4; ++i) g2v[i] = *(const f32x4*)(g2 + (i * 64 + F.lane) * 4); }
        f32x4 gsv[4], shv[4], scv[4];
#pragma unroll
        for (int i = 0; i < 4; ++i) { const int k = (i * 64 + F.lane) * 4; gsv[i] = *(const f32x4*)(gain + k); shv[i] = *(const f32x4*)(m + k); scv[i] = *(const f32x4*)(m + 1024 + k); }
        if (l == 0) {
#pragma unroll
            for (int r = 0; r < 2; ++r)
#pragma unroll
                for (int i = 0; i < 4; ++i) v[r][i] = rxf[r][i];
        } else {
#pragma unroll
            for (int r = 0; r < 2; ++r) { bf16_t* s = xres_row(F, tt[r]);
#pragma unroll
                for (int i = 0; i < 4; ++i) { const int k = (i * 64 + F.lane) * 4; v[r][i] = bf4_to_f32(rxb[r][i]) + g2v[i] * bf4_to_f32(ryb[r][i]);
                    u32x2 xo; xo[0] = cvtpk_rne(v[r][i][0], v[r][i][1]); xo[1] = cvtpk_rne(v[r][i][2], v[r][i][3]); *(u32x2*)(s + k) = xo; } }
        }
        __builtin_amdgcn_sched_barrier(0);
        N1_ISSUE(t0 + 2 * stride)
        N1_SLOTS(t0 + 4 * stride)
        __builtin_amdgcn_sched_barrier(0);
        float ss[2] = {0.f, 0.f};
#pragma unroll
        for (int r = 0; r < 2; ++r)
#pragma unroll
            for (int i = 0; i < 4; ++i) ss[r] += v[r][i][0] * v[r][i][0] + v[r][i][1] * v[r][i][1] + v[r][i][2] * v[r][i][2] + v[r][i][3] * v[r][i][3];
#pragma unroll
        for (int i = 0; i < 4; ++i) gsv[i] = gsv[i] * (scv[i] + 1.f);
        ss[0] = wave_sum(ss[0]); ss[1] = wave_sum(ss[1]);
#pragma unroll
        for (int r = 0; r < 2; ++r) { const int t = tt[r];
            const float rstd = rsqrtf(ss[r] * (1.f / D) + 1e-6f);
#pragma unroll
            for (int i = 0; i < 4; ++i) { const int k = (i * 64 + F.lane) * 4;
                const f32x4 h = v[r][i] * rstd * gsv[i] + shv[i];
                u32x2 o; o[0] = cvtpk_rne(h[0], h[1]); o[1] = cvtpk_rne(h[2], h[3]);
                *(u32x2*)(act + (size_t)t * D + k) = o; } }
    }
#undef N1_ISSUE
#undef N1_SLOTS
}

namespace pg8 {
typedef short bf16x8 __attribute__((ext_vector_type(8)));
constexpr int BM = 256, BK = 64, HALF = 128, HTB = HALF * BK * 2, STAGE_BYTES = 8 * HTB;
DI int lds_byte(int r, int c) { const int st = (r >> 4) * 2 + (c >> 5), rr = r & 15, cc = c & 31, ob = rr * 64 + cc * 2; return st * 1024 + (ob ^ (((ob >> 9) & 1) << 5)); }
DI void stage_rc(int b, int& R, int& C) { const int st = b / 1024, sb = b % 1024, swz = sb ^ (((sb >> 9) & 1) << 5); R = (st >> 1) * 16 + swz / 64; C = (st & 1) * 32 + (swz % 64) / 2; }
DI int perm32(int rho) { const int n = rho >> 4, i = rho & 15; return 8 * (i >> 2) + 4 * n + (i & 3); }
struct Unit { int pm, pn, aux; };
DI unsigned cvt_pk_bf16(float lo, float hi) { unsigned r; asm volatile("v_cvt_pk_bf16_f32 %0, %1, %2" : "=v"(r) : "v"(lo), "v"(hi)); return r; }

template <class Epi, class Sched>
DI void gemm_phase(LAS unsigned char* lds, const int K, const int lda, const int ldb, const Sched& S, const Epi& E) {
    int tid = threadIdx.x; asm volatile("" : "+v"(tid));
    const int wid = __builtin_amdgcn_readfirstlane(tid >> 6), lane = tid & 63, wr = wid >> 2, wc = wid & 3, fr = lane & 15, fq = lane >> 4;
    const int nt = K / BK, tps = nt / Sched::NSEG;
    int RA[2], CA[2]; unsigned voffB[2];
#pragma unroll
    for (int i = 0; i < 2; ++i) { int R, C; stage_rc(tid * 16 + i * 8192, R, C); const int Rb = Epi::PERM ? ((R & ~31) + perm32(R & 31)) : R; RA[i] = R; CA[i] = C; voffB[i] = (unsigned)(Rb * ldb + C) * 2u; }
    const size_t kstep = (size_t)(BK * 2);
    const size_t hstepB = (size_t)HALF * ldb * 2;
    const unsigned ldsw = (unsigned)wid * 1024u;
    const int aoff = lds_byte(wr * 64 + fr, fq * 8), boff = lds_byte(wc * 32 + fr, fq * 8);
#define PG8_SA(b, h) (((b) * 2 + (h)) * HTB)
#define PG8_SB(b, h) ((4 + (b) * 2 + (h)) * HTB)
#define PG8_STAGE(bufoff, gbase, voff) do { _Pragma("unroll") for (int _i = 0; _i < 2; ++_i) \
        __builtin_amdgcn_global_load_lds((const unsigned*)((const char*)(gbase) + (voff)[_i]), (LAS unsigned*)(lds + (bufoff) + ldsw + _i * 8192), 16, 0, 0); } while (0)
#define PG8_LDA(dst, b, h) do { _Pragma("unroll") for (int m = 0; m < 4; ++m) _Pragma("unroll") for (int k = 0; k < 2; ++k) dst[m][k] = *(const LAS bf16x8*)(lds + PG8_SA(b, h) + aoff + m * 2048 + k * 1024); } while (0)
#define PG8_LDB(dst, b, h) do { _Pragma("unroll") for (int n = 0; n < 2; ++n) _Pragma("unroll") for (int k = 0; k < 2; ++k) dst[n][k] = *(const LAS bf16x8*)(lds + PG8_SB(b, h) + boff + n * 2048 + k * 1024); } while (0)
#define PG8_MMA(ai, bj, At, Bt) do { __builtin_amdgcn_s_setprio(1); _Pragma("unroll") for (int m = 0; m < 4; ++m) _Pragma("unroll") for (int n = 0; n < 2; ++n) _Pragma("unroll") for (int k = 0; k < 2; ++k) \
        acc[ai][bj][m][n] = __builtin_amdgcn_mfma_f32_16x16x32_bf16(Bt[n][k], At[m][k], acc[ai][bj][m][n], 0, 0, 0); __builtin_amdgcn_s_setprio(0); } while (0)
#define PG8_WAIT_V(n) asm volatile("s_waitcnt vmcnt(" #n ")" ::: "memory")
#define PG8_WAIT_L(n) asm volatile("s_waitcnt lgkmcnt(" #n ")" ::: "memory")
#define PG8_BAR __builtin_amdgcn_s_barrier()
#define PG8_SCHED __builtin_amdgcn_sched_barrier(0)
    Unit cur, nxt; int ui = 0;
    if (!S.next(0, cur)) return;
    f32x4 acc[2][2][4][2];
#pragma unroll
    for (int a = 0; a < 2; ++a)
#pragma unroll
        for (int b = 0; b < 2; ++b)
#pragma unroll
            for (int m = 0; m < 4; ++m)
#pragma unroll
                for (int n = 0; n < 2; ++n) acc[a][b][m][n] = (f32x4){0.f, 0.f, 0.f, 0.f};
    bf16x8 At[4][2], B0[2][2], B1[2][2];
    float epre[8] = {0.f, 0.f, 0.f, 0.f, 0.f, 0.f, 0.f, 0.f};
    unsigned vA[2][2], nvA[2][2];
#pragma unroll
    for (int h = 0; h < 2; ++h) { int r0 = h * HALF + RA[0], r1 = h * HALF + RA[1]; if (Sched::GATHER) S.a_rows(cur, r0, r1);
        vA[h][0] = (unsigned)(r0 * lda + CA[0]) * 2u; vA[h][1] = (unsigned)(r1 * lda + CA[1]) * 2u; nvA[h][0] = vA[h][0]; nvA[h][1] = vA[h][1]; }
    const char* cA = S.a_base(cur); const char* cB0 = S.b_base(cur, 0); const char* cB1 = Sched::NSEG > 1 ? S.b_base(cur, 1) : cB0;
#define PG8_BPTR(b0, b1, t) ((Sched::NSEG > 1 && (t) >= tps) ? (b1) + (size_t)((t) - tps) * kstep : (b0) + (size_t)(t) * kstep)
    PG8_STAGE(PG8_SB(0, 0), cB0, voffB); PG8_STAGE(PG8_SA(0, 0), cA, vA[0]); PG8_STAGE(PG8_SB(0, 1), cB0 + hstepB, voffB); PG8_STAGE(PG8_SA(0, 1), cA, vA[1]);
    if (wr == 1) PG8_BAR;
    PG8_WAIT_V(4); PG8_BAR;
    PG8_STAGE(PG8_SB(1, 0), cB0 + kstep, voffB); PG8_STAGE(PG8_SA(1, 0), cA + kstep, vA[0]); PG8_STAGE(PG8_SB(1, 1), cB0 + hstepB + kstep, voffB);
    PG8_WAIT_V(6); PG8_BAR;
    for (;;) {
        const bool has_next = S.next(ui + 1, nxt);
        const char* nA = has_next ? S.a_base(nxt) : cA; const char* nB0 = has_next ? S.b_base(nxt, 0) : cB0; const char* nB1 = has_next ? (Sched::NSEG > 1 ? S.b_base(nxt, 1) : nB0) : cB1;
        if (Sched::GATHER && has_next) {
#pragma unroll
            for (int h = 0; h < 2; ++h) { int r0 = h * HALF + RA[0], r1 = h * HALF + RA[1]; S.a_rows(nxt, r0, r1); nvA[h][0] = (unsigned)(r0 * lda + CA[0]) * 2u; nvA[h][1] = (unsigned)(r1 * lda + CA[1]) * 2u; } }
        for (int t = 0; t < nt; t += 2) {
            const bool last = (t == nt - 2);
            const char* a1 = cA + (size_t)(t + 1) * kstep;
            const char* a2 = last ? nA : cA + (size_t)(t + 2) * kstep; const char* b2 = last ? nB0 : PG8_BPTR(cB0, cB1, t + 2);
            const char* a3 = a2 + kstep; const char* b3 = b2 + kstep;
            unsigned w0[2], w1[2];
            w0[0] = last ? nvA[0][0] : vA[0][0]; w0[1] = last ? nvA[0][1] : vA[0][1]; w1[0] = last ? nvA[1][0] : vA[1][0]; w1[1] = last ? nvA[1][1] : vA[1][1];
            if (last) E.pre(cur, wr, fr, epre);
            PG8_LDB(B0, 0, 0); PG8_SCHED; PG8_LDA(At, 0, 0); PG8_STAGE(PG8_SA(1, 1), a1, vA[1]);
            PG8_WAIT_L(8); PG8_BAR; PG8_WAIT_L(0); PG8_MMA(0, 0, At, B0); PG8_BAR; PG8_SCHED;
            PG8_LDB(B1, 0, 1); PG8_STAGE(PG8_SB(0, 0), b2, voffB);
            PG8_BAR; PG8_WAIT_L(0); PG8_MMA(0, 1, At, B1); PG8_BAR;
            PG8_LDA(At, 0, 1); PG8_STAGE(PG8_SA(0, 0), a2, w0);
            PG8_BAR; PG8_WAIT_L(0); PG8_MMA(1, 0, At, B0); PG8_BAR; PG8_SCHED;
            PG8_STAGE(PG8_SB(0, 1), b2 + hstepB, voffB);
            PG8_WAIT_V(6); PG8_BAR; PG8_MMA(1, 1, At, B1); PG8_BAR;
            PG8_LDB(B0, 1, 0); PG8_SCHED; PG8_LDA(At, 1, 0); PG8_STAGE(PG8_SA(0, 1), a2, w1);
            PG8_WAIT_L(8); PG8_BAR; PG8_WAIT_L(0); PG8_MMA(0, 0, At, B0); PG8_BAR; PG8_SCHED;
            PG8_LDB(B1, 1, 1); PG8_STAGE(PG8_SB(1, 0), b3, voffB);
            PG8_BAR; PG8_WAIT_L(0); PG8_MMA(0, 1, At, B1); PG8_BAR;
            PG8_LDA(At, 1, 1); PG8_STAGE(PG8_SA(1, 0), a3, w0);
            PG8_BAR; PG8_WAIT_L(0); PG8_MMA(1, 0, At, B0); PG8_BAR; PG8_SCHED;
            PG8_STAGE(PG8_SB(1, 1), b3 + hstepB, voffB);
            PG8_WAIT_V(6); PG8_BAR; PG8_MMA(1, 1, At, B1); PG8_BAR;
        }
        asm volatile("s_nop 7\n\ts_nop 7\n\ts_nop 3" ::: "memory");
        E(acc, cur, wr, wc, fr, fq, epre);
        if (!has_next) break;
#pragma unroll
        for (int a = 0; a < 2; ++a)
#pragma unroll
            for (int b = 0; b < 2; ++b)
#pragma unroll
                for (int m = 0; m < 4; ++m)
#pragma unroll
                    for (int n = 0; n < 2; ++n) acc[a][b][m][n] = (f32x4){0.f, 0.f, 0.f, 0.f};
        cur = nxt; cA = nA; cB0 = nB0; cB1 = nB1; ++ui;
#pragma unroll
        for (int h = 0; h < 2; ++h) { vA[h][0] = nvA[h][0]; vA[h][1] = nvA[h][1]; }
    }
    PG8_WAIT_V(0);
    if (wr == 0) PG8_BAR;
    PG8_BAR;
#undef PG8_SA
#undef PG8_SB
#undef PG8_STAGE
#undef PG8_LDA
#undef PG8_LDB
#undef PG8_MMA
#undef PG8_WAIT_V
#undef PG8_WAIT_L
#undef PG8_BAR
#undef PG8_SCHED
#undef PG8_BPTR
}
struct EpiBf16 {
    static constexpr bool PERM = true;
    bf16_t* O; int ldc; int mode;
    DI void pre(const Unit&, int, int, float (&)[8]) const {}
    DI void operator()(const f32x4 (&acc)[2][2][4][2], const Unit& u, int wr, int wc, int fr, int fq, const float (&)[8]) const {
        const int row0 = u.pm * BM + wr * 64 + fr, colt = u.pn * BM;
        bf16_t* base;
        if (mode == 0) base = O + colt;
        else { const int t0 = colt, b = tok_batch(t0), key0 = tok_key(t0); base = O + (size_t)b * 768 * KEYS + key0; }
        const int col0 = wc * 32 + 8 * fq;
#pragma unroll
        for (int ai = 0; ai < 2; ++ai)
#pragma unroll
            for (int m = 0; m < 4; ++m) { bf16_t* rowp = base + (size_t)(row0 + ai * HALF + m * 16) * ldc + col0;
#pragma unroll
                for (int bj = 0; bj < 2; ++bj) { const f32x4 v0 = acc[ai][bj][m][0], v1 = acc[ai][bj][m][1];
                    u32x4 w; w.x = cvt_pk_bf16(v0[0], v0[1]); w.y = cvt_pk_bf16(v0[2], v0[3]); w.z = cvt_pk_bf16(v1[0], v1[1]); w.w = cvt_pk_bf16(v1[2], v1[3]);
                    *(u32x4*)(rowp + bj * HALF) = w; } }
    }
};
struct DenseSched {
    static constexpr bool GATHER = false; static constexpr int NSEG = 1;
    const char* A; const char* B; int lda, ldb, nM, nN, G, c;
    DI bool next(int i, Unit& u) const { const int L = i * G + c; if (L >= nM * nN) return false;
        const int grp = L / (8 * nN), rem = L % (8 * nN), fm = grp * 8, gsz = (nM - fm) < 8 ? (nM - fm) : 8; u.pm = fm + rem % gsz; u.pn = rem / gsz; u.aux = 0; return true; }
    DI const char* a_base(const Unit& u) const { return A + (size_t)u.pm * BM * lda * 2; }
    DI const char* b_base(const Unit& u, int) const { return B + (size_t)u.pn * BM * ldb * 2; }
    DI void a_rows(const Unit&, int&, int&) const {}
};
}

DI int build_tiles(const Frame& F, int l, int* tile_bucket  , int* boff  ) {
    const unsigned* cnt = F.wsp<unsigned>(WS_SYNC) + CNT_OFF_WORDS + l * 32;
    int* ntl = boff + NBUCKET + 1;
    __syncthreads();
    if (F.tid < NBUCKET) { const int c_ = (int)cnt[F.tid]; ntl[F.tid] = (c_ + 255) >> 8; ntl[NBUCKET + F.tid] = c_; }
    __syncthreads();
    if (F.tid <= NBUCKET) { int o = 0;
#pragma unroll
        for (int k = 0; k < NBUCKET; ++k) { const int v_ = ntl[k]; o += k < F.tid ? v_ : 0; }
        boff[F.tid] = o; }
    __syncthreads();
    if (F.tid < MAXTILES) { int b = 0;
#pragma unroll
        for (int k = 1; k < NBUCKET; ++k) b += F.tid >= boff[k] ? 1 : 0;
        tile_bucket[F.tid] = b; }
    __syncthreads();
    return boff[NBUCKET];
}
DI void bucket_experts(int bucket, int& elo, int& ehi) { const int g = bucket / 6, pr = bucket % 6; const int lo = pr < 3 ? 0 : (pr < 5 ? 1 : 2), hi = pr < 3 ? pr + 1 : (pr < 5 ? pr - 1 : 3); elo = g * 4 + lo; ehi = g * 4 + hi; }

typedef short bf16x8 __attribute__((ext_vector_type(8)));
typedef float f32x16 __attribute__((ext_vector_type(16)));
#define MFMA32(a, b, c) __builtin_amdgcn_mfma_f32_32x32x16_bf16((a), (b), (c), 0, 0, 0)
constexpr float LOG2E = 1.4426950408889634f;
DI int swap23(int x) { return (x & 0x13) | ((x & 4) << 1) | ((x & 8) >> 1); }
DI unsigned cvtpk(float lo, float hi) { unsigned r; asm volatile("s_nop 0\n\tv_cvt_pk_bf16_f32 %0, %1, %2" : "=v"(r) : "v"(lo), "v"(hi)); return r; }
DI void softmax_tile(f32x16 (&st)[2], float& m, float& ls, f32x16& oa, f32x16& ob, bf16x8 (&pf)[2][2]) {
    float mx = st[0][0];
#pragma unroll
    for (int i = 1; i < 16; ++i) mx = fmaxf(mx, st[0][i]);
#pragma unroll
    for (int i = 0; i < 16; ++i) mx = fmaxf(mx, st[1][i]);
    mx = fmaxf(mx, __shfl_xor(mx, 32));
    const bool need = mx > m + 8.f;
    if (__any(need)) { const float mn = need ? mx : m; const float al = __builtin_amdgcn_exp2f(m - mn); m = mn; ls *= al; oa *= al; ob *= al; }
    float ps = 0.f;
#pragma unroll
    for (int s = 0; s < 2; ++s)
#pragma unroll
        for (int i = 0; i < 16; ++i) { const float p = __builtin_amdgcn_exp2f(st[s][i] - m); ps += p; st[s][i] = p; }
    ls += ps;
#pragma unroll
    for (int s = 0; s < 2; ++s)
#pragma unroll
        for (int k = 0; k < 2; ++k) { u32x4 w; w[0] = cvtpk(st[s][8 * k], st[s][8 * k + 1]); w[1] = cvtpk(st[s][8 * k + 2], st[s][8 * k + 3]); w[2] = cvtpk(st[s][8 * k + 4], st[s][8 * k + 5]); w[3] = cvtpk(st[s][8 * k + 6], st[s][8 * k + 7]);
            pf[s][k] = __builtin_bit_cast(bf16x8, w); }
}
template <int MODE, bool CTXQ> DI void attn_mfma_unit(const Frame& F, int l, int b, int head, int qblk) {
    const KParams Pp = F.p;
    LAS unsigned char* lds = (LAS unsigned char*)F.lds;
    LAS float* rpb = (LAS float*)(lds + 32768);
    const int lane = F.lane, r = lane & 31, h = lane >> 5, w = F.wid;
    const bf16_t* proj = F.wsp<bf16_t>(WS_BIG + BIG_PROJ);
    const int kh = MODE == 0 ? head : (MODE == 1 ? 6 + head : 10 + head / 3);
    const bf16_t* KP = F.wsp<bf16_t>(WS_BIG + BIG_KPOST) + (size_t)(b * NKH + kh) * KEYS * 64;
    const bf16_t* VT = F.wsp<bf16_t>(WS_BIG + BIG_VT) + (size_t)(b * NKH + kh) * 64 * KEYS;
    const int sq = CTXQ ? 0 : qblk * 256 + w * 32 + r;
    const int t = CTXQ ? NLAT + b * CTXL + w * 32 + r : b * SEQ + sq;
    const int qrow = sq >> 6, qcol = sq & 63;
    __syncthreads();
    if (MODE == 0 && !CTXQ) for (int i = F.tid; i < 15 * 31; i += NWG_THREADS) rpb[i] = gin(Pp, 10)[((size_t)l * 6 + head) * 465 + i] * LOG2E;
    bf16x8 qf[4];
    { const bf16_t* src = proj + (size_t)t * 1024 + ((MODE == 0 ? 0 : (MODE == 1 ? 6 : 10)) + head) * 64 + 8 * h;
#pragma unroll
      for (int ks = 0; ks < 4; ++ks) qf[ks] = *(const bf16x8*)(src + 16 * ks); }
    int ntile, rlo = 0;
    if (CTXQ) ntile = 4;
    else if (MODE == 0) { const int R0 = qblk * 4; rlo = clampi(R0 - 4, 0, 120); const int rhi = clampi(R0 + 3 - 4, 0, 120) + 7; ntile = 4 + (rhi - rlo + 1); }
    else ntile = KEYS / 64;
    const int wrow = CTXQ ? 0 : (qblk * 256 + w * 32) >> 6;
    const int r0w = clampi(wrow - 4, 0, 120), c0 = clampi(qcol - 8, 0, 48);
    const int srow = F.tid >> 3, schunk = F.tid & 7;
    const unsigned sdst = (unsigned)(srow * 128 + ((schunk ^ ((srow >> 1) & 7)) << 4));
    const bf16_t* kg = KP + (size_t)srow * 64 + schunk * 8;
    const bf16_t* vg = VT + (size_t)srow * KEYS + schunk * 8;
#define TILE_KEY0(ti) ((MODE == 0 && !CTXQ && (ti) >= 4) ? CTXL + (rlo + (ti) - 4) * 64 : (ti) * 64)
    u32x4 kreg, vreg;
    { const int k0 = TILE_KEY0(0); kreg = *(const u32x4*)(kg + (size_t)k0 * 64); vreg = *(const u32x4*)(vg + k0); }
    *(LAS u32x4*)(lds + sdst) = kreg; *(LAS u32x4*)(lds + 16384 + sdst) = vreg;
    __syncthreads();
    constexpr int NO = MODE == 1 ? 4 : 2;
    f32x16 o[NO];
#pragma unroll
    for (int i = 0; i < NO; ++i)
#pragma unroll
        for (int j = 0; j < 16; ++j) o[i][j] = 0.f;
    float m1 = -1e30f, l1 = 0.f, m2 = -1e30f, l2 = 0.f;
    const unsigned krd = (unsigned)(swap23(r) * 128), vrd = (unsigned)(r * 128);
    const int kswz = (swap23(r) >> 1) & 7, vswz = (r >> 1) & 7;
#pragma unroll 1
    for (int ti = 0; ti < ntile; ++ti) {
        const int buf = ti & 1;
        if (ti + 1 < ntile) { const int k0 = TILE_KEY0(ti + 1); kreg = *(const u32x4*)(kg + (size_t)k0 * 64); vreg = *(const u32x4*)(vg + k0); }
        bool relevant = true; int krow = 0;
        if (MODE == 0 && !CTXQ && ti >= 4) { krow = rlo + ti - 4; relevant = krow >= r0w && krow < r0w + 8; }
        if (relevant) {
            LAS unsigned char* kb = lds + buf * 8192; LAS unsigned char* vb = lds + 16384 + buf * 8192;
#pragma unroll
            for (int pass = 0; pass < (MODE == 1 ? 2 : 1); ++pass) {
                if (pass == 1) __builtin_amdgcn_sched_barrier(0);
                f32x16 st[2];
#pragma unroll
                for (int s = 0; s < 2; ++s)
#pragma unroll
                    for (int j = 0; j < 16; ++j) st[s][j] = 0.f;
#pragma unroll
                for (int kk = 0; kk < (MODE == 1 ? 2 : 4); ++kk) { const int ks = MODE == 1 ? pass * 2 + kk : kk;
#pragma unroll
                    for (int s = 0; s < 2; ++s) { const bf16x8 kf = *(const LAS bf16x8*)(kb + s * 4096 + krd + (((2 * ks + h) ^ kswz) << 4)); st[s] = MFMA32(kf, qf[ks], st[s]); } }
                if (MODE == 0 && !CTXQ && ti >= 4) { const int dr = krow - wrow + 7;
#pragma unroll
                    for (int s = 0; s < 2; ++s)
#pragma unroll
                        for (int i = 0; i < 16; ++i) { const int kc = s * 32 + 16 * (i >> 3) + 8 * h + (i & 7); const int dc = clampi(kc - qcol + 15, 0, 30); const bool valid = kc >= c0 && kc < c0 + 16;
                            st[s][i] = valid ? st[s][i] + rpb[dr * 31 + dc] : -3e38f; } }
                bf16x8 pf[2][2];
                if (pass == 0) softmax_tile(st, m1, l1, o[0], o[1], pf); else softmax_tile(st, m2, l2, o[NO - 2], o[NO - 1], pf);
#pragma unroll
                for (int ds = 0; ds < 2; ++ds)
#pragma unroll
                    for (int s = 0; s < 2; ++s)
#pragma unroll
                        for (int k = 0; k < 2; ++k) { const bf16x8 vf = *(const LAS bf16x8*)(vb + ds * 4096 + vrd + (((4 * s + 2 * k + h) ^ vswz) << 4)); o[pass * 2 + ds] = MFMA32(vf, pf[s][k], o[pass * 2 + ds]); }
            }
        }
        if (ti + 1 < ntile) { *(LAS u32x4*)(lds + (buf ^ 1) * 8192 + sdst) = kreg; *(LAS u32x4*)(lds + 16384 + (buf ^ 1) * 8192 + sdst) = vreg; }
        __syncthreads();
    }
#undef TILE_KEY0
    l1 += __shfl_xor(l1, 32); const float inv1 = 1.f / l1;
    if (MODE == 1) { l2 += __shfl_xor(l2, 32); const float inv2 = 1.f / l2;
        const float lam = F.wsp<float>(WS_LAM)[l * 2], li = F.wsp<float>(WS_LAM)[l * 2 + 1]; const float c2 = lam * inv2; float ss = 0.f;
#pragma unroll
        for (int ds = 0; ds < 2; ++ds)
#pragma unroll
            for (int i = 0; i < 16; ++i) { const float v = o[ds][i] * inv1 - c2 * o[2 + ds][i]; o[ds][i] = v; ss += v * v; }
        ss += __shfl_xor(ss, 32);
        const float rstd = rsqrtf(ss * (1.f / 64) + 1e-6f) * (1.f - li); const float* sub = gin(Pp, 15) + l * 64;
#pragma unroll
        for (int ds = 0; ds < 2; ++ds)
#pragma unroll
            for (int i = 0; i < 16; ++i) o[ds][i] = o[ds][i] * rstd * sub[32 * ds + (i & 3) + 8 * (i >> 2) + 4 * h];
    } else {
#pragma unroll
        for (int ds = 0; ds < 2; ++ds)
#pragma unroll
            for (int i = 0; i < 16; ++i) o[ds][i] *= inv1;
    }
    bf16_t* dst = F.wsp<bf16_t>(WS_ACT) + (size_t)t * D + (MODE == 0 ? 0 : (MODE == 1 ? 384 : 640)) + head * 64 + 4 * h;
#pragma unroll
    for (int ds = 0; ds < 2; ++ds)
#pragma unroll
        for (int g = 0; g < 4; ++g) { u32x2 wv; wv[0] = cvtpk(o[ds][4 * g], o[ds][4 * g + 1]); wv[1] = cvtpk(o[ds][4 * g + 2], o[ds][4 * g + 3]); *(u32x2*)(dst + 32 * ds + 8 * g) = wv; }
}
DI float xhalf_sum(float v) { const auto r = __builtin_amdgcn_permlane32_swap(__float_as_uint(v), __float_as_uint(v), false, false); return __uint_as_float(r[0]) + __uint_as_float(r[1]); }
DI unsigned exp2_acc_pack(float x0, float x1, float& ps0, float& ps1) {
    float p0, p1; unsigned pk;
    asm volatile("v_exp_f32 %0, %5\n\tv_exp_f32 %1, %6\n\tv_add_f32 %2, %0, %2\n\tv_add_f32 %3, %1, %3\n\tv_cvt_pk_bf16_f32 %4, %0, %1"
                 : "=&v"(p0), "=&v"(p1), "+v"(ps0), "+v"(ps1), "=&v"(pk) : "v"(x0), "v"(x1));
    return pk;
}
DI void exp2_pair(float x0, float x1, float& p0, float& p1) { asm volatile("v_exp_f32 %0, %2\n\tv_exp_f32 %1, %3" : "=&v"(p0), "=&v"(p1) : "v"(x0), "v"(x1)); }
DI unsigned acc_pack2(float p0, float p1, float& ps0, float& ps1) {
    unsigned pk; asm volatile("v_add_f32 %0, %3, %0\n\tv_add_f32 %1, %4, %1\n\tv_cvt_pk_bf16_f32 %2, %3, %4" : "+v"(ps0), "+v"(ps1), "=&v"(pk) : "v"(p0), "v"(p1)); return pk; }
template <int NKS> DI void attn_stream_core(LAS unsigned char* lds, const int w, const int lane, const bf16_t* KP, const bf16_t* VT, const bf16x8 (&qf)[NKS], const int kc0, f32x16 (&o)[2], float& ls) {
    const int r = lane & 31, h = lane >> 5;
    const int drow = 8 * w + (lane >> 3), dch = (lane & 7) ^ ((drow >> 1) & 7);
    const bf16_t* kg = KP + (size_t)drow * 64 + dch * 8;
    const bf16_t* vg = VT + (size_t)drow * KEYS + dch * 8;
    LAS unsigned char* kdst = lds + w * 1024; LAS unsigned char* vdst = lds + 32768 + w * 1024;
#define DMA_K(ti, off) __builtin_amdgcn_global_load_lds((const unsigned*)(kg + (size_t)(ti) * 64 * 64), (LAS unsigned*)(kdst + (off)), 16, 0, 0)
#define DMA_V(ti, off) __builtin_amdgcn_global_load_lds((const unsigned*)(vg + (size_t)(ti) * 64), (LAS unsigned*)(vdst + (off)), 16, 0, 0)
    const unsigned krd = (unsigned)(swap23(r) * 128), vrd = (unsigned)(r * 128);
    const int kswz = (swap23(r) >> 1) & 7, vswz = (r >> 1) & 7;
#define KFRAG(kb, s, ks) (*(const LAS bf16x8*)((kb) + (s) * 4096 + krd + (((kc0 + 2 * (ks) + h) ^ kswz) << 4)))
#define VFRAG(vb, ds, s, k) (*(const LAS bf16x8*)((vb) + (ds) * 4096 + vrd + (((4 * (s) + 2 * (k) + h) ^ vswz) << 4)))
#define PIN __builtin_amdgcn_sched_barrier(0)
    constexpr int ntile = KEYS / 64, nstage = ntile / 2;
    const f32x16 zero16 = {0.f, 0.f, 0.f, 0.f, 0.f, 0.f, 0.f, 0.f, 0.f, 0.f, 0.f, 0.f, 0.f, 0.f, 0.f, 0.f};
    o[0] = zero16; o[1] = zero16;
    float ps0 = 0.f, ps1 = 0.f;
    DMA_K(0, 16384 + 8192); DMA_K(1, 0); DMA_K(2, 8192); DMA_V(0, 0); DMA_V(1, 8192);
    asm volatile("s_waitcnt vmcnt(0)" ::: "memory");
    __syncthreads();
    f32x16 sa[2], sb[2];
#pragma unroll
    for (int s = 0; s < 2; ++s) { sa[s] = MFMA32(KFRAG(lds + 16384 + 8192, s, 0), qf[0], zero16);
#pragma unroll
        for (int ks = 1; ks < NKS; ++ks) sa[s] = MFMA32(KFRAG(lds + 16384 + 8192, s, ks), qf[ks], sa[s]); }
    sb[0] = zero16; sb[1] = zero16;
    bf16x8 pfh[2], vfh[2][2];
    { const bf16x8 z8 = {0, 0, 0, 0, 0, 0, 0, 0}; pfh[0] = z8; pfh[1] = z8; vfh[0][0] = z8; vfh[0][1] = z8; vfh[1][0] = z8; vfh[1][1] = z8; }
    __syncthreads();
#define STREAM_TILE(SC, SN, kbn, vb) do { \
        bf16x8 kf0[NKS], kf1[NKS], vf0[2][2]; u32x4 pw0[2], pw1[2]; \
        _Pragma("unroll") for (int ks = 0; ks < NKS; ++ks) kf0[ks] = KFRAG(kbn, 0, ks); \
        _Pragma("unroll") for (int ds = 0; ds < 2; ++ds) _Pragma("unroll") for (int k = 0; k < 2; ++k) vf0[ds][k] = VFRAG(vb, ds, 0, k); \
        PIN; \
          \
        _Pragma("unroll") for (int g = 0; g < 8; ++g) { float e0, e1; \
            exp2_pair(SC[0][2 * g], SC[0][2 * g + 1], e0, e1); PIN; \
            if (g < 4) o[g & 1] = MFMA32(vfh[g & 1][g >> 1], pfh[g >> 1], o[g & 1]); \
            else if (g - 4 < NKS) SN[0] = MFMA32(kf0[g - 4], qf[g - 4], g == 4 ? zero16 : SN[0]); \
            if (g == 4) { _Pragma("unroll") for (int ks = 0; ks < NKS; ++ks) kf1[ks] = KFRAG(kbn, 1, ks); } \
            PIN; pw0[g >> 2][g & 3] = acc_pack2(e0, e1, ps0, ps1); \
            PIN; } \
          \
        _Pragma("unroll") for (int g = 0; g < 8; ++g) { float e0, e1; \
            exp2_pair(SC[1][2 * g], SC[1][2 * g + 1], e0, e1); PIN; \
            if (g < NKS) SN[1] = MFMA32(kf1[g], qf[g], g == 0 ? zero16 : SN[1]); \
            else if (g - NKS < 4) o[(g - NKS) & 1] = MFMA32(vf0[(g - NKS) & 1][(g - NKS) >> 1], __builtin_bit_cast(bf16x8, pw0[(g - NKS) >> 1]), o[(g - NKS) & 1]); \
            if (g == 1) { _Pragma("unroll") for (int ds = 0; ds < 2; ++ds) _Pragma("unroll") for (int k = 0; k < 2; ++k) vfh[ds][k] = VFRAG(vb, ds, 1, k); } \
            PIN; pw1[g >> 2][g & 3] = acc_pack2(e0, e1, ps0, ps1); \
            PIN; } \
        pfh[0] = __builtin_bit_cast(bf16x8, pw1[0]); pfh[1] = __builtin_bit_cast(bf16x8, pw1[1]); \
    } while (0)
    if (w >= 4) __builtin_amdgcn_s_setprio(1);
#pragma unroll 1
    for (int st = 0; st < nstage; ++st) {
        const int cur = (st & 1) * 16384, nxt = 16384 - cur;
        if (st + 1 < nstage) { DMA_K(2 * st + 3, nxt); if (2 * st + 4 < ntile) DMA_K(2 * st + 4, nxt + 8192); DMA_V(2 * st + 2, nxt); DMA_V(2 * st + 3, nxt + 8192); }
        STREAM_TILE(sa, sb, lds + cur, lds + 32768 + cur);
        STREAM_TILE(sb, sa, lds + cur + 8192, lds + 32768 + cur + 8192);
        asm volatile("s_waitcnt vmcnt(0)" ::: "memory");
        __syncthreads();
    }
#undef STREAM_TILE
    __builtin_amdgcn_s_setprio(0);
#pragma unroll
    for (int g = 0; g < 4; ++g) o[g & 1] = MFMA32(vfh[g & 1][g >> 1], pfh[g >> 1], o[g & 1]);
    ls = ps0 + ps1;
#undef DMA_K
#undef DMA_V
#undef KFRAG
#undef VFRAG
#undef PIN
}
DI void store_o64(LAS unsigned char* stg, bf16_t* gbase  , const f32x16 (&o)[2], int lane) {
    const int r = lane & 31, h = lane >> 5;
#pragma unroll
    for (int ds = 0; ds < 2; ++ds)
#pragma unroll
        for (int g = 0; g < 4; ++g) { u32x2 wv; wv[0] = cvtpk(o[ds][4 * g], o[ds][4 * g + 1]); wv[1] = cvtpk(o[ds][4 * g + 2], o[ds][4 * g + 3]);
            *(LAS u32x2*)(stg + r * 128 + (((4 * ds + g) ^ (r & 7)) << 4) + 8 * h) = wv; }
#pragma unroll
    for (int i = 0; i < 4; ++i) { const int idx = lane + 64 * i, row = idx >> 3, ch = idx & 7;
        const u32x4 v = *(const LAS u32x4*)(stg + row * 128 + ((ch ^ (row & 7)) << 4));
        *(u32x4*)(gbase + (size_t)row * D + ch * 8) = v; }
}
constexpr int OSTG_OFF = 65536 + 1024 + 32768;
DI void attn_fast_unit_c(const Frame& F, int l, int b, int head, int qblk) {
    const KParams Pp = F.p;
    LAS unsigned char* lds = (LAS unsigned char*)F.lds;
    const int lane = F.lane, r = lane & 31, h = lane >> 5, w = F.wid, kh = 10 + head / 3;
    const bf16_t* KP = F.wsp<bf16_t>(WS_BIG + BIG_KPOST) + (size_t)(b * NKH + kh) * KEYS * 64;
    const bf16_t* VT = F.wsp<bf16_t>(WS_BIG + BIG_VT) + (size_t)(b * NKH + kh) * 64 * KEYS;
    const int sq = qblk * 256 + w * 32 + r, t = b * SEQ + sq, qrow = sq >> 6, qcol = sq & 63;
    bf16x8 qf[4];
    { const bf16_t* src = F.wsp<bf16_t>(WS_BIG + BIG_PROJ) + (size_t)t * 1024 + (10 + head) * 64 + 8 * h;
#pragma unroll
      for (int ks = 0; ks < 4; ++ks) qf[ks] = *(const bf16x8*)(src + 16 * ks); }
    f32x16 o[2]; float ls;
    __syncthreads();
    attn_stream_core<4>(lds, w, lane, KP, VT, qf, 0, o, ls);
    ls = xhalf_sum(ls); const float inv = 1.f / ls;
#pragma unroll
    for (int ds = 0; ds < 2; ++ds)
#pragma unroll
        for (int i = 0; i < 16; ++i) o[ds][i] *= inv;
    store_o64(lds + OSTG_OFF + w * 4096, F.wsp<bf16_t>(WS_ACT) + (size_t)(b * SEQ + qblk * 256 + w * 32) * D + 640 + head * 64, o, lane);
}
DI bool gqa_fast_ok(const Frame& F, int l, int b, int kvh) {
    const float g = F.wsp<float>(WS_LAM)[32 + l];
    const float qb = 8.f * g * 1.0001f * 0.125f * LOG2E * 1.01f;
    const float k2 = __uint_as_float(F.wsp<unsigned>(WS_SYNC)[KMAX_OFF_WORDS + l * 48 + b * NKH + 10 + kvh]);
    return qb * qb * k2 < 3600.f;
}
DI bool attn_fast_unit_b(const Frame& F, int l, int b, int head, int qblk) {
    const KParams Pp = F.p;
    LAS unsigned char* lds = (LAS unsigned char*)F.lds;
    LAS float* wmax = (LAS float*)(lds + 65536);
    LAS float* exch = (LAS float*)(lds + 65536 + 1024);
    const int lane = F.lane, r = lane & 31, h = lane >> 5, w = F.wid, stream = w >> 2, qw = w & 3, kh = 6 + head;
    const bf16_t* KP = F.wsp<bf16_t>(WS_BIG + BIG_KPOST) + (size_t)(b * NKH + kh) * KEYS * 64;
    const bf16_t* VT = F.wsp<bf16_t>(WS_BIG + BIG_VT) + (size_t)(b * NKH + kh) * 64 * KEYS;
    const float* ropeB = F.wsp<float>(WS_ROPEB);
    const bf16_t* qsrc = F.wsp<bf16_t>(WS_BIG + BIG_PROJ) + (size_t)(b * SEQ + qblk * 256 + qw * 32 + r) * 1024 + (6 + head) * 64 + stream * 32 + 8 * h;
    float qn2 = 0.f;
#pragma unroll
    for (int half = 0; half < 2; ++half) {
        const bf16_t* src = qsrc + (size_t)half * 128 * 1024;
        float na = 0.f;
#pragma unroll
        for (int ks = 0; ks < 2; ++ks) { const u32x4 wv = *(const u32x4*)(src + 16 * ks);
#pragma unroll
            for (int j = 0; j < 4; ++j) { const float x = __uint_as_float(wv[j] << 16), y = __uint_as_float(wv[j] & 0xffff0000u); na += x * x + y * y; } }
        qn2 = fmaxf(qn2, xhalf_sum(na));
    }
#pragma unroll
    for (int of = 16; of; of >>= 1) qn2 = fmaxf(qn2, __shfl_xor(qn2, of));
    __syncthreads();
    if (lane == 0) wmax[w] = qn2;
    __syncthreads();
    bool fast;
    { float q2 = wmax[0];
#pragma unroll
      for (int i = 1; i < 8; ++i) q2 = fmaxf(q2, wmax[i]);
      const float k2 = __uint_as_float(F.wsp<unsigned>(WS_SYNC)[KMAX_OFF_WORDS + l * 48 + b * NKH + kh]);
      fast = q2 * k2 < 3600.f; }
    if (!fast) return false;
    const float lam = F.wsp<float>(WS_LAM)[l * 2], li = F.wsp<float>(WS_LAM)[l * 2 + 1];
#pragma unroll 1
    for (int half = 0; half < 2; ++half) {
        f32x16 o[2]; float ls;
        if (half) __syncthreads();
        bf16x8 qh[2]; qh[0] = *(const bf16x8*)(qsrc + (size_t)half * 128 * 1024); qh[1] = *(const bf16x8*)(qsrc + (size_t)half * 128 * 1024 + 16);
        attn_stream_core<2>(lds, w, lane, KP, VT, qh, stream * 4, o, ls);
        ls = xhalf_sum(ls);
        if (stream == 1) { const float c2 = lam / ls;
#pragma unroll
            for (int ds = 0; ds < 2; ++ds)
#pragma unroll
                for (int i = 0; i < 16; ++i) exch[(qw * 32 + ds * 16 + i) * 64 + lane] = o[ds][i] * c2; }
        __syncthreads();
        if (stream == 0) { const float inv = 1.f / ls; float ss = 0.f;
#pragma unroll
            for (int ds = 0; ds < 2; ++ds)
#pragma unroll
                for (int i = 0; i < 16; ++i) { const float v = o[ds][i] * inv - exch[(qw * 32 + ds * 16 + i) * 64 + lane]; o[ds][i] = v; ss += v * v; }
            ss = xhalf_sum(ss);
            const float rstd = rsqrtf(ss * (1.f / 64) + 1e-6f) * (1.f - li); const float* sub = gin(Pp, 15) + l * 64;
#pragma unroll
            for (int ds = 0; ds < 2; ++ds)
#pragma unroll
                for (int i = 0; i < 16; ++i) o[ds][i] = o[ds][i] * rstd * sub[32 * ds + (i & 3) + 8 * (i >> 2) + 4 * h];
            store_o64(lds + OSTG_OFF + w * 4096, F.wsp<bf16_t>(WS_ACT) + (size_t)(b * SEQ + qblk * 256 + half * 128 + qw * 32) * D + 384 + head * 64, o, lane); }
    }
    return true;
}
DI void attn_na_fast_unit(const Frame& F, int l, int b, int head, int qblk) {
    const KParams Pp = F.p;
    LAS unsigned char* lds = (LAS unsigned char*)F.lds;
    LAS float* rpb = (LAS float*)(lds + 65536);
    const int lane = F.lane, r = lane & 31, h = lane >> 5, w = F.wid;
    const bf16_t* KP = F.wsp<bf16_t>(WS_BIG + BIG_KPOST) + (size_t)(b * NKH + head) * KEYS * 64;
    const bf16_t* VT = F.wsp<bf16_t>(WS_BIG + BIG_VT) + (size_t)(b * NKH + head) * 64 * KEYS;
    const int sq = qblk * 256 + w * 32 + r, qcol = sq & 63;
    __syncthreads();
    for (int i = F.tid; i < 15 * 31; i += NWG_THREADS) rpb[i] = gin(Pp, 10)[((size_t)l * 6 + head) * 465 + i] * LOG2E;
    bf16x8 qf[4];
    { const bf16_t* src = F.wsp<bf16_t>(WS_BIG + BIG_PROJ) + (size_t)(b * SEQ + sq) * 1024 + head * 64 + 8 * h;
#pragma unroll
      for (int ks = 0; ks < 4; ++ks) qf[ks] = *(const bf16x8*)(src + 16 * ks); }
    const int R0 = qblk * 4, rlo = clampi(R0 - 4, 0, 120), rhi = clampi(R0 + 3 - 4, 0, 120) + 7, ntile = 4 + (rhi - rlo + 1);
    const int wrow = (qblk * 256 + w * 32) >> 6, r0w = clampi(wrow - 4, 0, 120), c0 = clampi(qcol - 8, 0, 48);
    const int tbase = 8 * h - c0;
    const int drow = 8 * w + (lane >> 3), dch = (lane & 7) ^ ((drow >> 1) & 7);
    const bf16_t* kg = KP + (size_t)drow * 64 + dch * 8;
    const bf16_t* vg = VT + (size_t)drow * KEYS + dch * 8;
    LAS unsigned char* kdst = lds + w * 1024; LAS unsigned char* vdst = lds + 32768 + w * 1024;
#define NA_KEY0(ti) ((ti) >= 4 ? CTXL + (rlo + (ti) - 4) * 64 : (ti) * 64)
#define NA_DMA(ti) do { const int k0_ = NA_KEY0(ti); __builtin_amdgcn_global_load_lds((const unsigned*)(kg + (size_t)k0_ * 64), (LAS unsigned*)(kdst + ((ti) & 3) * 8192), 16, 0, 0); \
                         __builtin_amdgcn_global_load_lds((const unsigned*)(vg + k0_), (LAS unsigned*)(vdst + ((ti) & 3) * 8192), 16, 0, 0); } while (0)
    const unsigned krd = (unsigned)(swap23(r) * 128), vrd = (unsigned)(r * 128);
    const int kswz = (swap23(r) >> 1) & 7, vswz = (r >> 1) & 7;
    const f32x16 zero16 = {0.f, 0.f, 0.f, 0.f, 0.f, 0.f, 0.f, 0.f, 0.f, 0.f, 0.f, 0.f, 0.f, 0.f, 0.f, 0.f};
    f32x16 o[2] = {zero16, zero16};
    float ps0 = 0.f, ps1 = 0.f;
    NA_DMA(0); NA_DMA(1); NA_DMA(2);
    asm volatile("s_waitcnt vmcnt(4) lgkmcnt(0)" ::: "memory");
    __builtin_amdgcn_s_barrier(); asm volatile("" ::: "memory");
#pragma unroll 1
    for (int ti = 0; ti < ntile; ++ti) {
        if (ti + 3 < ntile) NA_DMA(ti + 3);
        const int krow = rlo + ti - 4;
        const bool relevant = ti < 4 || (krow >= r0w && krow < r0w + 8);
        if (relevant) {
            LAS unsigned char* kb = lds + (ti & 3) * 8192; LAS unsigned char* vb = lds + 32768 + (ti & 3) * 8192;
            f32x16 st[2];
#pragma unroll
            for (int s_ = 0; s_ < 2; ++s_) { st[s_] = MFMA32(*(const LAS bf16x8*)(kb + s_ * 4096 + krd + (((0 + h) ^ kswz) << 4)), qf[0], zero16);
#pragma unroll
                for (int ks = 1; ks < 4; ++ks) st[s_] = MFMA32(*(const LAS bf16x8*)(kb + s_ * 4096 + krd + (((2 * ks + h) ^ kswz) << 4)), qf[ks], st[s_]); }
            if (ti >= 4) { LAS const float* brow = rpb + (krow - wrow + 7) * 31 + (8 * h - qcol + 15);
                float bv[2][16];
#pragma unroll
                for (int s_ = 0; s_ < 2; ++s_)
#pragma unroll
                    for (int i = 0; i < 16; ++i) { bv[s_][i] = brow[s_ * 32 + 16 * (i >> 3) + (i & 7)]; }
#pragma unroll
                for (int s_ = 0; s_ < 2; ++s_)
#pragma unroll
                    for (int i = 0; i < 16; ++i) asm volatile("" : "+v"(bv[s_][i]));
#pragma unroll
                for (int s_ = 0; s_ < 2; ++s_)
#pragma unroll
                    for (int i = 0; i < 16; ++i) { const int kcc = s_ * 32 + 16 * (i >> 3) + (i & 7); const bool valid = (unsigned)(kcc + tbase) < 16u; st[s_][i] = valid ? st[s_][i] + bv[s_][i] : -3e38f; }
            } else asm volatile("s_nop 7\n\ts_nop 7" ::: "memory");
            u32x4 pw[2][2];
#pragma unroll
            for (int s_ = 0; s_ < 2; ++s_)
#pragma unroll
                for (int g = 0; g < 8; ++g) pw[s_][g >> 2][g & 3] = exp2_acc_pack(st[s_][2 * g], st[s_][2 * g + 1], ps0, ps1);
            asm volatile("s_nop 1" ::: "memory");
#pragma unroll
            for (int ds = 0; ds < 2; ++ds)
#pragma unroll
                for (int s_ = 0; s_ < 2; ++s_)
#pragma unroll
                    for (int k = 0; k < 2; ++k) o[ds] = MFMA32(*(const LAS bf16x8*)(vb + ds * 4096 + vrd + (((4 * s_ + 2 * k + h) ^ vswz) << 4)), __builtin_bit_cast(bf16x8, pw[s_][k]), o[ds]);
        }
        if (ti + 3 < ntile) asm volatile("s_waitcnt vmcnt(4) lgkmcnt(0)" ::: "memory"); else asm volatile("s_waitcnt vmcnt(0) lgkmcnt(0)" ::: "memory");
        __builtin_amdgcn_s_barrier(); asm volatile("" ::: "memory");
    }
#undef NA_DMA
#undef NA_KEY0
    const float ls = xhalf_sum(ps0 + ps1), inv = 1.f / ls;
#pragma unroll
    for (int ds = 0; ds < 2; ++ds)
#pragma unroll
        for (int i = 0; i < 16; ++i) o[ds][i] *= inv;
    store_o64(lds + OSTG_OFF + w * 4096, F.wsp<bf16_t>(WS_ACT) + (size_t)(b * SEQ + qblk * 256 + w * 32) * D + head * 64, o, lane);
}
DI bool na_fast_ok(const Frame& F, int l, int b, int head) {
    const float q2 = __uint_as_float(F.wsp<unsigned>(WS_SYNC)[QMAX_OFF_WORDS + l * 64 + b * 16 + head]), k2 = __uint_as_float(F.wsp<unsigned>(WS_SYNC)[KMAX_OFF_WORDS + l * 48 + b * NKH + head]);
    const float bm = F.wsp<float>(WS_LAM)[16 + l * 6 + head];
    return sqrtf(q2 * k2) * 1.01f + bm < 60.f;
}
DI Frame relaunder(const Frame& F0) {
    Frame F = F0; int tid = F0.tid; asm volatile("" : "+v"(tid)); asm volatile("" : "+s"(F.ws), "+s"(F.p));
    F.tid = tid; F.wid = __builtin_amdgcn_readfirstlane(tid >> 6); F.lane = tid & 63; return F;
}
DI void phase_attn_mfma(const Frame& F0, int l) {
    unsigned slow_b = 0u, slow_c = 0u;
    { const Frame F = relaunder(F0); int it = 0;
      for (int u = F.wg; u < 512; u += F.nwg, ++it) { const int xs = u & 7, idx = u >> 3, pr = xs * 2 + (idx >> 5); if (!attn_fast_unit_b(F, l, pr >> 2, pr & 3, idx & 31)) slow_b |= 1u << it; } }
    if (slow_b) { const Frame F = relaunder(F0); int it = 0;
      for (int u = F.wg; u < 512; u += F.nwg, ++it) { const int xs = u & 7, idx = u >> 3, pr = xs * 2 + (idx >> 5); if (slow_b >> it & 1u) attn_mfma_unit<1, false>(F, l, pr >> 2, pr & 3, idx & 31); } }
    { const Frame F = relaunder(F0); int it = 0;
      const bool okc = gqa_fast_ok(F, l, (F.wg & 7) >> 1, F.wg & 1);
      for (int u = F.wg; u < 768; u += F.nwg, ++it) { const int xs = u & 7, idx = u >> 3; if ((F.nwg & 7) == 0 ? okc : gqa_fast_ok(F, l, xs >> 1, xs & 1)) attn_fast_unit_c(F, l, xs >> 1, (xs & 1) * 3 + (idx >> 5), idx & 31); else slow_c |= 1u << it; } }
    if (slow_c) { const Frame F = relaunder(F0); int it = 0;
      for (int u = F.wg; u < 768; u += F.nwg, ++it) { const int xs = u & 7, idx = u >> 3; if (slow_c >> it & 1u) attn_mfma_unit<2, false>(F, l, xs >> 1, (xs & 1) * 3 + (idx >> 5), idx & 31); } }
    unsigned slow_a = 0u;
    { const Frame F = relaunder(F0); int it = 0;
      unsigned oka = 0u;
      { int j = 0; for (int u = F.wg; u < 768 && j < 8; u += F.nwg, ++j) { const int pr = (u & 7) * 3 + ((u >> 3) >> 5); oka |= (na_fast_ok(F, l, pr / 6, pr % 6) ? 1u : 0u) << j; } }
      for (int u = F.wg; u < 768; u += F.nwg, ++it) { const int xs = u & 7, idx = u >> 3, pr = xs * 3 + (idx >> 5); if (it < 8 ? (oka >> it & 1u) != 0u : na_fast_ok(F, l, pr / 6, pr % 6)) attn_na_fast_unit(F, l, pr / 6, pr % 6, idx & 31); else slow_a |= 1u << it; } }
    if (slow_a) { const Frame F = relaunder(F0); int it = 0;
      for (int u = F.wg; u < 768; u += F.nwg, ++it) { const int xs = u & 7, idx = u >> 3, pr = xs * 3 + (idx >> 5); if (slow_a >> it & 1u) attn_mfma_unit<0, false>(F, l, pr / 6, pr % 6, idx & 31); } }
    if (l == 0) {
        { const Frame F = relaunder(F0); for (int u = F.wg; u < 24; u += F.nwg) attn_mfma_unit<0, true>(F, l, u / 6, u % 6, 0); }
        { const Frame F = relaunder(F0); for (int u = F.wg - 24; u >= 0 && u < 16; u += F.nwg) attn_mfma_unit<1, true>(F, l, u / 4, u % 4, 0); }
        { const Frame F = relaunder(F0); for (int u = F.wg - 40; u >= 0 && u < 24; u += F.nwg) attn_mfma_unit<2, true>(F, l, u / 6, u % 6, 0); }
    }
}

DI void phase_norm2(const Frame& F, int l) {
    const KParams Pp = F.p;
    const int M = l == 0 ? NT : NLAT;
    float* rw = F.lds;
    __syncthreads();
    for (int i = F.tid; i < 1024 * 20 / 4; i += NWG_THREADS) *(f32x4*)(rw + 4 * i) = *(const f32x4*)(F.wsp<float>(WS_RWT) + (size_t)l * 20480 + 4 * i);
    __syncthreads();
    int* sp_tok = F.wsp<int>(WS_SPTOK); float* sp_w = F.wsp<float>(WS_SPW);
    const float* gain = gin(Pp, 7) + l * D;
    bf16_t* act = F.wsp<bf16_t>(WS_ACT);
    const bf16_t* tmp16 = F.wsp<bf16_t>(WS_BIG);
    unsigned* cnt = F.wsp<unsigned>(WS_SYNC) + CNT_OFF_WORDS + l * 32;
    int4* tokinfo = F.wsp<int4>(WS_TOKINFO);
    const int stride = F.nwg * 8;
    float* lgs = rw + 20 * 1024 + F.wid * 1280;
    int nrow = 0;
    for (int t0 = 2 * (F.wg * 8 + F.wid); t0 < M; t0 += 2 * stride) {
      const int tt[2] = {t0, t0 + 1};
      const float* m = mod_row(F, l, tok_modrow(t0));
      f32x4 g1v[4], rxf[2][4]; u32x2 rxb[2][4], rtr[2][4];
#pragma unroll
      for (int i = 0; i < 4; ++i) g1v[i] = *(const f32x4*)(m + 2048 + (i * 64 + F.lane) * 4);
#pragma unroll
      for (int r = 0; r < 2; ++r) { const int t = tt[r]; const float* xs = xin_row(F, t); const bf16_t* xq = xres_row(F, t); const bf16_t* tr = tmp16 + (size_t)t * D;
#pragma unroll
          for (int i = 0; i < 4; ++i) { const int k = (i * 64 + F.lane) * 4;
              if (l == 0) rxf[r][i] = *(const f32x4*)(xs + k); else rxb[r][i] = *(const u32x2*)(xq + k);
              rtr[r][i] = *(const u32x2*)(tr + k); } }
      f32x4 gsv[4], shv[4];
#pragma unroll
      for (int i = 0; i < 4; ++i) { const int k = (i * 64 + F.lane) * 4; gsv[i] = *(const f32x4*)(gain + k); shv[i] = *(const f32x4*)(m + 3072 + k); }
      f32x4 scv[4];
#pragma unroll
      for (int i = 0; i < 4; ++i) scv[i] = *(const f32x4*)(m + 4096 + (i * 64 + F.lane) * 4);
      f32x4 vv[2][4]; float ssq[2] = {0.f, 0.f};
#pragma unroll
      for (int r = 0; r < 2; ++r) { bf16_t* xd = xres_row(F, tt[r]);
#pragma unroll
          for (int i = 0; i < 4; ++i) { const int k = (i * 64 + F.lane) * 4;
              const f32x4 xv = l == 0 ? rxf[r][i] : bf4_to_f32(rxb[r][i]);
              vv[r][i] = xv + g1v[i] * bf4_to_f32(rtr[r][i]);
              { u32x2 xo; xo[0] = cvtpk_rne(vv[r][i][0], vv[r][i][1]); xo[1] = cvtpk_rne(vv[r][i][2], vv[r][i][3]); *(u32x2*)(xd + k) = xo; }
              ssq[r] += vv[r][i][0] * vv[r][i][0] + vv[r][i][1] * vv[r][i][1] + vv[r][i][2] * vv[r][i][2] + vv[r][i][3] * vv[r][i][3]; } }
#pragma unroll
      for (int i = 0; i < 4; ++i) gsv[i] = gsv[i] * (scv[i] + 1.f);
      ssq[0] = wave_sum(ssq[0]); ssq[1] = wave_sum(ssq[1]);
#pragma unroll
      for (int r = 0; r < 2; ++r) {
        const int t = tt[r];
        const float rstd = rsqrtf(ssq[r] * (1.f / D) + 1e-6f);
        float lg[20];
        f32x2 lgp[20];
#pragma unroll
        for (int j = 0; j < 20; ++j) lgp[j] = (f32x2){0.f, 0.f};
#pragma unroll
        for (int i = 0; i < 4; ++i) { const int k = (i * 64 + F.lane) * 4;
            const f32x4 h = vv[r][i] * rstd * gsv[i] + shv[i];
            u32x2 o; o[0] = cvtpk_rne(h[0], h[1]); o[1] = cvtpk_rne(h[2], h[3]);
            *(u32x2*)(act + (size_t)t * D + k) = o;
            const f32x2 h01 = {h[0], h[1]}, h23 = {h[2], h[3]};
#pragma unroll
            for (int j = 0; j < 20; ++j) { const f32x4 w = *(const f32x4*)(rw + j * 1024 + k);
                lgp[j] = __builtin_elementwise_fma(h01, (f32x2){w[0], w[1]}, lgp[j]); lgp[j] = __builtin_elementwise_fma(h23, (f32x2){w[2], w[3]}, lgp[j]); }
            __builtin_amdgcn_sched_barrier(0); }
#pragma unroll
        for (int j = 0; j < 20; ++j) lg[j] = lgp[j][0] + lgp[j][1];
        float ra[10], rb[5];
#pragma unroll
        for (int j = 0; j < 10; ++j) ra[j] = swap32_sum(lg[j], lg[j + 10]);
#pragma unroll
        for (int j = 0; j < 5; ++j) rb[j] = dpp_row_sum(swap16_sum(ra[j], ra[j + 5]));
        if ((F.lane & 15) == 0) {
#pragma unroll
            for (int j = 0; j < 5; ++j) lgs[nrow * 20 + 5 * (F.lane >> 4) + j] = rb[j]; }
        ++nrow;
      }
    }
    if (F.lane < nrow) {
        const int t = 2 * (F.wg * 8 + F.wid) + (F.lane >> 1) * 2 * stride + (F.lane & 1);
        float lg[20];
#pragma unroll
        for (int q = 0; q < 5; ++q) { const f32x4 v = *(const f32x4*)(lgs + F.lane * 20 + 4 * q); lg[4 * q] = v[0]; lg[4 * q + 1] = v[1]; lg[4 * q + 2] = v[2]; lg[4 * q + 3] = v[3]; }
        {
            float bge[20];
#pragma unroll
            for (int j = 0; j < 4; ++j) bge[j] = gin(Pp, 19)[l * 4 + j];
#pragma unroll
            for (int j = 0; j < 16; ++j) bge[4 + j] = gin(Pp, 21)[l * 16 + j];
#pragma unroll
            for (int j = 0; j < 20; ++j) asm volatile("" : "+v"(bge[j]));
            float gl[4];
#pragma unroll
            for (int j = 0; j < 4; ++j) gl[j] = lg[j] + bge[j];
            int gs = 0; float gmax = gl[0];
#pragma unroll
            for (int j = 1; j < 4; ++j) if (gl[j] > gmax) { gmax = gl[j]; gs = j; }
            float den = 0.f;
#pragma unroll
            for (int j = 0; j < 4; ++j) den += expf(gl[j] - gmax);
            const float pg = 1.f / den;
            float ev[4];
#pragma unroll
            for (int j = 0; j < 4; ++j) { float x = 0.f;
#pragma unroll
                for (int g2 = 0; g2 < 4; ++g2) x = (g2 == gs) ? lg[4 + g2 * 4 + j] + bge[4 + g2 * 4 + j] : x;
                ev[j] = x; }
            int i1 = 0; float v1 = ev[0];
#pragma unroll
            for (int j = 1; j < 4; ++j) if (ev[j] > v1) { v1 = ev[j]; i1 = j; }
            int i2 = -1; float v2 = 0.f;
#pragma unroll
            for (int j = 0; j < 4; ++j) if (j != i1 && (i2 < 0 || ev[j] > v2)) { v2 = ev[j]; i2 = j; }
            const float w1 = 1.f / (1.f + expf(v2 - v1)), w2 = 1.f - w1;
            const int lo = i1 < i2 ? i1 : i2, hi = i1 < i2 ? i2 : i1;
            const float wlo = (i1 < i2 ? w1 : w2) * pg, whi = (i1 < i2 ? w2 : w1) * pg;
            const int pr = lo == 0 ? hi - 1 : (lo == 1 ? hi + 1 : 5);
            const int bucket = gs * 6 + pr;
            const unsigned rank = atomicAdd(&cnt[bucket], 1u);
            tokinfo[t] = make_int4(bucket, (int)rank, __float_as_int(wlo), __float_as_int(whi));
            { const size_t sp = (size_t)bucket * SPCAP + rank; sp_tok[sp] = t; *(float2*)(sp_w + 2 * sp) = make_float2(wlo, whi); }
        }
    }
}

DI void phase_scatter(const Frame& F, int l) {
    const int M = l == 0 ? NT : NLAT;
    int* tile_bucket = (int*)F.lds; int* boff = tile_bucket + MAXTILES;
    build_tiles(F, l, tile_bucket, boff);
    const int4* tokinfo = F.wsp<int4>(WS_TOKINFO);
    int* slot_tok = F.wsp<int>(WS_SLOTTOK); int* tok_slot = F.wsp<int>(WS_TOKSLOT); float* slot_w = F.wsp<float>(WS_SLOTW);
    for (int t = F.wg * NWG_THREADS + F.tid; t < M; t += F.nwg * NWG_THREADS) {
        const int4 ti = tokinfo[t];
        const int slot = boff[ti.x] * 256 + ti.y;
        slot_tok[slot] = t; tok_slot[t] = slot; slot_w[slot * 2] = __int_as_float(ti.z); slot_w[slot * 2 + 1] = __int_as_float(ti.w);
    }
}

constexpr int TAB_OFF = pg8::STAGE_BYTES;
struct InSched {
    static constexpr bool GATHER = false; static constexpr int NSEG = 1;
    const char* act; const char* W; int G, c;
    DI bool next(int i, pg8::Unit& u) const { const int L = i * G + c; if (L >= 1320) return false;
        const int grp = L / 80, rem = L % 80, fm = grp * 8, gsz = (132 - fm) < 8 ? (132 - fm) : 8, panel = fm + rem % gsz, slot = rem / gsz;
        if (slot < 7) { u.pm = panel; u.pn = slot; u.aux = 0; } else { u.pm = slot - 7; u.pn = panel; u.aux = 1; }
        return true; }
    DI const char* a_base(const pg8::Unit& u) const { return u.aux == 0 ? act + (size_t)u.pm * 256 * D * 2 : W + (size_t)(QKW + u.pm * 256) * D * 2; }
    DI const char* b_base(const pg8::Unit& u, int) const { return u.aux == 0 ? W + (size_t)u.pn * 256 * D * 2 : act + (size_t)u.pn * 256 * D * 2; }
    DI void a_rows(const pg8::Unit&, int&, int&) const {}
};
struct InEpi {
    static constexpr bool PERM = true;
    bf16_t* qpost; bf16_t* kpost; bf16_t* VT; LAS const float* ropeB; LAS const float* ropeC; LAS const float* qn; LAS const float* kn; LAS unsigned* lmax;
    DI void pre(const pg8::Unit&, int, int, float (&)[8]) const {}
    DI void operator()(const f32x4 (&acc)[2][2][4][2], const pg8::Unit& u, int wr, int wc, int fr, int fq, const float (&epre)[8]) const {
        if (u.aux != 0) { pg8::EpiBf16 e{VT, KEYS, 1}; e(acc, u, wr, wc, fr, fq, epre); return; }
        const int hs = 4 * u.pn + wc;
        const bool isq = hs < 6 || (hs >= 12 && hs < 16) || (hs >= 20 && hs < 26), isb = hs >= 12 && hs < 20, isc = hs >= 20;
        const int hh = hs < 6 ? hs : (hs < 12 ? hs - 6 : (hs < 16 ? hs - 12 : (hs < 20 ? hs - 16 : (hs < 26 ? hs - 20 : hs - 26))));
        const int hidx = (isb ? 6 : (isc ? 10 : 0)) + hh;
        const int t0 = u.pm * 256; const bool lat = t0 < NLAT; const int b = lat ? (t0 >> 13) : ((t0 - NLAT) >> 8);
        const int elo = isb ? 32 * (fq >> 1) + 8 * (fq & 1) : 8 * fq, ehi = isb ? elo + 16 : elo + 32;
        f32x4 glo[2], ghi[2];
        if (isc) { LAS const float* g = isq ? qn : kn; glo[0] = *(LAS const f32x4*)(g + elo); glo[1] = *(LAS const f32x4*)(g + elo + 4); ghi[0] = *(LAS const f32x4*)(g + ehi); ghi[1] = *(LAS const f32x4*)(g + ehi + 4); }
        const float qscale = (isb ? 0.17677669529663689f : 0.125f) * LOG2E;
        float kmx = 0.f;
#pragma unroll
        for (int ai = 0; ai < 2; ++ai)
#pragma unroll
            for (int m = 0; m < 4; ++m) {
                const int t = t0 + 128 * ai + 64 * wr + 16 * m + fr, sp = t & (SEQ - 1), grow = sp >> 6, gcol = sp & 63;
                f32x4 lo[2] = {acc[ai][0][m][0], acc[ai][0][m][1]}, hi[2] = {acc[ai][1][m][0], acc[ai][1][m][1]};
                if (isc) { float ss = 0.f;
#pragma unroll
                    for (int q = 0; q < 2; ++q) ss += lo[q][0] * lo[q][0] + lo[q][1] * lo[q][1] + lo[q][2] * lo[q][2] + lo[q][3] * lo[q][3] + hi[q][0] * hi[q][0] + hi[q][1] * hi[q][1] + hi[q][2] * hi[q][2] + hi[q][3] * hi[q][3];
                    ss = swap16_sum(ss, ss); ss = swap32_sum(ss, ss);
                    const float rstd = rsqrtf(ss * (1.f / 64) + 1e-6f);
#pragma unroll
                    for (int q = 0; q < 2; ++q) { lo[q] = lo[q] * rstd * glo[q]; hi[q] = hi[q] * rstd * ghi[q]; } }
                if ((isb || isc) && lat) {
                    LAS const float* tab = isb ? ropeB + (((fq & 1) == 0 ? grow : gcol) * 8) * 2 : ropeC + ((fq < 2 ? grow : gcol) * 16 + 8 * (fq & 1)) * 2;
#pragma unroll
                    for (int q = 0; q < 2; ++q) { const f32x4 c0 = *(LAS const f32x4*)(tab + 8 * q), c1 = *(LAS const f32x4*)(tab + 8 * q + 4);
                        const f32x4 x1 = lo[q], x2 = hi[q];
                        lo[q] = (f32x4){x1[0] * c0[0] - x2[0] * c0[1], x1[1] * c0[2] - x2[1] * c0[3], x1[2] * c1[0] - x2[2] * c1[1], x1[3] * c1[2] - x2[3] * c1[3]};
                        hi[q] = (f32x4){x2[0] * c0[0] + x1[0] * c0[1], x2[1] * c0[2] + x1[1] * c0[3], x2[2] * c1[0] + x1[2] * c1[1], x2[3] * c1[2] + x1[3] * c1[3]}; } }
                if (isq) {
#pragma unroll
                    for (int q = 0; q < 2; ++q) { lo[q] = lo[q] * qscale; hi[q] = hi[q] * qscale; } }
                u32x4 wl, wh;
                wl[0] = cvtpk(lo[0][0], lo[0][1]); wl[1] = cvtpk(lo[0][2], lo[0][3]); wl[2] = cvtpk(lo[1][0], lo[1][1]); wl[3] = cvtpk(lo[1][2], lo[1][3]);
                wh[0] = cvtpk(hi[0][0], hi[0][1]); wh[1] = cvtpk(hi[0][2], hi[0][3]); wh[2] = cvtpk(hi[1][0], hi[1][1]); wh[3] = cvtpk(hi[1][2], hi[1][3]);
                bf16_t* dst;
                if (isq) dst = qpost + (size_t)t * 1024 + hidx * 64;
                else { const int key = lat ? CTXL + sp : ((t - NLAT) & (CTXL - 1)); dst = kpost + ((size_t)(b * NKH + hidx) * KEYS + key) * 64; }
                *(u32x4*)(dst + elo) = wl; *(u32x4*)(dst + ehi) = wh;
                { float n2 = 0.f;
#pragma unroll
                    for (int q = 0; q < 4; ++q) { const float a0 = __uint_as_float(wl[q] << 16), a1 = __uint_as_float(wl[q] & 0xffff0000u), b0 = __uint_as_float(wh[q] << 16), b1 = __uint_as_float(wh[q] & 0xffff0000u); n2 += a0 * a0 + a1 * a1 + b0 * b0 + b1 * b1; }
                    n2 = swap16_sum(n2, n2);
                    if (!isb) n2 = swap32_sum(n2, n2);
                    kmx = fmaxf(kmx, n2); }
            }
        {
#pragma unroll
            for (int of = 32; of; of >>= 1) kmx = fmaxf(kmx, __shfl_xor(kmx, of));
            if (fr == 0 && fq == 0) __hip_atomic_fetch_max(isq ? lmax + 48 + b * 16 + hidx : lmax + b * NKH + hidx, __float_as_uint(kmx), __ATOMIC_RELAXED, __HIP_MEMORY_SCOPE_WORKGROUP); }
    }
};
DI void phase_gemm_in_mfma(const Frame& F, int l) {
    const char* act = (const char*)F.wsp<bf16_t>(WS_ACT);
    const char* W = (const char*)(F.wsp<bf16_t>(WS_WINT) + (size_t)l * INW * D);
    InSched S{act, W, F.nwg, F.wg};
    LAS float* rl = (LAS float*)((LAS char*)F.lds + TAB_OFF);
    __syncthreads();
    static_assert(WS_ROPEC == WS_ROPEB + 2048 * 4, "rope tables contiguous");
    for (int i = F.tid; i < (2048 + 4096) / 4; i += NWG_THREADS) *(LAS f32x4*)(rl + 4 * i) = *(const f32x4*)(F.wsp<float>(WS_ROPEB) + 4 * i);
    if (F.tid < 128) rl[6144 + 112 + F.tid] = F.tid < 64 ? gin(F.p, 16)[l * 64 + F.tid] : gin(F.p, 17)[l * 64 + F.tid - 64];
    LAS unsigned* lmax = (LAS unsigned*)(rl + 6144);
    if (F.tid < 112) lmax[F.tid] = 0u;
    __syncthreads();
    InEpi E{F.wsp<bf16_t>(WS_BIG + BIG_PROJ), F.wsp<bf16_t>(WS_BIG + BIG_KPOST), F.wsp<bf16_t>(WS_BIG + BIG_VT), rl, rl + 2048, rl + 6144 + 112, rl + 6144 + 112 + 64, lmax};
    pg8::gemm_phase((LAS unsigned char*)F.lds, D, D, D, S, E);
    __syncthreads();
    if (F.tid < 112) { const unsigned v = lmax[F.tid];
        if (v != 0u) atomicMax(F.tid < 48 ? F.wsp<unsigned>(WS_SYNC) + KMAX_OFF_WORDS + l * 48 + F.tid : F.wsp<unsigned>(WS_SYNC) + QMAX_OFF_WORDS + l * 64 + (F.tid - 48), v); }
}
DI void phase_gemm_out_mfma(const Frame& F, int l) {
    const int M = l == 0 ? NT : NLAT;
    pg8::DenseSched S{(const char*)F.wsp<bf16_t>(WS_ACT), (const char*)(F.wsp<bf16_t>(WS_WOUTT) + (size_t)l * D * D), D, D, M / 256, 4, F.nwg, F.wg};
    pg8::EpiBf16 E{F.wsp<bf16_t>(WS_BIG), D, 0};
    pg8::gemm_phase((LAS unsigned char*)F.lds, D, D, D, S, E);
}
struct EpiMoe1 {
    static constexpr bool PERM = true;
    bf16_t* hid; const float* sp_w; const int* boff;
    DI void pre(const pg8::Unit& u, int wr, int fr, float (&epre)[8]) const {
        const int b = u.aux, base = (u.pm - boff[b]) * 256 + wr * 64 + fr, cm = boff[NBUCKET + 1 + NBUCKET + b] - 1, j = u.pn >> 2; const float* spw = sp_w + (size_t)b * SPCAP * 2;
#pragma unroll
        for (int ai = 0; ai < 2; ++ai)
#pragma unroll
            for (int m = 0; m < 4; ++m) { const int i_ = base + ai * 128 + m * 16; const float w_ = spw[(size_t)(i_ < cm ? i_ : cm) * 2 + j]; epre[ai * 4 + m] = i_ <= cm ? w_ : 0.f; } }
    DI void operator()(const f32x4 (&acc)[2][2][4][2], const pg8::Unit& u, int wr, int wc, int fr, int fq, const float (&epre)[8]) const {
        const int row0 = u.pm * 256 + wr * 64 + fr, j = u.pn >> 2, colb = j * 512 + (u.pn & 3) * 128 + 16 * wc + 4 * fq;
#pragma unroll
        for (int ai = 0; ai < 2; ++ai)
#pragma unroll
            for (int m = 0; m < 4; ++m) { const int slot = row0 + ai * 128 + m * 16; const float w = epre[ai * 4 + m];
#pragma unroll
                for (int bj = 0; bj < 2; ++bj) { const f32x4 v0 = acc[ai][bj][m][0], v1 = acc[ai][bj][m][1];
                    const float h0 = v0[0] * __builtin_amdgcn_rcpf(1.f + __builtin_amdgcn_exp2f(-v0[0] * LOG2E)) * v0[1] * w, h1 = v0[2] * __builtin_amdgcn_rcpf(1.f + __builtin_amdgcn_exp2f(-v0[2] * LOG2E)) * v0[3] * w;
                    const float h2 = v1[0] * __builtin_amdgcn_rcpf(1.f + __builtin_amdgcn_exp2f(-v1[0] * LOG2E)) * v1[1] * w, h3 = v1[2] * __builtin_amdgcn_rcpf(1.f + __builtin_amdgcn_exp2f(-v1[2] * LOG2E)) * v1[3] * w;
                    u32x2 o; o[0] = pg8::cvt_pk_bf16(h0, h1); o[1] = pg8::cvt_pk_bf16(h2, h3);
                    *(u32x2*)(hid + (size_t)slot * D + colb + 64 * bj) = o; } }
    }
};
struct Moe1Sched {
    static constexpr bool GATHER = true; static constexpr int NSEG = 1;
    const char* act; const char* W; const int* sp_tok; const int* tile_bucket; const int* boff; int ntiles, G, c;
    DI bool next(int i, pg8::Unit& u) const { const int U = ntiles * 8, x = c & 7, nper = (G - 1 - x) / 8 + 1, lo = (x * U) >> 3, hi = ((x + 1) * U) >> 3, j = lo + i * nper + (c >> 3);
        if (j >= hi) return false; u.pm = j >> 3; u.pn = j & 7; u.aux = tile_bucket[u.pm]; return true; }
    DI const char* a_base(const pg8::Unit&) const { return act; }
    DI const char* b_base(const pg8::Unit& u, int) const { int elo, ehi; bucket_experts(u.aux, elo, ehi); const int e = u.pn < 4 ? elo : ehi; return W + ((size_t)e * 1024 + (u.pn & 3) * 256) * D * 2; }
    DI void a_rows(const pg8::Unit& u, int& r0, int& r1) const { const int b = u.aux, base = (u.pm - boff[b]) * 256, cm = boff[NBUCKET + 1 + NBUCKET + b] - 1; const int* st = sp_tok + (size_t)b * SPCAP;
        const int i0 = base + r0, i1 = base + r1; r0 = st[i0 < cm ? i0 : cm]; r1 = st[i1 < cm ? i1 : cm]; }
};
struct Moe2Sched {
    static constexpr bool GATHER = false; static constexpr int NSEG = 2;
    const char* hid; const char* W; const int* tile_bucket; int ntiles, G, c;
    DI bool next(int i, pg8::Unit& u) const { const int U = ntiles * 4, x = c & 7, nper = (G - 1 - x) / 8 + 1, lo = (x * U) >> 3, hi = ((x + 1) * U) >> 3, j = lo + i * nper + (c >> 3);
        if (j >= hi) return false; u.pm = j >> 2; u.pn = j & 3; u.aux = tile_bucket[u.pm]; return true; }
    DI const char* a_base(const pg8::Unit& u) const { return hid + (size_t)u.pm * 256 * D * 2; }
    DI const char* b_base(const pg8::Unit& u, int seg) const { int elo, ehi; bucket_experts(u.aux, elo, ehi); return W + ((size_t)(seg == 0 ? elo : ehi) * 1024 + u.pn * 256) * 512 * 2; }
    DI void a_rows(const pg8::Unit&, int&, int&) const {}
};
DI void phase_gemm1_mfma(const Frame& F, int l) {
    int* tile_bucket = (int*)((char*)F.lds + TAB_OFF); int* boff = tile_bucket + MAXTILES;
    const int ntiles = build_tiles(F, l, tile_bucket, boff);
    Moe1Sched S{(const char*)F.wsp<bf16_t>(WS_ACT), (const char*)(F.wsp<bf16_t>(WS_WGU) + (size_t)l * 16 * 1024 * 1024), F.wsp<int>(WS_SPTOK), tile_bucket, boff, ntiles, F.nwg, F.wg};
    EpiMoe1 E{F.wsp<bf16_t>(WS_BIG), F.wsp<float>(WS_SPW), boff};
    pg8::gemm_phase((LAS unsigned char*)F.lds, D, D, D, S, E);
}
DI void phase_gemm2_mfma(const Frame& F, int l) {
    int* tile_bucket = (int*)((char*)F.lds + TAB_OFF); int* boff = tile_bucket + MAXTILES;
    const int ntiles = build_tiles(F, l, tile_bucket, boff);
    Moe2Sched S{(const char*)F.wsp<bf16_t>(WS_BIG), (const char*)(F.wsp<bf16_t>(WS_WDT) + (size_t)l * 16 * 1024 * 512), tile_bucket, ntiles, F.nwg, F.wg};
    pg8::EpiBf16 E{F.wsp<bf16_t>(WS_BIG + BIG_Y16), D, 0};
    pg8::gemm_phase((LAS unsigned char*)F.lds, D, D, 512, S, E);
}

DI void phase_final(const Frame& F) {
    const KParams Pp = F.p;
    const bf16_t* y16 = F.wsp<bf16_t>(WS_BIG + BIG_Y16); const int4* tokinfo = F.wsp<int4>(WS_TOKINFO);
    int* tile_bucket = (int*)F.lds; int* boff = tile_bucket + MAXTILES;
    build_tiles(F, 1, tile_bucket, boff);
    const int stride = F.nwg * 8;
    u32x2 rxb[2][4], ryb[2][4]; int nsl[2] = {0, 0};
#pragma unroll
    for (int r = 0; r < 2; ++r)
#pragma unroll
        for (int i = 0; i < 4; ++i) { rxb[r][i] = (u32x2){0u, 0u}; ryb[r][i] = (u32x2){0u, 0u}; }
#define FN_SLOTS(T0) if ((T0) < NLAT) { const int2 i0_ = *(const int2*)(tokinfo + (T0)), i1_ = *(const int2*)(tokinfo + (T0) + 1); nsl[0] = boff[i0_.x] * 256 + i0_.y; nsl[1] = boff[i1_.x] * 256 + i1_.y; }
#define FN_ISSUE(T0) if ((T0) < NLAT) { \
        _Pragma("unroll") for (int r = 0; r < 2; ++r) { const bf16_t* s_ = xres_row(F, (T0) + r); const bf16_t* yr_ = y16 + (size_t)nsl[r] * D; \
            _Pragma("unroll") for (int i = 0; i < 4; ++i) { const int k = (i * 64 + F.lane) * 4; rxb[r][i] = *(const u32x2*)(s_ + k); ryb[r][i] = *(const u32x2*)(yr_ + k); } } }
    const int tfirst = 2 * (F.wg * 8 + F.wid);
    FN_SLOTS(tfirst)
    FN_ISSUE(tfirst)
    FN_SLOTS(tfirst + 2 * stride)
    f32x4 gf[4];
#pragma unroll
    for (int i = 0; i < 4; ++i) gf[i] = *(const f32x4*)(gin(Pp, 25) + (i * 64 + F.lane) * 4);
    for (int t0 = tfirst; t0 < NLAT; t0 += 2 * stride) {
        const int tt[2] = {t0, t0 + 1};
        const float* g2 = mod_row(F, 1, t0 >> 13) + 5120;
        f32x4 g2v[4];
#pragma unroll
        for (int i = 0; i < 4; ++i) g2v[i] = *(const f32x4*)(g2 + (i * 64 + F.lane) * 4);
        f32x4 v[2][4]; float ss[2] = {0.f, 0.f};
#pragma unroll
        for (int r = 0; r < 2; ++r)
#pragma unroll
            for (int i = 0; i < 4; ++i) { v[r][i] = bf4_to_f32(rxb[r][i]) + g2v[i] * bf4_to_f32(ryb[r][i]);
                ss[r] += v[r][i][0] * v[r][i][0] + v[r][i][1] * v[r][i][1] + v[r][i][2] * v[r][i][2] + v[r][i][3] * v[r][i][3]; }
        __builtin_amdgcn_sched_barrier(0);
        FN_ISSUE(t0 + 2 * stride)
        FN_SLOTS(t0 + 4 * stride)
        __builtin_amdgcn_sched_barrier(0);
        ss[0] = wave_sum(ss[0]); ss[1] = wave_sum(ss[1]);
#pragma unroll
        for (int r = 0; r < 2; ++r) { float* s = gout(Pp) + (size_t)tt[r] * D;
            const float rstd = rsqrtf(ss[r] * (1.f / D) + 1e-6f);
#pragma unroll
            for (int i = 0; i < 4; ++i) { const int k = (i * 64 + F.lane) * 4; *(f32x4*)(s + k) = v[r][i] * rstd * gf[i]; } }
    }
#undef FN_ISSUE
#undef FN_SLOTS
}

template <int PH> DI void run_phase(unsigned char* lds_raw, int l) {
    KParams kp = (KParams)__builtin_amdgcn_kernarg_segment_ptr();
    asm volatile("" : "+s"(kp));
    GAS unsigned char* ws = (GAS unsigned char*)kp->ws;
    asm volatile("" : "+s"(ws));
    int tid = threadIdx.x; asm volatile("" : "+v"(tid));
    Frame F; F.p = kp; F.ws = ws; F.lds = (float*)(lds_raw + 16); F.tid = tid; F.wid = __builtin_amdgcn_readfirstlane(tid >> 6); F.lane = tid & 63; F.wg = blockIdx.x; F.nwg = gridDim.x;
    if (PH == 0) phase_prologue(F);
    if (PH == 1) phase_norm1(F, l);
    if (PH == 2) phase_gemm_in_mfma(F, l);
    if (PH == 4) phase_attn_mfma(F, l);
    if (PH == 5) phase_gemm_out_mfma(F, l);
    if (PH == 6) phase_norm2(F, l);
    if (PH == 7) phase_scatter(F, l);
    if (PH == 8) phase_gemm1_mfma(F, l);
    if (PH == 9) phase_gemm2_mfma(F, l);
    if (PH == 10) phase_final(F);
}
DI void grid_sync(unsigned char* lds_raw) {
    KParams kp = (KParams)__builtin_amdgcn_kernarg_segment_ptr();
    asm volatile("" : "+s"(kp));
    XcdBarrier b; b.bar = (unsigned*)kp->ws; b.x = xb_xcc_id(); b.st = (volatile LAS unsigned*)lds_raw;
    xcd_barrier(b);
}
__global__ void __launch_bounds__(NWG_THREADS, 2) fwd_kernel(Params p) {
    extern __shared__ __attribute__((aligned(16))) unsigned char lds_raw[];
    if (threadIdx.x == 0) *(uint4*)lds_raw = make_uint4(0u, 0u, 0u, 0u);
    __syncthreads();
    (void)xcd_barrier_post((unsigned*)p.ws, (volatile LAS unsigned*)lds_raw);
#define RUN(PH, l) run_phase<PH>(lds_raw, l); grid_sync(lds_raw); if (DUP_PH == PH && DUP_L == l) { run_phase<PH>(lds_raw, l); grid_sync(lds_raw); }
    RUN(0, 0)
    RUN(1, 0) RUN(2, 0) RUN(4, 0) RUN(5, 0) RUN(6, 0) RUN(8, 0) RUN(9, 0)
    RUN(1, 1) RUN(2, 1) RUN(4, 1) RUN(5, 1) RUN(6, 1) RUN(8, 1) RUN(9, 1)
    run_phase<10>(lds_raw, 0);
#undef RUN
}

extern "C" void kernel_launch(void* const* d_in, const int* in_sizes, int n_in, void* d_out, int out_size, void* d_ws, size_t ws_size, hipStream_t stream) {
    static int grid = 0;
    if (grid == 0) {
        if (n_in != 26 || out_size != NLAT * D || ws_size < WS_END2) { fprintf(stderr, "kernel_launch: unexpected shapes n_in %d out %d ws %zu (need %zu)\n", n_in, out_size, ws_size, (size_t)WS_END2); grid = -1; return; }
        int dev = 0, cus = 0, per_cu = 0;
        if (hipGetDevice(&dev) != hipSuccess || hipDeviceGetAttribute(&cus, hipDeviceAttributeMultiprocessorCount, dev) != hipSuccess) { grid = -1; return; }
        if (hipFuncSetAttribute((const void*)fwd_kernel, hipFuncAttributeMaxDynamicSharedMemorySize, LDS_BYTES) != hipSuccess) { fprintf(stderr, "kernel_launch: hipFuncSetAttribute failed\n"); grid = -1; return; }
        if (hipOccupancyMaxActiveBlocksPerMultiprocessor(&per_cu, (const void*)fwd_kernel, NWG_THREADS, LDS_BYTES) != hipSuccess || per_cu < 1) fprintf(stderr, "kernel_launch: occupancy query reports %d\n", per_cu);
        (void)hipGetLastError();
        if (cus < 64) { fprintf(stderr, "kernel_launch: %d CUs, need at least 64\n", cus); grid = -1; return; }
        grid = cus;
    }
    if (grid < 0) return;
    (void)hipMemsetAsync((char*)d_ws + WS_SYNC, 0, SYNC_BYTES, stream);
    Params p{};
    for (int i = 0; i < 26; ++i) p.in[i] = (const float*)d_in[i];
    p.out = (float*)d_out; p.ws = (unsigned char*)d_ws; p.ph_lo = 0; p.ph_hi = 0;
    hipLaunchKernelGGL(fwd_kernel, dim3(grid), dim3(NWG_THREADS), LDS_BYTES, stream, p);
}
```

```cpp
#include <hip/hip_runtime.h>
#include <stdint.h>
#include <stdio.h>

#define DI __device__ __forceinline__
#ifndef MFMA_GEMM
#define MFMA_GEMM 15
#endif
#ifndef DUP_PH
#define DUP_PH -1
#endif
#ifndef DUP_L
#define DUP_L 0
#endif
#ifndef MFMA_ATTN
#define MFMA_ATTN 1
#endif
#ifndef ATTN_PIPE
#define ATTN_PIPE 2
#endif
typedef unsigned short bf16_t;
typedef float f32x4 __attribute__((ext_vector_type(4)));
typedef unsigned u32x4 __attribute__((ext_vector_type(4)));
typedef unsigned u32x2 __attribute__((ext_vector_type(2)));

constexpr int D = 1024, NB = 4, SEQ = 8192, NLAT = NB * SEQ, CTXL = 256, NCTX = NB * CTXL, NT = NLAT + NCTX;
constexpr int KEYS = CTXL + SEQ;
constexpr int INW = 2560, QKW = 1792, VW = 768;
constexpr int NKH = 12;
constexpr int NBUCKET = 24, MAXTILES = 156, MAXSLOTS = MAXTILES * 256;
constexpr int NWG_THREADS = 512;
constexpr int LDS_BYTES = 163840;

constexpr size_t al256(size_t x) { return (x + 255) & ~(size_t)255; }
constexpr size_t WS_SYNC = 0;
constexpr size_t SYNC_BYTES = 65536;
constexpr size_t KMAX_OFF_WORDS = 4096 + 64;
constexpr size_t QMAX_OFF_WORDS = 4096 + 192;
constexpr size_t CNT_OFF_WORDS = 4096;
constexpr size_t WS_MOD = WS_SYNC + SYNC_BYTES;
constexpr size_t WS_ROPEB = WS_MOD + al256((size_t)2 * 5 * 6144 * 4);
constexpr size_t WS_ROPEC = WS_ROPEB + 128 * 8 * 2 * 4;
constexpr size_t WS_LAM = WS_ROPEC + 128 * 16 * 2 * 4;
constexpr size_t WS_TOKINFO = WS_LAM + 256;
constexpr size_t WS_TOKSLOT = WS_TOKINFO + (size_t)NT * 16;
constexpr size_t WS_SLOTTOK = WS_TOKSLOT + (size_t)NT * 4;
constexpr size_t WS_SLOTW = WS_SLOTTOK + (size_t)MAXSLOTS * 4;
constexpr size_t WS_XC = WS_SLOTW + (size_t)MAXSLOTS * 8;
constexpr size_t WS_WINT = WS_XC + (size_t)NCTX * D * 4;
constexpr size_t WS_WOUTT = WS_WINT + (size_t)2 * INW * D * 2;
constexpr size_t WS_WGU = WS_WOUTT + (size_t)2 * D * D * 2;
constexpr size_t WS_WDT = WS_WGU + (size_t)2 * 16 * 1024 * 1024 * 2;
constexpr size_t WS_ACT = WS_WDT + (size_t)2 * 16 * 1024 * 512 * 2;
constexpr size_t WS_BIG = WS_ACT + (size_t)MAXSLOTS * D * 2;
constexpr size_t BIG_PROJ = 0;
constexpr size_t BIG_KPOST = BIG_PROJ + (size_t)NT * QKW * 2;
constexpr size_t BIG_VT = BIG_KPOST + (size_t)NB * NKH * KEYS * 64 * 2;
constexpr size_t BIG_Y16 = (size_t)MAXSLOTS * D * 2;
constexpr size_t BIG_END = BIG_VT + (size_t)NB * NKH * KEYS * 64 * 2;
constexpr size_t WS_END = WS_BIG + BIG_END;
static_assert((size_t)MAXSLOTS * 2048 * 2 <= BIG_END && (size_t)NT * D * 4 <= BIG_END, "alias");
constexpr size_t WS_XB = WS_END;
constexpr int SPCAP = NT;
constexpr size_t WS_SPTOK = WS_XB + (size_t)NT * D * 2;
constexpr size_t WS_SPW = WS_SPTOK + (size_t)NBUCKET * SPCAP * 4;
constexpr size_t WS_RWT = WS_SPW + (size_t)NBUCKET * SPCAP * 8;
constexpr size_t WS_END2 = WS_RWT + (size_t)2 * 20 * 1024 * 4;
static_assert(WS_END2 <= (size_t)512 * 1024 * 1024, "workspace");

struct Params {
    const float* in[26];
    float* out;
    unsigned char* ws;
    int ph_lo, ph_hi;
};

DI float bf2f(bf16_t v) { return __uint_as_float((unsigned)v << 16); }
DI bf16_t f2bf(float f) { unsigned u = __float_as_uint(f); u += 0x7fffu + ((u >> 16) & 1u); return (bf16_t)(u >> 16); }
DI unsigned pack2(float a, float b) { return (unsigned)f2bf(a) | ((unsigned)f2bf(b) << 16); }
DI float dpp_row_sum(float s) {
    s += __int_as_float(__builtin_amdgcn_update_dpp(0, __float_as_int(s), 0xB1, 0xF, 0xF, false));
    s += __int_as_float(__builtin_amdgcn_update_dpp(0, __float_as_int(s), 0x4E, 0xF, 0xF, false));
    s += __int_as_float(__builtin_amdgcn_update_dpp(0, __float_as_int(s), 0x141, 0xF, 0xF, false));
    s += __int_as_float(__builtin_amdgcn_update_dpp(0, __float_as_int(s), 0x140, 0xF, 0xF, false));
    return s;
}
DI float swap32_sum(float a, float b) { const auto r = __builtin_amdgcn_permlane32_swap(__float_as_uint(a), __float_as_uint(b), false, false); return __uint_as_float(r[0]) + __uint_as_float(r[1]); }
DI float swap16_sum(float a, float b) { const auto r = __builtin_amdgcn_permlane16_swap(__float_as_uint(a), __float_as_uint(b), false, false); return __uint_as_float(r[0]) + __uint_as_float(r[1]); }
DI float wave_sum(float v) { const float a = swap32_sum(v, v); return dpp_row_sum(swap16_sum(a, a)); }
DI int clampi(int v, int lo, int hi) { return v < lo ? lo : (v > hi ? hi : v); }

#define XB_TMO      128
#define XB_XCNT(j)  (256  + 64 * (j))
#define XB_XSUB(j)  (1280 + 64 * (j))
#define XB_XGEN(j)  (2304 + 64 * (j))
#define XB_TOP      3328
#define XB_TOPGEN   3392
#define XCD_BAR_WORDS 3456
#define XB_SPIN_CAP (1u << 18)
typedef float f32x2 __attribute__((ext_vector_type(2)));
#define LAS __attribute__((address_space(3)))
#define GAS __attribute__((address_space(1)))
DI unsigned xb_ld(unsigned* p)              { return __hip_atomic_load(p, __ATOMIC_RELAXED, __HIP_MEMORY_SCOPE_AGENT); }
DI unsigned xb_add(unsigned* p, unsigned v) { return __hip_atomic_fetch_add(p, v, __ATOMIC_RELAXED, __HIP_MEMORY_SCOPE_AGENT); }
DI unsigned xb_xcc_id() { return (unsigned)__builtin_amdgcn_s_getreg((3 << 11) | 20) & 0xFu; }
#define XB_SPIN(cond, bar) do { unsigned _sp = 0; while (cond) { __builtin_amdgcn_s_sleep(1); \
    if ((++_sp & 255u) == 0u) { if (xb_ld(&(bar)[XB_TMO])) break; if (_sp > XB_SPIN_CAP) { atomicAdd(&(bar)[XB_TMO], 1u); break; } } } } while (0)
struct XcdBarrier { unsigned* bar; unsigned x; volatile LAS unsigned* st; };
DI XcdBarrier xcd_barrier_post(unsigned* bar, volatile LAS unsigned* st) {
    XcdBarrier b; b.bar = bar; b.x = xb_xcc_id(); b.st = st;
    if (threadIdx.x == 0) (void)xb_add(&bar[XB_XCNT(b.x)], 1u);
    return b;
}
DI void xcd_barrier_complete(unsigned* bar, unsigned x, unsigned& nloc, unsigned& nx) {
    const unsigned G = gridDim.x * gridDim.y * gridDim.z;
    unsigned sum, cnt, mine, sp = 0u;
    for (;;) {
        sum = 0u; cnt = 0u; mine = 0u;
#pragma unroll
        for (unsigned j = 0; j < 16; ++j) { const unsigned c = xb_ld(&bar[XB_XCNT(j)]); sum += c; cnt += (c > 0u) ? 1u : 0u; mine = (j == x) ? c : mine; }
        if (sum == G) break;
        __builtin_amdgcn_s_sleep(1);
        if ((++sp & 255u) == 0u) { if (xb_ld(&bar[XB_TMO])) break; if (sp > XB_SPIN_CAP) { atomicAdd(&bar[XB_TMO], 1u); break; } }
    }
    nloc = mine > 0u ? mine : 1u; nx = cnt > 0u ? cnt : 1u;
}
DI void xcd_barrier(const XcdBarrier& b) {
    asm volatile("s_waitcnt vmcnt(0)" ::: "memory");
    __syncthreads();
    if (threadIdx.x == 0) {
        unsigned* bar = b.bar;
        __builtin_amdgcn_s_waitcnt(0);
        unsigned nloc = b.st[0], nx = b.st[1];
        if (nloc == 0u) { xcd_barrier_complete(bar, b.x, nloc, nx); b.st[0] = nloc; b.st[1] = nx; }
        const unsigned old = xb_add(&bar[XB_XSUB(b.x)], 1u);
        const unsigned gen = old / nloc;
        if (old + 1u == (gen + 1u) * nloc) {
            __builtin_amdgcn_fence(__ATOMIC_RELEASE, "agent");
            asm volatile("s_waitcnt vmcnt(0)" ::: "memory");
            const unsigned og = xb_add(&bar[XB_TOP], 1u);
            const unsigned tg = og / nx;
            if (og + 1u == (tg + 1u) * nx) xb_add(&bar[XB_TOPGEN], 1u);
            else XB_SPIN(xb_ld(&bar[XB_TOPGEN]) == tg, bar);
            __builtin_amdgcn_fence(__ATOMIC_ACQUIRE, "agent");
            xb_add(&bar[XB_XGEN(b.x)], 1u);
            asm volatile("s_waitcnt vmcnt(0)" ::: "memory");
        } else {
            XB_SPIN(xb_ld(&bar[XB_XGEN(b.x)]) == gen, bar);
            __builtin_amdgcn_fence(__ATOMIC_ACQUIRE, "agent");
            asm volatile("s_waitcnt vmcnt(0)" ::: "memory");
        }
    }
    __syncthreads();
}

typedef const Params __attribute__((address_space(4)))* KParams;
DI const float* gin(KParams p, int i) { GAS const float* g = (GAS const float*)p->in[i]; asm volatile("" : "+s"(g)); return (const float*)g; }
DI float* gout(KParams p) { GAS float* g = (GAS float*)p->out; asm volatile("" : "+s"(g)); return (float*)g; }
struct Frame {
    KParams p; GAS unsigned char* ws; float* lds; int tid, wid, lane, wg, nwg;
    template <class T> DI T* wsp(size_t off) const { return (T*)(GAS T*)(ws + off); }
};
DI const float* mod_row(const Frame& F, int l, int mrow) { return F.wsp<float>(WS_MOD) + ((size_t)l * 5 + mrow) * 6144; }
DI int tok_modrow(int t) { return t < NLAT ? (t >> 13) : 4; }
DI int tok_batch(int t) { return t < NLAT ? (t >> 13) : ((t - NLAT) >> 8); }
DI int tok_key(int t) { return t < NLAT ? CTXL + (t & (SEQ - 1)) : ((t - NLAT) & (CTXL - 1)); }
DI bf16_t* xres_row(const Frame& F, int t) { return F.wsp<bf16_t>(WS_XB) + (size_t)t * D; }
DI const float* xin_row(const Frame& F, int t) { return t < NLAT ? gin(F.p, 0) + (size_t)t * D : gin(F.p, 2) + (size_t)(t - NLAT) * D; }
DI double lam_init_of(int l) { return l == 0 ? 0.8 - 0.6 : 0.8 - 0.6 * 0.74081822068171786607; }
DI void sincos_d(double a, double& s, double& c) {
    const double n = __builtin_rint(a * 0.63661977236758134308);
    const double r = (a - n * 1.57079632673412561417e+00) - n * 6.07710050650619224932e-11;
    const double r2 = r * r;
    double ts = 1.0, tc = 1.0;
#pragma unroll
    for (int k = 12; k >= 1; --k) { ts = 1.0 - ts * r2 * (1.0 / (double)((2 * k) * (2 * k + 1))); tc = 1.0 - tc * r2 * (1.0 / (double)((2 * k - 1) * (2 * k))); }
    const double sr = r * ts, cr = tc;
    const int q = ((int)n) & 3;
    s = q == 0 ? sr : (q == 1 ? cr : (q == 2 ? -sr : -cr));
    c = q == 0 ? cr : (q == 1 ? -sr : (q == 2 ? -cr : sr));
}
DI double exp_d(double x) { double t = 1.0;
#pragma unroll
    for (int k = 40; k >= 1; --k) t = 1.0 + t * x * (1.0 / (double)k);
    return t; }

DI int win_rowmap(int c) {
    int hs, e; bool isb = false;
    if (c < 384) { hs = c >> 6; e = c & 63; }
    else if (c < 768) { hs = 6 + ((c - 384) >> 6); e = c & 63; }
    else if (c < 1152) return QKW + (c - 768);
    else if (c < 1408) { hs = 12 + ((c - 1152) >> 6); e = (c - 1152) & 63; isb = true; }
    else if (c < 1664) { hs = 16 + ((c - 1408) >> 6); e = (c - 1408) & 63; isb = true; }
    else if (c < 1920) return QKW + 384 + (c - 1664);
    else if (c < 2304) { hs = 20 + ((c - 1920) >> 6); e = (c - 1920) & 63; }
    else if (c < 2432) { hs = 26 + ((c - 2304) >> 6); e = (c - 2304) & 63; }
    else return QKW + 640 + (c - 2432);
    int bj, fq; const int j = e & 7;
    if (!isb) { bj = e >> 5; fq = (e >> 3) & 3; } else { const int mp = e >> 5, i = e & 31; bj = i >> 4; fq = 2 * mp + ((i >> 3) & 1); }
    return 256 * (hs >> 2) + 128 * bj + 32 * (hs & 3) + 8 * fq + j;
}
DI void cvt_tile(const Frame& F, const float* src, int C, int k0, int n0, bf16_t* dst, int ldd, int mode) {
    float* t = F.lds;
    __syncthreads();
    { const int kk = F.tid >> 3, nn = (F.tid & 7) * 8;
      const float* s = src + (size_t)(k0 + kk) * C + n0 + nn;
      const f32x4 a = *(const f32x4*)s, b = *(const f32x4*)(s + 4);
      float* d = t + kk * 65 + nn;
      d[0] = a[0]; d[1] = a[1]; d[2] = a[2]; d[3] = a[3]; d[4] = b[0]; d[5] = b[1]; d[6] = b[2]; d[7] = b[3]; }
    __syncthreads();
    { const int nn = F.tid >> 3, kk0 = (F.tid & 7) * 8;
      u32x4 o;
#pragma unroll
      for (int j = 0; j < 4; ++j) o[j] = pack2(t[(kk0 + 2 * j) * 65 + nn], t[(kk0 + 2 * j + 1) * 65 + nn]);
      const int c = n0 + nn; const int orow = mode == 0 ? c : (mode == 1 ? win_rowmap(c) : (mode == 2 ? 2 * c : 2 * c + 1));
      *(u32x4*)(dst + (size_t)orow * ldd + k0 + kk0) = o; }
}
struct CvtJob { const float* src; bf16_t* dst; int C, k0, n0, ldd, mode; };
DI CvtJob cvt_job(const Frame& F, int ug) {
    const KParams Pp = F.p;
    const int T0 = 1280, T1 = T0 + 512, T2 = T1 + 4096, T3 = T2 + 4096;
    const int u = ug * 4;
    CvtJob J;
    if (u < T0) { const int l = u / 640, r = u % 640, kt = r / 40, nt = r % 40;
        J.src = gin(Pp, 8) + (size_t)l * D * INW; J.C = INW; J.k0 = kt * 64; J.n0 = nt * 64; J.dst = F.wsp<bf16_t>(WS_WINT) + (size_t)l * INW * D; J.ldd = D; J.mode = 1;
    } else if (u < T1) { const int v = u - T0, l = v / 256, r = v % 256, kt = r / 16, nt = r % 16;
        J.src = gin(Pp, 9) + (size_t)l * D * D; J.C = D; J.k0 = kt * 64; J.n0 = nt * 64; J.dst = F.wsp<bf16_t>(WS_WOUTT) + (size_t)l * D * D; J.ldd = D; J.mode = 0;
    } else if (u < T3) { const bool up = u >= T2; const int v = u - (up ? T2 : T1), le = v / 128, r = v % 128, kt = r / 8, nt = r % 8;
        J.src = (up ? gin(Pp, 23) : gin(Pp, 22)) + (size_t)le * D * 512; J.C = 512; J.k0 = kt * 64; J.n0 = nt * 64; J.dst = F.wsp<bf16_t>(WS_WGU) + (size_t)le * 1024 * 1024; J.ldd = D; J.mode = up ? 3 : 2;
    } else { const int v = u - T3, le = v / 128, r = v % 128, kt = r / 16, nt = r % 16;
        J.src = gin(Pp, 24) + (size_t)le * 512 * D; J.C = D; J.k0 = kt * 64; J.n0 = nt * 64; J.dst = F.wsp<bf16_t>(WS_WDT) + (size_t)le * 1024 * 512; J.ldd = 512; J.mode = 0;
    }
    return J;
}
DI void phase_prologue(const Frame& F) {
    const KParams Pp = F.p;
    {
        constexpr int NG = (1280 + 512 + 3 * 4096) / 4;
        float* t = F.lds;
        const int kk = F.tid >> 3, nn = (F.tid & 7) * 8;
        const int tn = F.tid >> 3, kk0 = (F.tid & 7) * 8;
        int ug = F.wg;
        CvtJob J = cvt_job(F, ug < NG ? ug : 0);
        f32x4 a[4], b[4];
#define CVT_ISSUE() { const float* sp = J.src + (size_t)(J.k0 + kk) * J.C + J.n0 + nn; \
        _Pragma("unroll") for (int q = 0; q < 4; ++q) { a[q] = *(const f32x4*)(sp + 64 * q); b[q] = *(const f32x4*)(sp + 64 * q + 4); } }
        if (ug < NG) CVT_ISSUE()
        while (ug < NG) {
            __syncthreads();
#pragma unroll
            for (int q = 0; q < 4; ++q) { float* d = t + q * (64 * 65) + kk * 65 + nn;
                d[0] = a[q][0]; d[1] = a[q][1]; d[2] = a[q][2]; d[3] = a[q][3]; d[4] = b[q][0]; d[5] = b[q][1]; d[6] = b[q][2]; d[7] = b[q][3]; }
            __syncthreads();
            const CvtJob Jc = J; const int un = ug + F.nwg;
            if (un < NG) { J = cvt_job(F, un); CVT_ISSUE() }
#pragma unroll
            for (int q = 0; q < 4; ++q) { const float* tq = t + q * (64 * 65);
                u32x4 o;
#pragma unroll
                for (int j = 0; j < 4; ++j) o[j] = pack2(tq[(kk0 + 2 * j) * 65 + tn], tq[(kk0 + 2 * j + 1) * 65 + tn]);
                const int c = Jc.n0 + 64 * q + tn; const int orow = Jc.mode == 0 ? c : (Jc.mode == 1 ? win_rowmap(c) : (Jc.mode == 2 ? 2 * c : 2 * c + 1));
                *(u32x4*)(Jc.dst + (size_t)orow * Jc.ldd + Jc.k0 + kk0) = o; }
            ug = un;
        }
#undef CVT_ISSUE
    }
    __syncthreads();
    {
        float* sc = F.lds;
        float* red = F.lds + 5 * 1024;
        { float cv[10];
#pragma unroll
          for (int it = 0; it < 10; ++it) { const int k = (F.tid + NWG_THREADS * it) & 1023; cv[it] = (it >> 1) < 4 ? gin(Pp, 1)[(it >> 1) * 1024 + k] : gin(Pp, 3)[k]; }
#pragma unroll
          for (int it = 0; it < 10; ++it) sc[F.tid + NWG_THREADS * it] = cv[it] / (1.f + expf(-cv[it])); }
        __syncthreads();
        for (int u = F.wg; u < 192; u += F.nwg) {
            const int l = u / 96, j0 = (u % 96) * 64, kg = F.tid >> 4, jq = (F.tid & 15) * 4;
            const float* w = gin(Pp, 4) + (size_t)l * D * 6144 + j0 + jq + (size_t)(kg * 32) * 6144;
            f32x4 acc[5];
#pragma unroll
            for (int r = 0; r < 5; ++r) acc[r] = (f32x4){0.f, 0.f, 0.f, 0.f};
#pragma unroll
            for (int kb = 0; kb < 32; kb += 16) {
                f32x4 wv[16];
#pragma unroll
                for (int e = 0; e < 16; ++e) wv[e] = *(const f32x4*)(w + (size_t)(kb + e) * 6144);
#pragma unroll
                for (int e = 0; e < 16; ++e) { const int k = kg * 32 + kb + e;
#pragma unroll
                    for (int r = 0; r < 5; ++r) acc[r] += wv[e] * sc[r * 1024 + k]; } }
#pragma unroll
            for (int r = 0; r < 5; ++r) *(f32x4*)(red + (kg * 5 + r) * 64 + jq) = acc[r];
            __syncthreads();
            if (F.tid < 320) { const int r = F.tid >> 6, jj = F.tid & 63; float s = 0; for (int g = 0; g < 32; ++g) s += red[(g * 5 + r) * 64 + jj]; F.wsp<float>(WS_MOD)[((size_t)l * 5 + r) * 6144 + j0 + jj] = s + gin(Pp, 5)[l * 6144 + j0 + jj]; }
            __syncthreads();
        }
    }
    for (int i = F.wg * NWG_THREADS + F.tid; i < 2 * 20480; i += F.nwg * NWG_THREADS) { const int l = i / 20480, r = i % 20480, j = r >> 10, k = r & 1023;
        F.wsp<float>(WS_RWT)[i] = j < 4 ? gin(Pp, 18)[(size_t)l * 4096 + k * 4 + j] : gin(Pp, 20)[(size_t)l * 16384 + k * 16 + (j - 4)]; }
    const bool rev = F.nwg >= 32; const int rwg = rev ? F.nwg - 1 - F.wg : F.wg, qoff = rev ? 8 : 0, lamwg = rev ? 24 : 0;
    for (int i = rwg * NWG_THREADS + F.tid; i < 128 * 8 + 128 * 16; i += F.nwg * NWG_THREADS) {
        const bool isb = i < 1024; const int v = isb ? i : i - 1024, pos = isb ? v >> 3 : v >> 4, j = isb ? v & 7 : v & 15;
        const double base = isb ? 0.31622776601683793320 : 0.56234132519034908039;
        double f = 1.0; for (int k = 0; k < j; ++k) f *= base;
        double sn, cs; sincos_d((double)pos * f, sn, cs);
        float* dst = isb ? F.wsp<float>(WS_ROPEB) : F.wsp<float>(WS_ROPEC);
        dst[v * 2] = (float)cs; dst[v * 2 + 1] = (float)sn;
    }
    for (int q = rwg - qoff; q >= 0 && q < 12; q += F.nwg) {
        float bm = F.tid < 465 ? fabsf(gin(Pp, 10)[(size_t)q * 465 + F.tid]) : 0.f;
#pragma unroll
        for (int of = 32; of; of >>= 1) bm = fmaxf(bm, __shfl_xor(bm, of));
        __syncthreads();
        if (F.lane == 0) F.lds[F.wid] = bm;
        __syncthreads();
        if (F.tid == 0) { float m = F.lds[0]; for (int i = 1; i < 8; ++i) m = fmaxf(m, F.lds[i]); F.wsp<float>(WS_LAM)[16 + q] = m * 1.4426950408889634f; }
        __syncthreads(); }
    if (F.wg == F.nwg - 1 && F.wid == 1) {
#pragma unroll
        for (int l = 0; l < 2; ++l) { float g = fabsf(gin(Pp, 16)[l * 64 + F.lane]);
#pragma unroll
            for (int of = 32; of; of >>= 1) g = fmaxf(g, __shfl_xor(g, of));
            if (F.lane == 0) F.wsp<float>(WS_LAM)[32 + l] = g; } }
    if (rwg == lamwg && F.wid == 0) {
#pragma unroll
        for (int l = 0; l < 2; ++l) { double s1 = 0.0, s2 = 0.0;
            if (F.lane < 32) { s1 = (double)gin(Pp, 11)[l * 32 + F.lane] * (double)gin(Pp, 12)[l * 32 + F.lane]; s2 = (double)gin(Pp, 13)[l * 32 + F.lane] * (double)gin(Pp, 14)[l * 32 + F.lane]; }
#pragma unroll
            for (int of = 16; of; of >>= 1) { s1 += __shfl_xor(s1, of); s2 += __shfl_xor(s2, of); }
            if (F.lane == 0) { const double li = lam_init_of(l); F.wsp<float>(WS_LAM)[l * 2] = (float)(exp_d(s1) - exp_d(s2) + li); F.wsp<float>(WS_LAM)[l * 2 + 1] = (float)li; } } }
}

DI f32x4 bf4_to_f32(u32x2 v) { return (f32x4){__uint_as_float(v[0] << 16), __uint_as_float(v[0] & 0xffff0000u), __uint_as_float(v[1] << 16), __uint_as_float(v[1] & 0xffff0000u)}; }
DI unsigned cvtpk_rne(float lo, float hi) { unsigned r; asm volatile("s_nop 0\n\tv_cvt_pk_bf16_f32 %0, %1, %2" : "=v"(r) : "v"(lo), "v"(hi)); return r; }
DI int build_tiles(const Frame& F, int l, int* tile_bucket, int* boff);
DI void phase_norm1(const Frame& F, int l) {
    const KParams Pp = F.p;
    const float* gain = gin(Pp, 6) + l * D;
    bf16_t* act = F.wsp<bf16_t>(WS_ACT);
    const bf16_t* y16 = F.wsp<bf16_t>(WS_BIG + BIG_Y16); const int4* tokinfo = F.wsp<int4>(WS_TOKINFO);
    int* tile_bucket = (int*)F.lds; int* boff = tile_bucket + MAXTILES;
    if (l != 0) build_tiles(F, l - 1, tile_bucket, boff);
    const int stride = F.nwg * 8;
    f32x4 rxf[2][4]; u32x2 rxb[2][4], ryb[2][4]; int nsl[2] = {0, 0};
#pragma unroll
    for (int r = 0; r < 2; ++r)
#pragma unroll
        for (int i = 0; i < 4; ++i) { rxf[r][i] = (f32x4){0.f, 0.f, 0.f, 0.f}; rxb[r][i] = (u32x2){0u, 0u}; ryb[r][i] = (u32x2){0u, 0u}; }
#define N1_SLOTS(T0) if (l != 0 && (T0) < NT) { const int2 i0_ = *(const int2*)(tokinfo + (T0)), i1_ = *(const int2*)(tokinfo + (T0) + 1); nsl[0] = boff[i0_.x] * 256 + i0_.y; nsl[1] = boff[i1_.x] * 256 + i1_.y; }
#define N1_ISSUE(T0) if ((T0) < NT) { \
        _Pragma("unroll") for (int r = 0; r < 2; ++r) { \
            if (l == 0) { const float* s_ = xin_row(F, (T0) + r); _Pragma("unroll") for (int i = 0; i < 4; ++i) rxf[r][i] = *(const f32x4*)(s_ + (i * 64 + F.lane) * 4); } \
            else { const bf16_t* s_ = xres_row(F, (T0) + r); const bf16_t* yr_ = y16 + (size_t)nsl[r] * D; \
                _Pragma("unroll") for (int i = 0; i < 4; ++i) { const int k = (i * 64 + F.lane) * 4; rxb[r][i] = *(const u32x2*)(s_ + k); ryb[r][i] = *(const u32x2*)(yr_ + k); } } } }
    const int tfirst = 2 * (F.wg * 8 + F.wid);
    N1_SLOTS(tfirst)
    N1_ISSUE(tfirst)
    N1_SLOTS(tfirst + 2 * stride)
    for (int t0 = tfirst; t0 < NT; t0 += 2 * stride) {
        const int tt[2] = {t0, t0 + 1};
        const float* m = mod_row(F, l, tok_modrow(t0));
        f32x4 v[2][4], g2v[4];
        if (l != 0) { const float* g2 = mod_row(F, l - 1, tok_modrow(t0)) + 5120;
#pragma unroll
            for (int i = 0; i < 4; ++i) g2v[i] = *(const f32x4*)(g2 + (i * 64 + F.lane) * 4); }
        f32x4 gsv[4], shv[4], scv[4];
#pragma unroll
        for (int i = 0; i < 4; ++i) { const int k = (i * 64 + F.lane) * 4; gsv[i] = *(const f32x4*)(gain + k); shv[i] = *(const f32x4*)(m + k); scv[i] = *(const f32x4*)(m + 1024 + k); }
        if (l == 0) {
#pragma unroll
            for (int r = 0; r < 2; ++r)
#pragma unroll
                for (int i = 0; i < 4; ++i) v[r][i] = rxf[r][i];
        } else {
#pragma unroll
            for (int r = 0; r < 2; ++r) { bf16_t* s = xres_row(F, tt[r]);
#pragma unroll
                for (int i = 0; i < 4; ++i) { const int k = (i * 64 + F.lane) * 4; v[r][i] = bf4_to_f32(rxb[r][i]) + g2v[i] * bf4_to_f32(ryb[r][i]);
                    u32x2 xo; xo[0] = cvtpk_rne(v[r][i][0], v[r][i][1]); xo[1] = cvtpk_rne(v[r][i][2], v[r][i][3]); *(u32x2*)(s + k) = xo; } }
        }
        __builtin_amdgcn_sched_barrier(0);
        N1_ISSUE(t0 + 2 * stride)
        N1_SLOTS(t0 + 4 * stride)
        __builtin_amdgcn_sched_barrier(0);
        float ss[2] = {0.f, 0.f};
#pragma unroll
        for (int r = 0; r < 2; ++r)
#pragma unroll
            for (int i = 0; i < 4; ++i) ss[r] += v[r][i][0] * v[r][i][0] + v[r][i][1] * v[r][i][1] + v[r][i][2] * v[r][i][2] + v[r][i][3] * v[r][i][3];
#pragma unroll
        for (int i = 0; i < 4; ++i) gsv[i] = gsv[i] * (scv[i] + 1.f);
        ss[0] = wave_sum(ss[0]); ss[1] = wave_sum(ss[1]);
#pragma unroll
        for (int r = 0; r < 2; ++r) { const int t = tt[r];
            const float rstd = rsqrtf(ss[r] * (1.f / D) + 1e-6f);
#pragma unroll
            for (int i = 0; i < 4; ++i) { const int k = (i * 64 + F.lane) * 4;
                const f32x4 h = v[r][i] * rstd * gsv[i] + shv[i];
                u32x2 o; o[0] = cvtpk_rne(h[0], h[1]); o[1] = cvtpk_rne(h[2], h[3]);
                *(u32x2*)(act + (size_t)t * D + k) = o; } }
    }
#undef N1_ISSUE
#undef N1_SLOTS
}

namespace pg8 {
typedef short bf16x8 __attribute__((ext_vector_type(8)));
constexpr int BM = 256, BK = 64, HALF = 128, HTB = HALF * BK * 2, STAGE_BYTES = 8 * HTB;
DI int lds_byte(int r, int c) { const int st = (r >> 4) * 2 + (c >> 5), rr = r & 15, cc = c & 31, ob = rr * 64 + cc * 2; return st * 1024 + (ob ^ (((ob >> 9) & 1) << 5)); }
DI void stage_rc(int b, int& R, int& C) { const int st = b / 1024, sb = b % 1024, swz = sb ^ (((sb >> 9) & 1) << 5); R = (st >> 1) * 16 + swz / 64; C = (st & 1) * 32 + (swz % 64) / 2; }
DI int perm32(int rho) { const int n = rho >> 4, i = rho & 15; return 8 * (i >> 2) + 4 * n + (i & 3); }
struct Unit { int pm, pn, aux; };
DI unsigned cvt_pk_bf16(float lo, float hi) { unsigned r; asm volatile("v_cvt_pk_bf16_f32 %0, %1, %2" : "=v"(r) : "v"(lo), "v"(hi)); return r; }

template <class Epi, class Sched>
DI void gemm_phase(LAS unsigned char* lds, const int K, const int lda, const int ldb, const Sched& S, const Epi& E) {
    int tid = threadIdx.x; asm volatile("" : "+v"(tid));
    const int wid = __builtin_amdgcn_readfirstlane(tid >> 6), lane = tid & 63, wr = wid >> 2, wc = wid & 3, fr = lane & 15, fq = lane >> 4;
    const int nt = K / BK, tps = nt / Sched::NSEG;
    int RA[2], CA[2]; unsigned voffB[2];
#pragma unroll
    for (int i = 0; i < 2; ++i) { int R, C; stage_rc(tid * 16 + i * 8192, R, C); const int Rb = Epi::PERM ? ((R & ~31) + perm32(R & 31)) : R; RA[i] = R; CA[i] = C; voffB[i] = (unsigned)(Rb * ldb + C) * 2u; }
    const size_t kstep = (size_t)(BK * 2);
    const size_t hstepB = (size_t)HALF * ldb * 2;
    const unsigned ldsw = (unsigned)wid * 1024u;
    const int aoff = lds_byte(wr * 64 + fr, fq * 8), boff = lds_byte(wc * 32 + fr, fq * 8);
#define PG8_SA(b, h) (((b) * 2 + (h)) * HTB)
#define PG8_SB(b, h) ((4 + (b) * 2 + (h)) * HTB)
#define PG8_STAGE(bufoff, gbase, voff) do { _Pragma("unroll") for (int _i = 0; _i < 2; ++_i) \
        __builtin_amdgcn_global_load_lds((const unsigned*)((const char*)(gbase) + (voff)[_i]), (LAS unsigned*)(lds + (bufoff) + ldsw + _i * 8192), 16, 0, 0); } while (0)
#define PG8_LDA(dst, b, h) do { _Pragma("unroll") for (int m = 0; m < 4; ++m) _Pragma("unroll") for (int k = 0; k < 2; ++k) dst[m][k] = *(const LAS bf16x8*)(lds + PG8_SA(b, h) + aoff + m * 2048 + k * 1024); } while (0)
#define PG8_LDB(dst, b, h) do { _Pragma("unroll") for (int n = 0; n < 2; ++n) _Pragma("unroll") for (int k = 0; k < 2; ++k) dst[n][k] = *(const LAS bf16x8*)(lds + PG8_SB(b, h) + boff + n * 2048 + k * 1024); } while (0)
#define PG8_MMA(ai, bj, At, Bt) do { __builtin_amdgcn_s_setprio(1); _Pragma("unroll") for (int m = 0; m < 4; ++m) _Pragma("unroll") for (int n = 0; n < 2; ++n) _Pragma("unroll") for (int k = 0; k < 2; ++k) \
        acc[ai][bj][m][n] = __builtin_amdgcn_mfma_f32_16x16x32_bf16(Bt[n][k], At[m][k], acc[ai][bj][m][n], 0, 0, 0); __builtin_amdgcn_s_setprio(0); } while (0)
#define PG8_WAIT_V(n) asm volatile("s_waitcnt vmcnt(" #n ")" ::: "memory")
#define PG8_WAIT_L(n) asm volatile("s_waitcnt lgkmcnt(" #n ")" ::: "memory")
#define PG8_BAR __builtin_amdgcn_s_barrier()
#define PG8_SCHED __builtin_amdgcn_sched_barrier(0)
    Unit cur, nxt; int ui = 0;
    if (!S.next(0, cur)) return;
    f32x4 acc[2][2][4][2];
#pragma unroll
    for (int a = 0; a < 2; ++a)
#pragma unroll
        for (int b = 0; b < 2; ++b)
#pragma unroll
            for (int m = 0; m < 4; ++m)
#pragma unroll
                for (int n = 0; n < 2; ++n) acc[a][b][m][n] = (f32x4){0.f, 0.f, 0.f, 0.f};
    bf16x8 At[4][2], B0[2][2], B1[2][2];
    float epre[8] = {0.f, 0.f, 0.f, 0.f, 0.f, 0.f, 0.f, 0.f};
    unsigned vA[2][2], nvA[2][2];
#pragma unroll
    for (int h = 0; h < 2; ++h) { int r0 = h * HALF + RA[0], r1 = h * HALF + RA[1]; if (Sched::GATHER) S.a_rows(cur, r0, r1);
        vA[h][0] = (unsigned)(r0 * lda + CA[0]) * 2u; vA[h][1] = (unsigned)(r1 * lda + CA[1]) * 2u; nvA[h][0] = vA[h][0]; nvA[h][1] = vA[h][1]; }
    const char* cA = S.a_base(cur); const char* cB0 = S.b_base(cur, 0); const char* cB1 = Sched::NSEG > 1 ? S.b_base(cur, 1) : cB0;
#define PG8_BPTR(b0, b1, t) ((Sched::NSEG > 1 && (t) >= tps) ? (b1) + (size_t)((t) - tps) * kstep : (b0) + (size_t)(t) * kstep)
    PG8_STAGE(PG8_SB(0, 0), cB0, voffB); PG8_STAGE(PG8_SA(0, 0), cA, vA[0]); PG8_STAGE(PG8_SB(0, 1), cB0 + hstepB, voffB); PG8_STAGE(PG8_SA(0, 1), cA, vA[1]);
    if (wr == 1) PG8_BAR;
    PG8_WAIT_V(4); PG8_BAR;
    PG8_STAGE(PG8_SB(1, 0), cB0 + kstep, voffB); PG8_STAGE(PG8_SA(1, 0), cA + kstep, vA[0]); PG8_STAGE(PG8_SB(1, 1), cB0 + hstepB + kstep, voffB);
    PG8_WAIT_V(6); PG8_BAR;
    for (;;) {
        const bool has_next = S.next(ui + 1, nxt);
        const char* nA = has_next ? S.a_base(nxt) : cA; const char* nB0 = has_next ? S.b_base(nxt, 0) : cB0; const char* nB1 = has_next ? (Sched::NSEG > 1 ? S.b_base(nxt, 1) : nB0) : cB1;
        if (Sched::GATHER && has_next) {
#pragma unroll
            for (int h = 0; h < 2; ++h) { int r0 = h * HALF + RA[0], r1 = h * HALF + RA[1]; S.a_rows(nxt, r0, r1); nvA[h][0] = (unsigned)(r0 * lda + CA[0]) * 2u; nvA[h][1] = (unsigned)(r1 * lda + CA[1]) * 2u; } }
        for (int t = 0; t < nt; t += 2) {
            const bool last = (t == nt - 2);
            const char* a1 = cA + (size_t)(t + 1) * kstep;
            const char* a2 = last ? nA : cA + (size_t)(t + 2) * kstep; const char* b2 = last ? nB0 : PG8_BPTR(cB0, cB1, t + 2);
            const char* a3 = a2 + kstep; const char* b3 = b2 + kstep;
            unsigned w0[2], w1[2];
            w0[0] = last ? nvA[0][0] : vA[0][0]; w0[1] = last ? nvA[0][1] : vA[0][1]; w1[0] = last ? nvA[1][0] : vA[1][0]; w1[1] = last ? nvA[1][1] : vA[1][1];
            if (last) E.pre(cur, wr, fr, epre);
            PG8_LDB(B0, 0, 0); PG8_SCHED; PG8_LDA(At, 0, 0); PG8_STAGE(PG8_SA(1, 1), a1, vA[1]);
            PG8_WAIT_L(8); PG8_BAR; PG8_WAIT_L(0); PG8_MMA(0, 0, At, B0); PG8_BAR; PG8_SCHED;
            PG8_LDB(B1, 0, 1); PG8_STAGE(PG8_SB(0, 0), b2, voffB);
            PG8_BAR; PG8_WAIT_L(0); PG8_MMA(0, 1, At, B1); PG8_BAR;
            PG8_LDA(At, 0, 1); PG8_STAGE(PG8_SA(0, 0), a2, w0);
            PG8_BAR; PG8_WAIT_L(0); PG8_MMA(1, 0, At, B0); PG8_BAR; PG8_SCHED;
            PG8_STAGE(PG8_SB(0, 1), b2 + hstepB, voffB);
            PG8_WAIT_V(6); PG8_BAR; PG8_MMA(1, 1, At, B1); PG8_BAR;
            PG8_LDB(B0, 1, 0); PG8_SCHED; PG8_LDA(At, 1, 0); PG8_STAGE(PG8_SA(0, 1), a2, w1);
            PG8_WAIT_L(8); PG8_BAR; PG8_WAIT_L(0); PG8_MMA(0, 0, At, B0); PG8_BAR; PG8_SCHED;
            PG8_LDB(B1, 1, 1); PG8_STAGE(PG8_SB(1, 0), b3, voffB);
            PG8_BAR; PG8_WAIT_L(0); PG8_MMA(0, 1, At, B1); PG8_BAR;
            PG8_LDA(At, 1, 1); PG8_STAGE(PG8_SA(1, 0), a3, w0);
            PG8_BAR; PG8_WAIT_L(0); PG8_MMA(1, 0, At, B0); PG8_BAR; PG8_SCHED;
            PG8_STAGE(PG8_SB(1, 1), b3 + hstepB, voffB);
            PG8_WAIT_V(6); PG8_BAR; PG8_MMA(1, 1, At, B1); PG8_BAR;
        }
        asm volatile("s_nop 7\n\ts_nop 7\n\ts_nop 3" ::: "memory");
        E(acc, cur, wr, wc, fr, fq, epre);
        if (!has_next) break;
#pragma unroll
        for (int a = 0; a < 2; ++a)
#pragma unroll
            for (int b = 0; b < 2; ++b)
#pragma unroll
                for (int m = 0; m < 4; ++m)
#pragma unroll
                    for (int n = 0; n < 2; ++n) acc[a][b][m][n] = (f32x4){0.f, 0.f, 0.f, 0.f};
        cur = nxt; cA = nA; cB0 = nB0; cB1 = nB1; ++ui;
#pragma unroll
        for (int h = 0; h < 2; ++h) { vA[h][0] = nvA[h][0]; vA[h][1] = nvA[h][1]; }
    }
    PG8_WAIT_V(0);
    if (wr == 0) PG8_BAR;
    PG8_BAR;
#undef PG8_SA
#undef PG8_SB
#undef PG8_STAGE
#undef PG8_LDA
#undef PG8_LDB
#undef PG8_MMA
#undef PG8_WAIT_V
#undef PG8_WAIT_L
#undef PG8_BAR
#undef PG8_SCHED
#undef PG8_BPTR
}
struct EpiBf16 {
    static constexpr bool PERM = true;
    bf16_t* O; int ldc; int mode;
    DI void pre(const Unit&, int, int, float (&)[8]) const {}
    DI void operator()(const f32x4 (&acc)[2][2][4][2], const Unit& u, int wr, int wc, int fr, int fq, const float (&)[8]) const {
        const int row0 = u.pm * BM + wr * 64 + fr, colt = u.pn * BM;
        bf16_t* base;
        if (mode == 0) base = O + colt;
        else { const int t0 = colt, b = tok_batch(t0), key0 = tok_key(t0); base = O + (size_t)b * 768 * KEYS + key0; }
        const int col0 = wc * 32 + 8 * fq;
#pragma unroll
        for (int ai = 0; ai < 2; ++ai)
#pragma unroll
            for (int m = 0; m < 4; ++m) { bf16_t* rowp = base + (size_t)(row0 + ai * HALF + m * 16) * ldc + col0;
#pragma unroll
                for (int bj = 0; bj < 2; ++bj) { const f32x4 v0 = acc[ai][bj][m][0], v1 = acc[ai][bj][m][1];
                    u32x4 w; w.x = cvt_pk_bf16(v0[0], v0[1]); w.y = cvt_pk_bf16(v0[2], v0[3]); w.z = cvt_pk_bf16(v1[0], v1[1]); w.w = cvt_pk_bf16(v1[2], v1[3]);
                    *(u32x4*)(rowp + bj * HALF) = w; } }
    }
};
struct DenseSched {
    static constexpr bool GATHER = false; static constexpr int NSEG = 1;
    const char* A; const char* B; int lda, ldb, nM, nN, G, c;
    DI bool next(int i, Unit& u) const { const int L = i * G + c; if (L >= nM * nN) return false;
        const int grp = L / (8 * nN), rem = L % (8 * nN), fm = grp * 8, gsz = (nM - fm) < 8 ? (nM - fm) : 8; u.pm = fm + rem % gsz; u.pn = rem / gsz; u.aux = 0; return true; }
    DI const char* a_base(const Unit& u) const { return A + (size_t)u.pm * BM * lda * 2; }
    DI const char* b_base(const Unit& u, int) const { return B + (size_t)u.pn * BM * ldb * 2; }
    DI void a_rows(const Unit&, int&, int&) const {}
};
}

DI int build_tiles(const Frame& F, int l, int* tile_bucket  , int* boff  ) {
    const unsigned* cnt = F.wsp<unsigned>(WS_SYNC) + CNT_OFF_WORDS + l * 32;
    int* ntl = boff + NBUCKET + 1;
    __syncthreads();
    if (F.tid < NBUCKET) { const int c_ = (int)cnt[F.tid]; ntl[F.tid] = (c_ + 255) >> 8; ntl[NBUCKET + F.tid] = c_; }
    __syncthreads();
    if (F.tid <= NBUCKET) { int o = 0;
#pragma unroll
        for (int k = 0; k < NBUCKET; ++k) { const int v_ = ntl[k]; o += k < F.tid ? v_ : 0; }
        boff[F.tid] = o; }
    __syncthreads();
    if (F.tid < MAXTILES) { int b = 0;
#pragma unroll
        for (int k = 1; k < NBUCKET; ++k) b += F.tid >= boff[k] ? 1 : 0;
        tile_bucket[F.tid] = b; }
    __syncthreads();
    return boff[NBUCKET];
}
DI void bucket_experts(int bucket, int& elo, int& ehi) { const int g = bucket / 6, pr = bucket % 6; const int lo = pr < 3 ? 0 : (pr < 5 ? 1 : 2), hi = pr < 3 ? pr + 1 : (pr < 5 ? pr - 1 : 3); elo = g * 4 + lo; ehi = g * 4 + hi; }

typedef short bf16x8 __attribute__((ext_vector_type(8)));
typedef float f32x16 __attribute__((ext_vector_type(16)));
#define MFMA32(a, b, c) __builtin_amdgcn_mfma_f32_32x32x16_bf16((a), (b), (c), 0, 0, 0)
constexpr float LOG2E = 1.4426950408889634f;
DI int swap23(int x) { return (x & 0x13) | ((x & 4) << 1) | ((x & 8) >> 1); }
DI unsigned cvtpk(float lo, float hi) { unsigned r; asm volatile("s_nop 0\n\tv_cvt_pk_bf16_f32 %0, %1, %2" : "=v"(r) : "v"(lo), "v"(hi)); return r; }
DI void softmax_tile(f32x16 (&st)[2], float& m, float& ls, f32x16& oa, f32x16& ob, bf16x8 (&pf)[2][2]) {
    float mx = st[0][0];
#pragma unroll
    for (int i = 1; i < 16; ++i) mx = fmaxf(mx, st[0][i]);
#pragma unroll
    for (int i = 0; i < 16; ++i) mx = fmaxf(mx, st[1][i]);
    mx = fmaxf(mx, __shfl_xor(mx, 32));
    const bool need = mx > m + 8.f;
    if (__any(need)) { const float mn = need ? mx : m; const float al = __builtin_amdgcn_exp2f(m - mn); m = mn; ls *= al; oa *= al; ob *= al; }
    float ps = 0.f;
#pragma unroll
    for (int s = 0; s < 2; ++s)
#pragma unroll
        for (int i = 0; i < 16; ++i) { const float p = __builtin_amdgcn_exp2f(st[s][i] - m); ps += p; st[s][i] = p; }
    ls += ps;
#pragma unroll
    for (int s = 0; s < 2; ++s)
#pragma unroll
        for (int k = 0; k < 2; ++k) { u32x4 w; w[0] = cvtpk(st[s][8 * k], st[s][8 * k + 1]); w[1] = cvtpk(st[s][8 * k + 2], st[s][8 * k + 3]); w[2] = cvtpk(st[s][8 * k + 4], st[s][8 * k + 5]); w[3] = cvtpk(st[s][8 * k + 6], st[s][8 * k + 7]);
            pf[s][k] = __builtin_bit_cast(bf16x8, w); }
}
template <int MODE, bool CTXQ> DI void attn_mfma_unit(const Frame& F, int l, int b, int head, int qblk) {
    const KParams Pp = F.p;
    LAS unsigned char* lds = (LAS unsigned char*)F.lds;
    LAS float* rpb = (LAS float*)(lds + 32768);
    const int lane = F.lane, r = lane & 31, h = lane >> 5, w = F.wid;
    const bf16_t* proj = F.wsp<bf16_t>(WS_BIG + BIG_PROJ);
    const int kh = MODE == 0 ? head : (MODE == 1 ? 6 + head : 10 + head / 3);
    const bf16_t* KP = F.wsp<bf16_t>(WS_BIG + BIG_KPOST) + (size_t)(b * NKH + kh) * KEYS * 64;
    const bf16_t* VT = F.wsp<bf16_t>(WS_BIG + BIG_VT) + (size_t)(b * NKH + kh) * 64 * KEYS;
    const int sq = CTXQ ? 0 : qblk * 256 + w * 32 + r;
    const int t = CTXQ ? NLAT + b * CTXL + w * 32 + r : b * SEQ + sq;
    const int qrow = sq >> 6, qcol = sq & 63;
    __syncthreads();
    if (MODE == 0 && !CTXQ) for (int i = F.tid; i < 15 * 31; i += NWG_THREADS) rpb[i] = gin(Pp, 10)[((size_t)l * 6 + head) * 465 + i] * LOG2E;
    bf16x8 qf[4];
    { const bf16_t* src = proj + (size_t)t * 1024 + ((MODE == 0 ? 0 : (MODE == 1 ? 6 : 10)) + head) * 64 + 8 * h;
#pragma unroll
      for (int ks = 0; ks < 4; ++ks) qf[ks] = *(const bf16x8*)(src + 16 * ks); }
    int ntile, rlo = 0;
    if (CTXQ) ntile = 4;
    else if (MODE == 0) { const int R0 = qblk * 4; rlo = clampi(R0 - 4, 0, 120); const int rhi = clampi(R0 + 3 - 4, 0, 120) + 7; ntile = 4 + (rhi - rlo + 1); }
    else ntile = KEYS / 64;
    const int wrow = CTXQ ? 0 : (qblk * 256 + w * 32) >> 6;
    const int r0w = clampi(wrow - 4, 0, 120), c0 = clampi(qcol - 8, 0, 48);
    const int srow = F.tid >> 3, schunk = F.tid & 7;
    const unsigned sdst = (unsigned)(srow * 128 + ((schunk ^ ((srow >> 1) & 7)) << 4));
    const bf16_t* kg = KP + (size_t)srow * 64 + schunk * 8;
    const bf16_t* vg = VT + (size_t)srow * KEYS + schunk * 8;
#define TILE_KEY0(ti) ((MODE == 0 && !CTXQ && (ti) >= 4) ? CTXL + (rlo + (ti) - 4) * 64 : (ti) * 64)
    u32x4 kreg, vreg;
    { const int k0 = TILE_KEY0(0); kreg = *(const u32x4*)(kg + (size_t)k0 * 64); vreg = *(const u32x4*)(vg + k0); }
    *(LAS u32x4*)(lds + sdst) = kreg; *(LAS u32x4*)(lds + 16384 + sdst) = vreg;
    __syncthreads();
    constexpr int NO = MODE == 1 ? 4 : 2;
    f32x16 o[NO];
#pragma unroll
    for (int i = 0; i < NO; ++i)
#pragma unroll
        for (int j = 0; j < 16; ++j) o[i][j] = 0.f;
    float m1 = -1e30f, l1 = 0.f, m2 = -1e30f, l2 = 0.f;
    const unsigned krd = (unsigned)(swap23(r) * 128), vrd = (unsigned)(r * 128);
    const int kswz = (swap23(r) >> 1) & 7, vswz = (r >> 1) & 7;
#pragma unroll 1
    for (int ti = 0; ti < ntile; ++ti) {
        const int buf = ti & 1;
        if (ti + 1 < ntile) { const int k0 = TILE_KEY0(ti + 1); kreg = *(const u32x4*)(kg + (size_t)k0 * 64); vreg = *(const u32x4*)(vg + k0); }
        bool relevant = true; int krow = 0;
        if (MODE == 0 && !CTXQ && ti >= 4) { krow = rlo + ti - 4; relevant = krow >= r0w && krow < r0w + 8; }
        if (relevant) {
            LAS unsigned char* kb = lds + buf * 8192; LAS unsigned char* vb = lds + 16384 + buf * 8192;
#pragma unroll
            for (int pass = 0; pass < (MODE == 1 ? 2 : 1); ++pass) {
                if (pass == 1) __builtin_amdgcn_sched_barrier(0);
                f32x16 st[2];
#pragma unroll
                for (int s = 0; s < 2; ++s)
#pragma unroll
                    for (int j = 0; j < 16; ++j) st[s][j] = 0.f;
#pragma unroll
                for (int kk = 0; kk < (MODE == 1 ? 2 : 4); ++kk) { const int ks = MODE == 1 ? pass * 2 + kk : kk;
#pragma unroll
                    for (int s = 0; s < 2; ++s) { const bf16x8 kf = *(const LAS bf16x8*)(kb + s * 4096 + krd + (((2 * ks + h) ^ kswz) << 4)); st[s] = MFMA32(kf, qf[ks], st[s]); } }
                if (MODE == 0 && !CTXQ && ti >= 4) { const int dr = krow - wrow + 7;
#pragma unroll
                    for (int s = 0; s < 2; ++s)
#pragma unroll
                        for (int i = 0; i < 16; ++i) { const int kc = s * 32 + 16 * (i >> 3) + 8 * h + (i & 7); const int dc = clampi(kc - qcol + 15, 0, 30); const bool valid = kc >= c0 && kc < c0 + 16;
                            st[s][i] = valid ? st[s][i] + rpb[dr * 31 + dc] : -3e38f; } }
                bf16x8 pf[2][2];
                if (pass == 0) softmax_tile(st, m1, l1, o[0], o[1], pf); else softmax_tile(st, m2, l2, o[NO - 2], o[NO - 1], pf);
#pragma unroll
                for (int ds = 0; ds < 2; ++ds)
#pragma unroll
                    for (int s = 0; s < 2; ++s)
#pragma unroll
                        for (int k = 0; k < 2; ++k) { const bf16x8 vf = *(const LAS bf16x8*)(vb + ds * 4096 + vrd + (((4 * s + 2 * k + h) ^ vswz) << 4)); o[pass * 2 + ds] = MFMA32(vf, pf[s][k], o[pass * 2 + ds]); }
            }
        }
        if (ti + 1 < ntile) { *(LAS u32x4*)(lds + (buf ^ 1) * 8192 + sdst) = kreg; *(LAS u32x4*)(lds + 16384 + (buf ^ 1) * 8192 + sdst) = vreg; }
        __syncthreads();
    }
#undef TILE_KEY0
    l1 += __shfl_xor(l1, 32); const float inv1 = 1.f / l1;
    if (MODE == 1) { l2 += __shfl_xor(l2, 32); const float inv2 = 1.f / l2;
        const float lam = F.wsp<float>(WS_LAM)[l * 2], li = F.wsp<float>(WS_LAM)[l * 2 + 1]; const float c2 = lam * inv2; float ss = 0.f;
#pragma unroll
        for (int ds = 0; ds < 2; ++ds)
#pragma unroll
            for (int i = 0; i < 16; ++i) { const float v = o[ds][i] * inv1 - c2 * o[2 + ds][i]; o[ds][i] = v; ss += v * v; }
        ss += __shfl_xor(ss, 32);
        const float rstd = rsqrtf(ss * (1.f / 64) + 1e-6f) * (1.f - li); const float* sub = gin(Pp, 15) + l * 64;
#pragma unroll
        for (int ds = 0; ds < 2; ++ds)
#pragma unroll
            for (int i = 0; i < 16; ++i) o[ds][i] = o[ds][i] * rstd * sub[32 * ds + (i & 3) + 8 * (i >> 2) + 4 * h];
    } else {
#pragma unroll
        for (int ds = 0; ds < 2; ++ds)
#pragma unroll
            for (int i = 0; i < 16; ++i) o[ds][i] *= inv1;
    }
    bf16_t* dst = F.wsp<bf16_t>(WS_ACT) + (size_t)t * D + (MODE == 0 ? 0 : (MODE == 1 ? 384 : 640)) + head * 64 + 4 * h;
#pragma unroll
    for (int ds = 0; ds < 2; ++ds)
#pragma unroll
        for (int g = 0; g < 4; ++g) { u32x2 wv; wv[0] = cvtpk(o[ds][4 * g], o[ds][4 * g + 1]); wv[1] = cvtpk(o[ds][4 * g + 2], o[ds][4 * g + 3]); *(u32x2*)(dst + 32 * ds + 8 * g) = wv; }
}
DI float xhalf_sum(float v) { const auto r = __builtin_amdgcn_permlane32_swap(__float_as_uint(v), __float_as_uint(v), false, false); return __uint_as_float(r[0]) + __uint_as_float(r[1]); }
DI unsigned exp2_acc_pack(float x0, float x1, float& ps0, float& ps1) {
    float p0, p1; unsigned pk;
    asm volatile("v_exp_f32 %0, %5\n\tv_exp_f32 %1, %6\n\tv_add_f32 %2, %0, %2\n\tv_add_f32 %3, %1, %3\n\tv_cvt_pk_bf16_f32 %4, %0, %1"
                 : "=&v"(p0), "=&v"(p1), "+v"(ps0), "+v"(ps1), "=&v"(pk) : "v"(x0), "v"(x1));
    return pk;
}
DI void exp2_pair(float x0, float x1, float& p0, float& p1) { asm volatile("v_exp_f32 %0, %2\n\tv_exp_f32 %1, %3" : "=&v"(p0), "=&v"(p1) : "v"(x0), "v"(x1)); }
DI unsigned acc_pack2(float p0, float p1, float& ps0, float& ps1) {
    unsigned pk; asm volatile("v_add_f32 %0, %3, %0\n\tv_add_f32 %1, %4, %1\n\tv_cvt_pk_bf16_f32 %2, %3, %4" : "+v"(ps0), "+v"(ps1), "=&v"(pk) : "v"(p0), "v"(p1)); return pk; }
template <int NKS> DI void attn_stream_core(LAS unsigned char* lds, const int w, const int lane, const bf16_t* KP, const bf16_t* VT, const bf16x8 (&qf)[NKS], const int kc0, f32x16 (&o)[2], float& ls) {
    const int r = lane & 31, h = lane >> 5;
    const int drow = 8 * w + (lane >> 3), dch = (lane & 7) ^ ((drow >> 1) & 7);
    const bf16_t* kg = KP + (size_t)drow * 64 + dch * 8;
    const bf16_t* vg = VT + (size_t)drow * KEYS + dch * 8;
    LAS unsigned char* kdst = lds + w * 1024; LAS unsigned char* vdst = lds + 32768 + w * 1024;
#define DMA_K(ti, off) __builtin_amdgcn_global_load_lds((const unsigned*)(kg + (size_t)(ti) * 64 * 64), (LAS unsigned*)(kdst + (off)), 16, 0, 0)
#define DMA_V(ti, off) __builtin_amdgcn_global_load_lds((const unsigned*)(vg + (size_t)(ti) * 64), (LAS unsigned*)(vdst + (off)), 16, 0, 0)
    const unsigned krd = (unsigned)(swap23(r) * 128), vrd = (unsigned)(r * 128);
    const int kswz = (swap23(r) >> 1) & 7, vswz = (r >> 1) & 7;
#define KFRAG(kb, s, ks) (*(const LAS bf16x8*)((kb) + (s) * 4096 + krd + (((kc0 + 2 * (ks) + h) ^ kswz) << 4)))
#define VFRAG(vb, ds, s, k) (*(const LAS bf16x8*)((vb) + (ds) * 4096 + vrd + (((4 * (s) + 2 * (k) + h) ^ vswz) << 4)))
#define PIN __builtin_amdgcn_sched_barrier(0)
    constexpr int ntile = KEYS / 64, nstage = ntile / 2;
    const f32x16 zero16 = {0.f, 0.f, 0.f, 0.f, 0.f, 0.f, 0.f, 0.f, 0.f, 0.f, 0.f, 0.f, 0.f, 0.f, 0.f, 0.f};
    o[0] = zero16; o[1] = zero16;
    float ps0 = 0.f, ps1 = 0.f;
    DMA_K(0, 16384 + 8192); DMA_K(1, 0); DMA_K(2, 8192); DMA_V(0, 0); DMA_V(1, 8192);
    asm volatile("s_waitcnt vmcnt(0)" ::: "memory");
    __syncthreads();
    f32x16 sa[2], sb[2];
#pragma unroll
    for (int s = 0; s < 2; ++s) { sa[s] = MFMA32(KFRAG(lds + 16384 + 8192, s, 0), qf[0], zero16);
#pragma unroll
        for (int ks = 1; ks < NKS; ++ks) sa[s] = MFMA32(KFRAG(lds + 16384 + 8192, s, ks), qf[ks], sa[s]); }
    sb[0] = zero16; sb[1] = zero16;
    bf16x8 pfh[2], vfh[2][2];
    { const bf16x8 z8 = {0, 0, 0, 0, 0, 0, 0, 0}; pfh[0] = z8; pfh[1] = z8; vfh[0][0] = z8; vfh[0][1] = z8; vfh[1][0] = z8; vfh[1][1] = z8; }
    __syncthreads();
#define STREAM_TILE(SC, SN, kbn, vb) do { \
        bf16x8 kf0[NKS], kf1[NKS], vf0[2][2]; u32x4 pw0[2], pw1[2]; \
        _Pragma("unroll") for (int ks = 0; ks < NKS; ++ks) kf0[ks] = KFRAG(kbn, 0, ks); \
        _Pragma("unroll") for (int ds = 0; ds < 2; ++ds) _Pragma("unroll") for (int k = 0; k < 2; ++k) vf0[ds][k] = VFRAG(vb, ds, 0, k); \
        PIN; \
          \
        _Pragma("unroll") for (int g = 0; g < 8; ++g) { float e0, e1; \
            exp2_pair(SC[0][2 * g], SC[0][2 * g + 1], e0, e1); PIN; \
            if (g < 4) o[g & 1] = MFMA32(vfh[g & 1][g >> 1], pfh[g >> 1], o[g & 1]); \
            else if (g - 4 < NKS) SN[0] = MFMA32(kf0[g - 4], qf[g - 4], g == 4 ? zero16 : SN[0]); \
            if (g == 4) { _Pragma("unroll") for (int ks = 0; ks < NKS; ++ks) kf1[ks] = KFRAG(kbn, 1, ks); } \
            PIN; pw0[g >> 2][g & 3] = acc_pack2(e0, e1, ps0, ps1); \
            PIN; } \
          \
        _Pragma("unroll") for (int g = 0; g < 8; ++g) { float e0, e1; \
            exp2_pair(SC[1][2 * g], SC[1][2 * g + 1], e0, e1); PIN; \
            if (g < NKS) SN[1] = MFMA32(kf1[g], qf[g], g == 0 ? zero16 : SN[1]); \
            else if (g - NKS < 4) o[(g - NKS) & 1] = MFMA32(vf0[(g - NKS) & 1][(g - NKS) >> 1], __builtin_bit_cast(bf16x8, pw0[(g - NKS) >> 1]), o[(g - NKS) & 1]); \
            if (g == 1) { _Pragma("unroll") for (int ds = 0; ds < 2; ++ds) _Pragma("unroll") for (int k = 0; k < 2; ++k) vfh[ds][k] = VFRAG(vb, ds, 1, k); } \
            PIN; pw1[g >> 2][g & 3] = acc_pack2(e0, e1, ps0, ps1); \
            PIN; } \
        pfh[0] = __builtin_bit_cast(bf16x8, pw1[0]); pfh[1] = __builtin_bit_cast(bf16x8, pw1[1]); \
    } while (0)
    if (w >= 4) __builtin_amdgcn_s_setprio(1);
#pragma unroll 1
    for (int st = 0; st < nstage; ++st) {
        const int cur = (st & 1) * 16384, nxt = 16384 - cur;
        if (st + 1 < nstage) { DMA_K(2 * st + 3, nxt); if (2 * st + 4 < ntile) DMA_K(2 * st + 4, nxt + 8192); DMA_V(2 * st + 2, nxt); DMA_V(2 * st + 3, nxt + 8192); }
        STREAM_TILE(sa, sb, lds + cur, lds + 32768 + cur);
        STREAM_TILE(sb, sa, lds + cur + 8192, lds + 32768 + cur + 8192);
        asm volatile("s_waitcnt vmcnt(0)" ::: "memory");
        __syncthreads();
    }
#undef STREAM_TILE
    __builtin_amdgcn_s_setprio(0);
#pragma unroll
    for (int g = 0; g < 4; ++g) o[g & 1] = MFMA32(vfh[g & 1][g >> 1], pfh[g >> 1], o[g & 1]);
    ls = ps0 + ps1;
#undef DMA_K
#undef DMA_V
#undef KFRAG
#undef VFRAG
#undef PIN
}
DI void store_o64(LAS unsigned char* stg, bf16_t* gbase  , const f32x16 (&o)[2], int lane) {
    const int r = lane & 31, h = lane >> 5;
#pragma unroll
    for (int ds = 0; ds < 2; ++ds)
#pragma unroll
        for (int g = 0; g < 4; ++g) { u32x2 wv; wv[0] = cvtpk(o[ds][4 * g], o[ds][4 * g + 1]); wv[1] = cvtpk(o[ds][4 * g + 2], o[ds][4 * g + 3]);
            *(LAS u32x2*)(stg + r * 128 + (((4 * ds + g) ^ (r & 7)) << 4) + 8 * h) = wv; }
#pragma unroll
    for (int i = 0; i < 4; ++i) { const int idx = lane + 64 * i, row = idx >> 3, ch = idx & 7;
        const u32x4 v = *(const LAS u32x4*)(stg + row * 128 + ((ch ^ (row & 7)) << 4));
        *(u32x4*)(gbase + (size_t)row * D + ch * 8) = v; }
}
constexpr int OSTG_OFF = 65536 + 1024 + 32768;
DI void attn_fast_unit_c(const Frame& F, int l, int b, int head, int qblk) {
    const KParams Pp = F.p;
    LAS unsigned char* lds = (LAS unsigned char*)F.lds;
    const int lane = F.lane, r = lane & 31, h = lane >> 5, w = F.wid, kh = 10 + head / 3;
    const bf16_t* KP = F.wsp<bf16_t>(WS_BIG + BIG_KPOST) + (size_t)(b * NKH + kh) * KEYS * 64;
    const bf16_t* VT = F.wsp<bf16_t>(WS_BIG + BIG_VT) + (size_t)(b * NKH + kh) * 64 * KEYS;
    const int sq = qblk * 256 + w * 32 + r, t = b * SEQ + sq, qrow = sq >> 6, qcol = sq & 63;
    bf16x8 qf[4];
    { const bf16_t* src = F.wsp<bf16_t>(WS_BIG + BIG_PROJ) + (size_t)t * 1024 + (10 + head) * 64 + 8 * h;
#pragma unroll
      for (int ks = 0; ks < 4; ++ks) qf[ks] = *(const bf16x8*)(src + 16 * ks); }
    f32x16 o[2]; float ls;
    __syncthreads();
    attn_stream_core<4>(lds, w, lane, KP, VT, qf, 0, o, ls);
    ls = xhalf_sum(ls); const float inv = 1.f / ls;
#pragma unroll
    for (int ds = 0; ds < 2; ++ds)
#pragma unroll
        for (int i = 0; i < 16; ++i) o[ds][i] *= inv;
    store_o64(lds + OSTG_OFF + w * 4096, F.wsp<bf16_t>(WS_ACT) + (size_t)(b * SEQ + qblk * 256 + w * 32) * D + 640 + head * 64, o, lane);
}
DI bool gqa_fast_ok(const Frame& F, int l, int b, int kvh) {
    const float g = F.wsp<float>(WS_LAM)[32 + l];
    const float qb = 8.f * g * 1.0001f * 0.125f * LOG2E * 1.01f;
    const float k2 = __uint_as_float(F.wsp<unsigned>(WS_SYNC)[KMAX_OFF_WORDS + l * 48 + b * NKH + 10 + kvh]);
    return qb * qb * k2 < 3600.f;
}
DI bool attn_fast_unit_b(const Frame& F, int l, int b, int head, int qblk) {
    const KParams Pp = F.p;
    LAS unsigned char* lds = (LAS unsigned char*)F.lds;
    LAS float* wmax = (LAS float*)(lds + 65536);
    LAS float* exch = (LAS float*)(lds + 65536 + 1024);
    const int lane = F.lane, r = lane & 31, h = lane >> 5, w = F.wid, stream = w >> 2, qw = w & 3, kh = 6 + head;
    const bf16_t* KP = F.wsp<bf16_t>(WS_BIG + BIG_KPOST) + (size_t)(b * NKH + kh) * KEYS * 64;
    const bf16_t* VT = F.wsp<bf16_t>(WS_BIG + BIG_VT) + (size_t)(b * NKH + kh) * 64 * KEYS;
    const float* ropeB = F.wsp<float>(WS_ROPEB);
    const bf16_t* qsrc = F.wsp<bf16_t>(WS_BIG + BIG_PROJ) + (size_t)(b * SEQ + qblk * 256 + qw * 32 + r) * 1024 + (6 + head) * 64 + stream * 32 + 8 * h;
    float qn2 = 0.f;
#pragma unroll
    for (int half = 0; half < 2; ++half) {
        const bf16_t* src = qsrc + (size_t)half * 128 * 1024;
        float na = 0.f;
#pragma unroll
        for (int ks = 0; ks < 2; ++ks) { const u32x4 wv = *(const u32x4*)(src + 16 * ks);
#pragma unroll
            for (int j = 0; j < 4; ++j) { const float x = __uint_as_float(wv[j] << 16), y = __uint_as_float(wv[j] & 0xffff0000u); na += x * x + y * y; } }
        qn2 = fmaxf(qn2, xhalf_sum(na));
    }
#pragma unroll
    for (int of = 16; of; of >>= 1) qn2 = fmaxf(qn2, __shfl_xor(qn2, of));
    __syncthreads();
    if (lane == 0) wmax[w] = qn2;
    __syncthreads();
    bool fast;
    { float q2 = wmax[0];
#pragma unroll
      for (int i = 1; i < 8; ++i) q2 = fmaxf(q2, wmax[i]);
      const float k2 = __uint_as_float(F.wsp<unsigned>(WS_SYNC)[KMAX_OFF_WORDS + l * 48 + b * NKH + kh]);
      fast = q2 * k2 < 3600.f; }
    if (!fast) return false;
    const float lam = F.wsp<float>(WS_LAM)[l * 2], li = F.wsp<float>(WS_LAM)[l * 2 + 1];
#pragma unroll 1
    for (int half = 0; half < 2; ++half) {
        f32x16 o[2]; float ls;
        if (half) __syncthreads();
        bf16x8 qh[2]; qh[0] = *(const bf16x8*)(qsrc + (size_t)half * 128 * 1024); qh[1] = *(const bf16x8*)(qsrc + (size_t)half * 128 * 1024 + 16);
        attn_stream_core<2>(lds, w, lane, KP, VT, qh, stream * 4, o, ls);
        ls = xhalf_sum(ls);
        if (stream == 1) { const float c2 = lam / ls;
#pragma unroll
            for (int ds = 0; ds < 2; ++ds)
#pragma unroll
                for (int i = 0; i < 16; ++i) exch[(qw * 32 + ds * 16 + i) * 64 + lane] = o[ds][i] * c2; }
        f32x4 subv[2][4];
        if (stream == 0) { const float* sub = gin(Pp, 15) + l * 64 + 4 * h;
#pragma unroll
            for (int ds = 0; ds < 2; ++ds)
#pragma unroll
                for (int g = 0; g < 4; ++g) subv[ds][g] = *(const f32x4*)(sub + 32 * ds + 8 * g); }
        __syncthreads();
        if (stream == 0) { const float inv = 1.f / ls; float ss = 0.f;
#pragma unroll
            for (int ds = 0; ds < 2; ++ds)
#pragma unroll
                for (int i = 0; i < 16; ++i) { const float v = o[ds][i] * inv - exch[(qw * 32 + ds * 16 + i) * 64 + lane]; o[ds][i] = v; ss += v * v; }
            ss = xhalf_sum(ss);
            const float rstd = rsqrtf(ss * (1.f / 64) + 1e-6f) * (1.f - li);
#pragma unroll
            for (int ds = 0; ds < 2; ++ds)
#pragma unroll
                for (int i = 0; i < 16; ++i) o[ds][i] = o[ds][i] * rstd * subv[ds][i >> 2][i & 3];
            store_o64(lds + OSTG_OFF + w * 4096, F.wsp<bf16_t>(WS_ACT) + (size_t)(b * SEQ + qblk * 256 + half * 128 + qw * 32) * D + 384 + head * 64, o, lane); }
    }
    return true;
}
DI void attn_na_fast_unit(const Frame& F, int l, int b, int head, int qblk) {
    const KParams Pp = F.p;
    LAS unsigned char* lds = (LAS unsigned char*)F.lds;
    LAS float* rpb = (LAS float*)(lds + 65536);
    const int lane = F.lane, r = lane & 31, h = lane >> 5, w = F.wid;
    const bf16_t* KP = F.wsp<bf16_t>(WS_BIG + BIG_KPOST) + (size_t)(b * NKH + head) * KEYS * 64;
    const bf16_t* VT = F.wsp<bf16_t>(WS_BIG + BIG_VT) + (size_t)(b * NKH + head) * 64 * KEYS;
    const int sq = qblk * 256 + w * 32 + r, qcol = sq & 63;
    __syncthreads();
    for (int i = F.tid; i < 15 * 31; i += NWG_THREADS) rpb[i] = gin(Pp, 10)[((size_t)l * 6 + head) * 465 + i] * LOG2E;
    bf16x8 qf[4];
    { const bf16_t* src = F.wsp<bf16_t>(WS_BIG + BIG_PROJ) + (size_t)(b * SEQ + sq) * 1024 + head * 64 + 8 * h;
#pragma unroll
      for (int ks = 0; ks < 4; ++ks) qf[ks] = *(const bf16x8*)(src + 16 * ks); }
    const int R0 = qblk * 4, rlo = clampi(R0 - 4, 0, 120), rhi = clampi(R0 + 3 - 4, 0, 120) + 7, ntile = 4 + (rhi - rlo + 1);
    const int wrow = (qblk * 256 + w * 32) >> 6, r0w = clampi(wrow - 4, 0, 120), c0 = clampi(qcol - 8, 0, 48);
    const int tbase = 8 * h - c0;
    const int drow = 8 * w + (lane >> 3), dch = (lane & 7) ^ ((drow >> 1) & 7);
    const bf16_t* kg = KP + (size_t)drow * 64 + dch * 8;
    const bf16_t* vg = VT + (size_t)drow * KEYS + dch * 8;
    LAS unsigned char* kdst = lds + w * 1024; LAS unsigned char* vdst = lds + 32768 + w * 1024;
#define NA_KEY0(ti) ((ti) >= 4 ? CTXL + (rlo + (ti) - 4) * 64 : (ti) * 64)
#define NA_DMA(ti) do { const int k0_ = NA_KEY0(ti); __builtin_amdgcn_global_load_lds((const unsigned*)(kg + (size_t)k0_ * 64), (LAS unsigned*)(kdst + ((ti) & 3) * 8192), 16, 0, 0); \
                         __builtin_amdgcn_global_load_lds((const unsigned*)(vg + k0_), (LAS unsigned*)(vdst + ((ti) & 3) * 8192), 16, 0, 0); } while (0)
    const unsigned krd = (unsigned)(swap23(r) * 128), vrd = (unsigned)(r * 128);
    const int kswz = (swap23(r) >> 1) & 7, vswz = (r >> 1) & 7;
    const f32x16 zero16 = {0.f, 0.f, 0.f, 0.f, 0.f, 0.f, 0.f, 0.f, 0.f, 0.f, 0.f, 0.f, 0.f, 0.f, 0.f, 0.f};
    f32x16 o[2] = {zero16, zero16};
    float ps0 = 0.f, ps1 = 0.f;
    NA_DMA(0); NA_DMA(1); NA_DMA(2);
    asm volatile("s_waitcnt vmcnt(4) lgkmcnt(0)" ::: "memory");
    __builtin_amdgcn_s_barrier(); asm volatile("" ::: "memory");
#pragma unroll 1
    for (int ti = 0; ti < ntile; ++ti) {
        if (ti + 3 < ntile) NA_DMA(ti + 3);
        const int krow = rlo + ti - 4;
        const bool relevant = ti < 4 || (krow >= r0w && krow < r0w + 8);
        if (relevant) {
            LAS unsigned char* kb = lds + (ti & 3) * 8192; LAS unsigned char* vb = lds + 32768 + (ti & 3) * 8192;
            f32x16 st[2];
#pragma unroll
            for (int s_ = 0; s_ < 2; ++s_) { st[s_] = MFMA32(*(const LAS bf16x8*)(kb + s_ * 4096 + krd + (((0 + h) ^ kswz) << 4)), qf[0], zero16);
#pragma unroll
                for (int ks = 1; ks < 4; ++ks) st[s_] = MFMA32(*(const LAS bf16x8*)(kb + s_ * 4096 + krd + (((2 * ks + h) ^ kswz) << 4)), qf[ks], st[s_]); }
            if (ti >= 4) { LAS const float* brow = rpb + (krow - wrow + 7) * 31 + (8 * h - qcol + 15);
                float bv[2][16];
#pragma unroll
                for (int s_ = 0; s_ < 2; ++s_)
#pragma unroll
                    for (int i = 0; i < 16; ++i) { bv[s_][i] = brow[s_ * 32 + 16 * (i >> 3) + (i & 7)]; }
#pragma unroll
                for (int s_ = 0; s_ < 2; ++s_)
#pragma unroll
                    for (int i = 0; i < 16; ++i) asm volatile("" : "+v"(bv[s_][i]));
#pragma unroll
                for (int s_ = 0; s_ < 2; ++s_)
#pragma unroll
                    for (int i = 0; i < 16; ++i) { const int kcc = s_ * 32 + 16 * (i >> 3) + (i & 7); const bool valid = (unsigned)(kcc + tbase) < 16u; st[s_][i] = valid ? st[s_][i] + bv[s_][i] : -3e38f; }
            } else asm volatile("s_nop 7\n\ts_nop 7" ::: "memory");
            u32x4 pw[2][2];
#pragma unroll
            for (int s_ = 0; s_ < 2; ++s_)
#pragma unroll
                for (int g = 0; g < 8; ++g) pw[s_][g >> 2][g & 3] = exp2_acc_pack(st[s_][2 * g], st[s_][2 * g + 1], ps0, ps1);
            asm volatile("s_nop 1" ::: "memory");
#pragma unroll
            for (int ds = 0; ds < 2; ++ds)
#pragma unroll
                for (int s_ = 0; s_ < 2; ++s_)
#pragma unroll
                    for (int k = 0; k < 2; ++k) o[ds] = MFMA32(*(const LAS bf16x8*)(vb + ds * 4096 + vrd + (((4 * s_ + 2 * k + h) ^ vswz) << 4)), __builtin_bit_cast(bf16x8, pw[s_][k]), o[ds]);
        }
        if (ti + 3 < ntile) asm volatile("s_waitcnt vmcnt(4) lgkmcnt(0)" ::: "memory"); else asm volatile("s_waitcnt vmcnt(0) lgkmcnt(0)" ::: "memory");
        __builtin_amdgcn_s_barrier(); asm volatile("" ::: "memory");
    }
#undef NA_DMA
#undef NA_KEY0
    const float ls = xhalf_sum(ps0 + ps1), inv = 1.f / ls;
#pragma unroll
    for (int ds = 0; ds < 2; ++ds)
#pragma unroll
        for (int i = 0; i < 16; ++i) o[ds][i] *= inv;
    store_o64(lds + OSTG_OFF + w * 4096, F.wsp<bf16_t>(WS_ACT) + (size_t)(b * SEQ + qblk * 256 + w * 32) * D + head * 64, o, lane);
}
DI bool na_fast_ok(const Frame& F, int l, int b, int head) {
    const float q2 = __uint_as_float(F.wsp<unsigned>(WS_SYNC)[QMAX_OFF_WORDS + l * 64 + b * 16 + head]), k2 = __uint_as_float(F.wsp<unsigned>(WS_SYNC)[KMAX_OFF_WORDS + l * 48 + b * NKH + head]);
    const float bm = F.wsp<float>(WS_LAM)[16 + l * 6 + head];
    return sqrtf(q2 * k2) * 1.01f + bm < 60.f;
}
DI Frame relaunder(const Frame& F0) {
    Frame F = F0; int tid = F0.tid; asm volatile("" : "+v"(tid)); asm volatile("" : "+s"(F.ws), "+s"(F.p));
    F.tid = tid; F.wid = __builtin_amdgcn_readfirstlane(tid >> 6); F.lane = tid & 63; return F;
}
DI void phase_attn_mfma(const Frame& F0, int l) {
    unsigned slow_b = 0u, slow_c = 0u;
    { const Frame F = relaunder(F0); int it = 0;
      for (int u = F.wg; u < 512; u += F.nwg, ++it) { const int xs = u & 7, idx = u >> 3, pr = xs * 2 + (idx >> 5); if (!attn_fast_unit_b(F, l, pr >> 2, pr & 3, idx & 31)) slow_b |= 1u << it; } }
    if (slow_b) { const Frame F = relaunder(F0); int it = 0;
      for (int u = F.wg; u < 512; u += F.nwg, ++it) { const int xs = u & 7, idx = u >> 3, pr = xs * 2 + (idx >> 5); if (slow_b >> it & 1u) attn_mfma_unit<1, false>(F, l, pr >> 2, pr & 3, idx & 31); } }
    { const Frame F = relaunder(F0); int it = 0;
      const bool okc = gqa_fast_ok(F, l, (F.wg & 7) >> 1, F.wg & 1);
      for (int u = F.wg; u < 768; u += F.nwg, ++it) { const int xs = u & 7, idx = u >> 3; if ((F.nwg & 7) == 0 ? okc : gqa_fast_ok(F, l, xs >> 1, xs & 1)) attn_fast_unit_c(F, l, xs >> 1, (xs & 1) * 3 + (idx >> 5), idx & 31); else slow_c |= 1u << it; } }
    if (slow_c) { const Frame F = relaunder(F0); int it = 0;
      for (int u = F.wg; u < 768; u += F.nwg, ++it) { const int xs = u & 7, idx = u >> 3; if (slow_c >> it & 1u) attn_mfma_unit<2, false>(F, l, xs >> 1, (xs & 1) * 3 + (idx >> 5), idx & 31); } }
    unsigned slow_a = 0u;
    { const Frame F = relaunder(F0); int it = 0;
      unsigned oka = 0u;
      { int j = 0; for (int u = F.wg; u < 768 && j < 8; u += F.nwg, ++j) { const int pr = (u & 7) * 3 + ((u >> 3) >> 5); oka |= (na_fast_ok(F, l, pr / 6, pr % 6) ? 1u : 0u) << j; } }
      for (int u = F.wg; u < 768; u += F.nwg, ++it) { const int xs = u & 7, idx = u >> 3, pr = xs * 3 + (idx >> 5); if (it < 8 ? (oka >> it & 1u) != 0u : na_fast_ok(F, l, pr / 6, pr % 6)) attn_na_fast_unit(F, l, pr / 6, pr % 6, idx & 31); else slow_a |= 1u << it; } }
    if (slow_a) { const Frame F = relaunder(F0); int it = 0;
      for (int u = F.wg; u < 768; u += F.nwg, ++it) { const int xs = u & 7, idx = u >> 3, pr = xs * 3 + (idx >> 5); if (slow_a >> it & 1u) attn_mfma_unit<0, false>(F, l, pr / 6, pr % 6, idx & 31); } }
    if (l == 0) {
        { const Frame F = relaunder(F0); for (int u = F.wg; u < 24; u += F.nwg) attn_mfma_unit<0, true>(F, l, u / 6, u % 6, 0); }
        { const Frame F = relaunder(F0); for (int u = F.wg - 24; u >= 0 && u < 16; u += F.nwg) attn_mfma_unit<1, true>(F, l, u / 4, u % 4, 0); }
        { const Frame F = relaunder(F0); for (int u = F.wg - 40; u >= 0 && u < 24; u += F.nwg) attn_mfma_unit<2, true>(F, l, u / 6, u % 6, 0); }
    }
}

DI void phase_norm2(const Frame& F, int l) {
    const KParams Pp = F.p;
    const int M = l == 0 ? NT : NLAT;
    float* rw = F.lds;
    __syncthreads();
    for (int i = F.tid; i < 1024 * 20 / 4; i += NWG_THREADS) *(f32x4*)(rw + 4 * i) = *(const f32x4*)(F.wsp<float>(WS_RWT) + (size_t)l * 20480 + 4 * i);
    __syncthreads();
    int* sp_tok = F.wsp<int>(WS_SPTOK); float* sp_w = F.wsp<float>(WS_SPW);
    const float* gain = gin(Pp, 7) + l * D;
    bf16_t* act = F.wsp<bf16_t>(WS_ACT);
    const bf16_t* tmp16 = F.wsp<bf16_t>(WS_BIG);
    unsigned* cnt = F.wsp<unsigned>(WS_SYNC) + CNT_OFF_WORDS + l * 32;
    int4* tokinfo = F.wsp<int4>(WS_TOKINFO);
    const int stride = F.nwg * 8;
    float* lgs = rw + 20 * 1024 + F.wid * 1280;
    int nrow = 0;
    for (int t0 = 2 * (F.wg * 8 + F.wid); t0 < M; t0 += 2 * stride) {
      const int tt[2] = {t0, t0 + 1};
      const float* m = mod_row(F, l, tok_modrow(t0));
      f32x4 g1v[4], rxf[2][4]; u32x2 rxb[2][4], rtr[2][4];
#pragma unroll
      for (int i = 0; i < 4; ++i) g1v[i] = *(const f32x4*)(m + 2048 + (i * 64 + F.lane) * 4);
#pragma unroll
      for (int r = 0; r < 2; ++r) { const int t = tt[r]; const float* xs = xin_row(F, t); const bf16_t* xq = xres_row(F, t); const bf16_t* tr = tmp16 + (size_t)t * D;
#pragma unroll
          for (int i = 0; i < 4; ++i) { const int k = (i * 64 + F.lane) * 4;
              if (l == 0) rxf[r][i] = *(const f32x4*)(xs + k); else rxb[r][i] = *(const u32x2*)(xq + k);
              rtr[r][i] = *(const u32x2*)(tr + k); } }
      f32x4 gsv[4], shv[4];
#pragma unroll
      for (int i = 0; i < 4; ++i) { const int k = (i * 64 + F.lane) * 4; gsv[i] = *(const f32x4*)(gain + k); shv[i] = *(const f32x4*)(m + 3072 + k); }
      f32x4 scv[4];
#pragma unroll
      for (int i = 0; i < 4; ++i) scv[i] = *(const f32x4*)(m + 4096 + (i * 64 + F.lane) * 4);
      f32x4 vv[2][4]; float ssq[2] = {0.f, 0.f};
#pragma unroll
      for (int r = 0; r < 2; ++r) { bf16_t* xd = xres_row(F, tt[r]);
#pragma unroll
          for (int i = 0; i < 4; ++i) { const int k = (i * 64 + F.lane) * 4;
              const f32x4 xv = l == 0 ? rxf[r][i] : bf4_to_f32(rxb[r][i]);
              vv[r][i] = xv + g1v[i] * bf4_to_f32(rtr[r][i]);
              { u32x2 xo; xo[0] = cvtpk_rne(vv[r][i][0], vv[r][i][1]); xo[1] = cvtpk_rne(vv[r][i][2], vv[r][i][3]); *(u32x2*)(xd + k) = xo; }
              ssq[r] += vv[r][i][0] * vv[r][i][0] + vv[r][i][1] * vv[r][i][1] + vv[r][i][2] * vv[r][i][2] + vv[r][i][3] * vv[r][i][3]; } }
#pragma unroll
      for (int i = 0; i < 4; ++i) gsv[i] = gsv[i] * (scv[i] + 1.f);
      ssq[0] = wave_sum(ssq[0]); ssq[1] = wave_sum(ssq[1]);
#pragma unroll
      for (int r = 0; r < 2; ++r) {
        const int t = tt[r];
        const float rstd = rsqrtf(ssq[r] * (1.f / D) + 1e-6f);
        float lg[20];
        f32x2 lgp[20];
#pragma unroll
        for (int j = 0; j < 20; ++j) lgp[j] = (f32x2){0.f, 0.f};
#pragma unroll
        for (int i = 0; i < 4; ++i) { const int k = (i * 64 + F.lane) * 4;
            const f32x4 h = vv[r][i] * rstd * gsv[i] + shv[i];
            u32x2 o; o[0] = cvtpk_rne(h[0], h[1]); o[1] = cvtpk_rne(h[2], h[3]);
            *(u32x2*)(act + (size_t)t * D + k) = o;
            const f32x2 h01 = {h[0], h[1]}, h23 = {h[2], h[3]};
#pragma unroll
            for (int j = 0; j < 20; ++j) { const f32x4 w = *(const f32x4*)(rw + j * 1024 + k);
                lgp[j] = __builtin_elementwise_fma(h01, (f32x2){w[0], w[1]}, lgp[j]); lgp[j] = __builtin_elementwise_fma(h23, (f32x2){w[2], w[3]}, lgp[j]); }
            __builtin_amdgcn_sched_barrier(0); }
#pragma unroll
        for (int j = 0; j < 20; ++j) lg[j] = lgp[j][0] + lgp[j][1];
        float ra[10], rb[5];
#pragma unroll
        for (int j = 0; j < 10; ++j) ra[j] = swap32_sum(lg[j], lg[j + 10]);
#pragma unroll
        for (int j = 0; j < 5; ++j) rb[j] = dpp_row_sum(swap16_sum(ra[j], ra[j + 5]));
        if ((F.lane & 15) == 0) {
#pragma unroll
            for (int j = 0; j < 5; ++j) lgs[nrow * 20 + 5 * (F.lane >> 4) + j] = rb[j]; }
        ++nrow;
      }
    }
    if (F.lane < nrow) {
        const int t = 2 * (F.wg * 8 + F.wid) + (F.lane >> 1) * 2 * stride + (F.lane & 1);
        float lg[20];
#pragma unroll
        for (int q = 0; q < 5; ++q) { const f32x4 v = *(const f32x4*)(lgs + F.lane * 20 + 4 * q); lg[4 * q] = v[0]; lg[4 * q + 1] = v[1]; lg[4 * q + 2] = v[2]; lg[4 * q + 3] = v[3]; }
        {
            float bge[20];
#pragma unroll
            for (int j = 0; j < 4; ++j) bge[j] = gin(Pp, 19)[l * 4 + j];
#pragma unroll
            for (int j = 0; j < 16; ++j) bge[4 + j] = gin(Pp, 21)[l * 16 + j];
#pragma unroll
            for (int j = 0; j < 20; ++j) asm volatile("" : "+v"(bge[j]));
            float gl[4];
#pragma unroll
            for (int j = 0; j < 4; ++j) gl[j] = lg[j] + bge[j];
            int gs = 0; float gmax = gl[0];
#pragma unroll
            for (int j = 1; j < 4; ++j) if (gl[j] > gmax) { gmax = gl[j]; gs = j; }
            float den = 0.f;
#pragma unroll
            for (int j = 0; j < 4; ++j) den += expf(gl[j] - gmax);
            const float pg = 1.f / den;
            float ev[4];
#pragma unroll
            for (int j = 0; j < 4; ++j) { float x = 0.f;
#pragma unroll
                for (int g2 = 0; g2 < 4; ++g2) x = (g2 == gs) ? lg[4 + g2 * 4 + j] + bge[4 + g2 * 4 + j] : x;
                ev[j] = x; }
            int i1 = 0; float v1 = ev[0];
#pragma unroll
            for (int j = 1; j < 4; ++j) if (ev[j] > v1) { v1 = ev[j]; i1 = j; }
            int i2 = -1; float v2 = 0.f;
#pragma unroll
            for (int j = 0; j < 4; ++j) if (j != i1 && (i2 < 0 || ev[j] > v2)) { v2 = ev[j]; i2 = j; }
            const float w1 = 1.f / (1.f + expf(v2 - v1)), w2 = 1.f - w1;
            const int lo = i1 < i2 ? i1 : i2, hi = i1 < i2 ? i2 : i1;
            const float wlo = (i1 < i2 ? w1 : w2) * pg, whi = (i1 < i2 ? w2 : w1) * pg;
            const int pr = lo == 0 ? hi - 1 : (lo == 1 ? hi + 1 : 5);
            const int bucket = gs * 6 + pr;
            const unsigned rank = atomicAdd(&cnt[bucket], 1u);
            tokinfo[t] = make_int4(bucket, (int)rank, __float_as_int(wlo), __float_as_int(whi));
            { const size_t sp = (size_t)bucket * SPCAP + rank; sp_tok[sp] = t; *(float2*)(sp_w + 2 * sp) = make_float2(wlo, whi); }
        }
    }
}

DI void phase_scatter(const Frame& F, int l) {
    const int M = l == 0 ? NT : NLAT;
    int* tile_bucket = (int*)F.lds; int* boff = tile_bucket + MAXTILES;
    build_tiles(F, l, tile_bucket, boff);
    const int4* tokinfo = F.wsp<int4>(WS_TOKINFO);
    int* slot_tok = F.wsp<int>(WS_SLOTTOK); int* tok_slot = F.wsp<int>(WS_TOKSLOT); float* slot_w = F.wsp<float>(WS_SLOTW);
    for (int t = F.wg * NWG_THREADS + F.tid; t < M; t += F.nwg * NWG_THREADS) {
        const int4 ti = tokinfo[t];
        const int slot = boff[ti.x] * 256 + ti.y;
        slot_tok[slot] = t; tok_slot[t] = slot; slot_w[slot * 2] = __int_as_float(ti.z); slot_w[slot * 2 + 1] = __int_as_float(ti.w);
    }
}

constexpr int TAB_OFF = pg8::STAGE_BYTES;
struct InSched {
    static constexpr bool GATHER = false; static constexpr int NSEG = 1;
    const char* act; const char* W; int G, c;
    DI bool next(int i, pg8::Unit& u) const { const int L = i * G + c; if (L >= 1320) return false;
        const int grp = L / 80, rem = L % 80, fm = grp * 8, gsz = (132 - fm) < 8 ? (132 - fm) : 8, panel = fm + rem % gsz, slot = rem / gsz;
        if (slot < 7) { u.pm = panel; u.pn = slot; u.aux = 0; } else { u.pm = slot - 7; u.pn = panel; u.aux = 1; }
        return true; }
    DI const char* a_base(const pg8::Unit& u) const { return u.aux == 0 ? act + (size_t)u.pm * 256 * D * 2 : W + (size_t)(QKW + u.pm * 256) * D * 2; }
    DI const char* b_base(const pg8::Unit& u, int) const { return u.aux == 0 ? W + (size_t)u.pn * 256 * D * 2 : act + (size_t)u.pn * 256 * D * 2; }
    DI void a_rows(const pg8::Unit&, int&, int&) const {}
};
struct InEpi {
    static constexpr bool PERM = true;
    bf16_t* qpost; bf16_t* kpost; bf16_t* VT; LAS const float* ropeB; LAS const float* ropeC; LAS const float* qn; LAS const float* kn; LAS unsigned* lmax;
    DI void pre(const pg8::Unit&, int, int, float (&)[8]) const {}
    DI void operator()(const f32x4 (&acc)[2][2][4][2], const pg8::Unit& u, int wr, int wc, int fr, int fq, const float (&epre)[8]) const {
        if (u.aux != 0) { pg8::EpiBf16 e{VT, KEYS, 1}; e(acc, u, wr, wc, fr, fq, epre); return; }
        const int hs = 4 * u.pn + wc;
        const bool isq = hs < 6 || (hs >= 12 && hs < 16) || (hs >= 20 && hs < 26), isb = hs >= 12 && hs < 20, isc = hs >= 20;
        const int hh = hs < 6 ? hs : (hs < 12 ? hs - 6 : (hs < 16 ? hs - 12 : (hs < 20 ? hs - 16 : (hs < 26 ? hs - 20 : hs - 26))));
        const int hidx = (isb ? 6 : (isc ? 10 : 0)) + hh;
        const int t0 = u.pm * 256; const bool lat = t0 < NLAT; const int b = lat ? (t0 >> 13) : ((t0 - NLAT) >> 8);
        const int elo = isb ? 32 * (fq >> 1) + 8 * (fq & 1) : 8 * fq, ehi = isb ? elo + 16 : elo + 32;
        f32x4 glo[2], ghi[2];
        if (isc) { LAS const float* g = isq ? qn : kn; glo[0] = *(LAS const f32x4*)(g + elo); glo[1] = *(LAS const f32x4*)(g + elo + 4); ghi[0] = *(LAS const f32x4*)(g + ehi); ghi[1] = *(LAS const f32x4*)(g + ehi + 4); }
        const float qscale = (isb ? 0.17677669529663689f : 0.125f) * LOG2E;
        float kmx = 0.f;
#pragma unroll
        for (int ai = 0; ai < 2; ++ai)
#pragma unroll
            for (int m = 0; m < 4; ++m) {
                const int t = t0 + 128 * ai + 64 * wr + 16 * m + fr, sp = t & (SEQ - 1), grow = sp >> 6, gcol = sp & 63;
                f32x4 lo[2] = {acc[ai][0][m][0], acc[ai][0][m][1]}, hi[2] = {acc[ai][1][m][0], acc[ai][1][m][1]};
                if (isc) { float ss = 0.f;
#pragma unroll
                    for (int q = 0; q < 2; ++q) ss += lo[q][0] * lo[q][0] + lo[q][1] * lo[q][1] + lo[q][2] * lo[q][2] + lo[q][3] * lo[q][3] + hi[q][0] * hi[q][0] + hi[q][1] * hi[q][1] + hi[q][2] * hi[q][2] + hi[q][3] * hi[q][3];
                    ss = swap16_sum(ss, ss); ss = swap32_sum(ss, ss);
                    const float rstd = rsqrtf(ss * (1.f / 64) + 1e-6f);
#pragma unroll
                    for (int q = 0; q < 2; ++q) { lo[q] = lo[q] * rstd * glo[q]; hi[q] = hi[q] * rstd * ghi[q]; } }
                if ((isb || isc) && lat) {
                    LAS const float* tab = isb ? ropeB + (((fq & 1) == 0 ? grow : gcol) * 8) * 2 : ropeC + ((fq < 2 ? grow : gcol) * 16 + 8 * (fq & 1)) * 2;
#pragma unroll
                    for (int q = 0; q < 2; ++q) { const f32x4 c0 = *(LAS const f32x4*)(tab + 8 * q), c1 = *(LAS const f32x4*)(tab + 8 * q + 4);
                        const f32x4 x1 = lo[q], x2 = hi[q];
                        lo[q] = (f32x4){x1[0] * c0[0] - x2[0] * c0[1], x1[1] * c0[2] - x2[1] * c0[3], x1[2] * c1[0] - x2[2] * c1[1], x1[3] * c1[2] - x2[3] * c1[3]};
                        hi[q] = (f32x4){x2[0] * c0[0] + x1[0] * c0[1], x2[1] * c0[2] + x1[1] * c0[3], x2[2] * c1[0] + x1[2] * c1[1], x2[3] * c1[2] + x1[3] * c1[3]}; } }
                if (isq) {
#pragma unroll
                    for (int q = 0; q < 2; ++q) { lo[q] = lo[q] * qscale; hi[q] = hi[q] * qscale; } }
                u32x4 wl, wh;
                wl[0] = cvtpk(lo[0][0], lo[0][1]); wl[1] = cvtpk(lo[0][2], lo[0][3]); wl[2] = cvtpk(lo[1][0], lo[1][1]); wl[3] = cvtpk(lo[1][2], lo[1][3]);
                wh[0] = cvtpk(hi[0][0], hi[0][1]); wh[1] = cvtpk(hi[0][2], hi[0][3]); wh[2] = cvtpk(hi[1][0], hi[1][1]); wh[3] = cvtpk(hi[1][2], hi[1][3]);
                bf16_t* dst;
                if (isq) dst = qpost + (size_t)t * 1024 + hidx * 64;
                else { const int key = lat ? CTXL + sp : ((t - NLAT) & (CTXL - 1)); dst = kpost + ((size_t)(b * NKH + hidx) * KEYS + key) * 64; }
                *(u32x4*)(dst + elo) = wl; *(u32x4*)(dst + ehi) = wh;
                { float n2 = 0.f;
#pragma unroll
                    for (int q = 0; q < 4; ++q) { const float a0 = __uint_as_float(wl[q] << 16), a1 = __uint_as_float(wl[q] & 0xffff0000u), b0 = __uint_as_float(wh[q] << 16), b1 = __uint_as_float(wh[q] & 0xffff0000u); n2 += a0 * a0 + a1 * a1 + b0 * b0 + b1 * b1; }
                    n2 = swap16_sum(n2, n2);
                    if (!isb) n2 = swap32_sum(n2, n2);
                    kmx = fmaxf(kmx, n2); }
            }
        {
#pragma unroll
            for (int of = 32; of; of >>= 1) kmx = fmaxf(kmx, __shfl_xor(kmx, of));
            if (fr == 0 && fq == 0) __hip_atomic_fetch_max(isq ? lmax + 48 + b * 16 + hidx : lmax + b * NKH + hidx, __float_as_uint(kmx), __ATOMIC_RELAXED, __HIP_MEMORY_SCOPE_WORKGROUP); }
    }
};
DI void phase_gemm_in_mfma(const Frame& F, int l) {
    const char* act = (const char*)F.wsp<bf16_t>(WS_ACT);
    const char* W = (const char*)(F.wsp<bf16_t>(WS_WINT) + (size_t)l * INW * D);
    InSched S{act, W, F.nwg, F.wg};
    LAS float* rl = (LAS float*)((LAS char*)F.lds + TAB_OFF);
    __syncthreads();
    static_assert(WS_ROPEC == WS_ROPEB + 2048 * 4, "rope tables contiguous");
    for (int i = F.tid; i < (2048 + 4096) / 4; i += NWG_THREADS) *(LAS f32x4*)(rl + 4 * i) = *(const f32x4*)(F.wsp<float>(WS_ROPEB) + 4 * i);
    if (F.tid < 128) rl[6144 + 112 + F.tid] = F.tid < 64 ? gin(F.p, 16)[l * 64 + F.tid] : gin(F.p, 17)[l * 64 + F.tid - 64];
    LAS unsigned* lmax = (LAS unsigned*)(rl + 6144);
    if (F.tid < 112) lmax[F.tid] = 0u;
    __syncthreads();
    InEpi E{F.wsp<bf16_t>(WS_BIG + BIG_PROJ), F.wsp<bf16_t>(WS_BIG + BIG_KPOST), F.wsp<bf16_t>(WS_BIG + BIG_VT), rl, rl + 2048, rl + 6144 + 112, rl + 6144 + 112 + 64, lmax};
    pg8::gemm_phase((LAS unsigned char*)F.lds, D, D, D, S, E);
    __syncthreads();
    if (F.tid < 112) { const unsigned v = lmax[F.tid];
        if (v != 0u) atomicMax(F.tid < 48 ? F.wsp<unsigned>(WS_SYNC) + KMAX_OFF_WORDS + l * 48 + F.tid : F.wsp<unsigned>(WS_SYNC) + QMAX_OFF_WORDS + l * 64 + (F.tid - 48), v); }
}
DI void phase_gemm_out_mfma(const Frame& F, int l) {
    const int M = l == 0 ? NT : NLAT;
    pg8::DenseSched S{(const char*)F.wsp<bf16_t>(WS_ACT), (const char*)(F.wsp<bf16_t>(WS_WOUTT) + (size_t)l * D * D), D, D, M / 256, 4, F.nwg, F.wg};
    pg8::EpiBf16 E{F.wsp<bf16_t>(WS_BIG), D, 0};
    pg8::gemm_phase((LAS unsigned char*)F.lds, D, D, D, S, E);
}
struct EpiMoe1 {
    static constexpr bool PERM = true;
    bf16_t* hid; const float* sp_w; const int* boff;
    DI void pre(const pg8::Unit& u, int wr, int fr, float (&epre)[8]) const {
        const int b = u.aux, base = (u.pm - boff[b]) * 256 + wr * 64 + fr, cm = boff[NBUCKET + 1 + NBUCKET + b] - 1, j = u.pn >> 2; const float* spw = sp_w + (size_t)b * SPCAP * 2;
#pragma unroll
        for (int ai = 0; ai < 2; ++ai)
#pragma unroll
            for (int m = 0; m < 4; ++m) { const int i_ = base + ai * 128 + m * 16; const float w_ = spw[(size_t)(i_ < cm ? i_ : cm) * 2 + j]; epre[ai * 4 + m] = i_ <= cm ? w_ : 0.f; } }
    DI void operator()(const f32x4 (&acc)[2][2][4][2], const pg8::Unit& u, int wr, int wc, int fr, int fq, const float (&epre)[8]) const {
        const int row0 = u.pm * 256 + wr * 64 + fr, j = u.pn >> 2, colb = j * 512 + (u.pn & 3) * 128 + 16 * wc + 4 * fq;
#pragma unroll
        for (int ai = 0; ai < 2; ++ai)
#pragma unroll
            for (int m = 0; m < 4; ++m) { const int slot = row0 + ai * 128 + m * 16; const float w = epre[ai * 4 + m];
#pragma unroll
                for (int bj = 0; bj < 2; ++bj) { const f32x4 v0 = acc[ai][bj][m][0], v1 = acc[ai][bj][m][1];
                    const float h0 = v0[0] * __builtin_amdgcn_rcpf(1.f + __builtin_amdgcn_exp2f(-v0[0] * LOG2E)) * v0[1] * w, h1 = v0[2] * __builtin_amdgcn_rcpf(1.f + __builtin_amdgcn_exp2f(-v0[2] * LOG2E)) * v0[3] * w;
                    const float h2 = v1[0] * __builtin_amdgcn_rcpf(1.f + __builtin_amdgcn_exp2f(-v1[0] * LOG2E)) * v1[1] * w, h3 = v1[2] * __builtin_amdgcn_rcpf(1.f + __builtin_amdgcn_exp2f(-v1[2] * LOG2E)) * v1[3] * w;
                    u32x2 o; o[0] = pg8::cvt_pk_bf16(h0, h1); o[1] = pg8::cvt_pk_bf16(h2, h3);
                    *(u32x2*)(hid + (size_t)slot * D + colb + 64 * bj) = o; } }
    }
};
struct Moe1Sched {
    static constexpr bool GATHER = true; static constexpr int NSEG = 1;
    const char* act; const char* W; const int* sp_tok; const int* tile_bucket; const int* boff; int ntiles, G, c;
    DI bool next(int i, pg8::Unit& u) const { const int U = ntiles * 8, x = c & 7, nper = (G - 1 - x) / 8 + 1, lo = (x * U) >> 3, hi = ((x + 1) * U) >> 3, j = lo + i * nper + (c >> 3);
        if (j >= hi) return false; u.pm = j >> 3; u.pn = j & 7; u.aux = tile_bucket[u.pm]; return true; }
    DI const char* a_base(const pg8::Unit&) const { return act; }
    DI const char* b_base(const pg8::Unit& u, int) const { int elo, ehi; bucket_experts(u.aux, elo, ehi); const int e = u.pn < 4 ? elo : ehi; return W + ((size_t)e * 1024 + (u.pn & 3) * 256) * D * 2; }
    DI void a_rows(const pg8::Unit& u, int& r0, int& r1) const { const int b = u.aux, base = (u.pm - boff[b]) * 256, cm = boff[NBUCKET + 1 + NBUCKET + b] - 1; const int* st = sp_tok + (size_t)b * SPCAP;
        const int i0 = base + r0, i1 = base + r1; r0 = st[i0 < cm ? i0 : cm]; r1 = st[i1 < cm ? i1 : cm]; }
};
struct Moe2Sched {
    static constexpr bool GATHER = false; static constexpr int NSEG = 2;
    const char* hid; const char* W; const int* tile_bucket; int ntiles, G, c;
    DI bool next(int i, pg8::Unit& u) const { const int U = ntiles * 4, x = c & 7, nper = (G - 1 - x) / 8 + 1, lo = (x * U) >> 3, hi = ((x + 1) * U) >> 3, j = lo + i * nper + (c >> 3);
        if (j >= hi) return false; u.pm = j >> 2; u.pn = j & 3; u.aux = tile_bucket[u.pm]; return true; }
    DI const char* a_base(const pg8::Unit& u) const { return hid + (size_t)u.pm * 256 * D * 2; }
    DI const char* b_base(const pg8::Unit& u, int seg) const { int elo, ehi; bucket_experts(u.aux, elo, ehi); return W + ((size_t)(seg == 0 ? elo : ehi) * 1024 + u.pn * 256) * 512 * 2; }
    DI void a_rows(const pg8::Unit&, int&, int&) const {}
};
DI void phase_gemm1_mfma(const Frame& F, int l) {
    int* tile_bucket = (int*)((char*)F.lds + TAB_OFF); int* boff = tile_bucket + MAXTILES;
    const int ntiles = build_tiles(F, l, tile_bucket, boff);
    Moe1Sched S{(const char*)F.wsp<bf16_t>(WS_ACT), (const char*)(F.wsp<bf16_t>(WS_WGU) + (size_t)l * 16 * 1024 * 1024), F.wsp<int>(WS_SPTOK), tile_bucket, boff, ntiles, F.nwg, F.wg};
    EpiMoe1 E{F.wsp<bf16_t>(WS_BIG), F.wsp<float>(WS_SPW), boff};
    pg8::gemm_phase((LAS unsigned char*)F.lds, D, D, D, S, E);
}
DI void phase_gemm2_mfma(const Frame& F, int l) {
    int* tile_bucket = (int*)((char*)F.lds + TAB_OFF); int* boff = tile_bucket + MAXTILES;
    const int ntiles = build_tiles(F, l, tile_bucket, boff);
    Moe2Sched S{(const char*)F.wsp<bf16_t>(WS_BIG), (const char*)(F.wsp<bf16_t>(WS_WDT) + (size_t)l * 16 * 1024 * 512), tile_bucket, ntiles, F.nwg, F.wg};
    pg8::EpiBf16 E{F.wsp<bf16_t>(WS_BIG + BIG_Y16), D, 0};
    pg8::gemm_phase((LAS unsigned char*)F.lds, D, D, 512, S, E);
}

DI void phase_final(const Frame& F) {
    const KParams Pp = F.p;
    const bf16_t* y16 = F.wsp<bf16_t>(WS_BIG + BIG_Y16); const int4* tokinfo = F.wsp<int4>(WS_TOKINFO);
    int* tile_bucket = (int*)F.lds; int* boff = tile_bucket + MAXTILES;
    build_tiles(F, 1, tile_bucket, boff);
    const int stride = F.nwg * 8;
    u32x2 rxb[2][4], ryb[2][4]; int nsl[2] = {0, 0};
#pragma unroll
    for (int r = 0; r < 2; ++r)
#pragma unroll
        for (int i = 0; i < 4; ++i) { rxb[r][i] = (u32x2){0u, 0u}; ryb[r][i] = (u32x2){0u, 0u}; }
#define FN_SLOTS(T0) if ((T0) < NLAT) { const int2 i0_ = *(const int2*)(tokinfo + (T0)), i1_ = *(const int2*)(tokinfo + (T0) + 1); nsl[0] = boff[i0_.x] * 256 + i0_.y; nsl[1] = boff[i1_.x] * 256 + i1_.y; }
#define FN_ISSUE(T0) if ((T0) < NLAT) { \
        _Pragma("unroll") for (int r = 0; r < 2; ++r) { const bf16_t* s_ = xres_row(F, (T0) + r); const bf16_t* yr_ = y16 + (size_t)nsl[r] * D; \
            _Pragma("unroll") for (int i = 0; i < 4; ++i) { const int k = (i * 64 + F.lane) * 4; rxb[r][i] = *(const u32x2*)(s_ + k); ryb[r][i] = *(const u32x2*)(yr_ + k); } } }
    const int tfirst = 2 * (F.wg * 8 + F.wid);
    FN_SLOTS(tfirst)
    FN_ISSUE(tfirst)
    FN_SLOTS(tfirst + 2 * stride)
    f32x4 gf[4];
#pragma unroll
    for (int i = 0; i < 4; ++i) gf[i] = *(const f32x4*)(gin(Pp, 25) + (i * 64 + F.lane) * 4);
    for (int t0 = tfirst; t0 < NLAT; t0 += 2 * stride) {
        const int tt[2] = {t0, t0 + 1};
        const float* g2 = mod_row(F, 1, t0 >> 13) + 5120;
        f32x4 g2v[4];
#pragma unroll
        for (int i = 0; i < 4; ++i) g2v[i] = *(const f32x4*)(g2 + (i * 64 + F.lane) * 4);
        f32x4 v[2][4]; float ss[2] = {0.f, 0.f};
#pragma unroll
        for (int r = 0; r < 2; ++r)
#pragma unroll
            for (int i = 0; i < 4; ++i) { v[r][i] = bf4_to_f32(rxb[r][i]) + g2v[i] * bf4_to_f32(ryb[r][i]);
                ss[r] += v[r][i][0] * v[r][i][0] + v[r][i][1] * v[r][i][1] + v[r][i][2] * v[r][i][2] + v[r][i][3] * v[r][i][3]; }
        __builtin_amdgcn_sched_barrier(0);
        FN_ISSUE(t0 + 2 * stride)
        FN_SLOTS(t0 + 4 * stride)
        __builtin_amdgcn_sched_barrier(0);
        ss[0] = wave_sum(ss[0]); ss[1] = wave_sum(ss[1]);
#pragma unroll
        for (int r = 0; r < 2; ++r) { float* s = gout(Pp) + (size_t)tt[r] * D;
            const float rstd = rsqrtf(ss[r] * (1.f / D) + 1e-6f);
#pragma unroll
            for (int i = 0; i < 4; ++i) { const int k = (i * 64 + F.lane) * 4; *(f32x4*)(s + k) = v[r][i] * rstd * gf[i]; } }
    }
#undef FN_ISSUE
#undef FN_SLOTS
}

template <int PH> DI void run_phase(unsigned char* lds_raw, int l) {
    KParams kp = (KParams)__builtin_amdgcn_kernarg_segment_ptr();
    asm volatile("" : "+s"(kp));
    GAS unsigned char* ws = (GAS unsigned char*)kp->ws;
    asm volatile("" : "+s"(ws));
    int tid = threadIdx.x; asm volatile("" : "+v"(tid));
    Frame F; F.p = kp; F.ws = ws; F.lds = (float*)(lds_raw + 16); F.tid = tid; F.wid = __builtin_amdgcn_readfirstlane(tid >> 6); F.lane = tid & 63; F.wg = blockIdx.x; F.nwg = gridDim.x;
    if (PH == 0) phase_prologue(F);
    if (PH == 1) phase_norm1(F, l);
    if (PH == 2) phase_gemm_in_mfma(F, l);
    if (PH == 4) phase_attn_mfma(F, l);
    if (PH == 5) phase_gemm_out_mfma(F, l);
    if (PH == 6) phase_norm2(F, l);
    if (PH == 7) phase_scatter(F, l);
    if (PH == 8) phase_gemm1_mfma(F, l);
    if (PH == 9) phase_gemm2_mfma(F, l);
    if (PH == 10) phase_final(F);
}
DI void grid_sync(unsigned char* lds_raw) {
    KParams kp = (KParams)__builtin_amdgcn_kernarg_segment_ptr();
    asm volatile("" : "+s"(kp));
    XcdBarrier b; b.bar = (unsigned*)kp->ws; b.x = xb_xcc_id(); b.st = (volatile LAS unsigned*)lds_raw;
    xcd_barrier(b);
}
__global__ void __launch_bounds__(NWG_THREADS, 2) fwd_kernel(Params p) {
    extern __shared__ __attribute__((aligned(16))) unsigned char lds_raw[];
    if (threadIdx.x == 0) *(uint4*)lds_raw = make_uint4(0u, 0u, 0u, 0u);
    __syncthreads();
    (void)xcd_barrier_post((unsigned*)p.ws, (volatile LAS unsigned*)lds_raw);
#define RUN(PH, l) run_phase<PH>(lds_raw, l); grid_sync(lds_raw); if (DUP_PH == PH && DUP_L == l) { run_phase<PH>(lds_raw, l); grid_sync(lds_raw); }
    RUN(0, 0)
    RUN(1, 0) RUN(2, 0) RUN(4, 0) RUN(5, 0) RUN(6, 0) RUN(8, 0) RUN(9, 0)
    RUN(1, 1) RUN(2, 1) RUN(4, 1) RUN(5, 1) RUN(6, 1) RUN(8, 1) RUN(9, 1)
    run_phase<10>(lds_raw, 0);
#undef RUN
}

extern "C" void kernel_launch(void* const* d_in, const int* in_sizes, int n_in, void* d_out, int out_size, void* d_ws, size_t ws_size, hipStream_t stream) {
    static int grid = 0;
    if (grid == 0) {
        if (n_in != 26 || out_size != NLAT * D || ws_size < WS_END2) { fprintf(stderr, "kernel_launch: unexpected shapes n_in %d out %d ws %zu (need %zu)\n", n_in, out_size, ws_size, (size_t)WS_END2); grid = -1; return; }
        int dev = 0, cus = 0, per_cu = 0;
        if (hipGetDevice(&dev) != hipSuccess || hipDeviceGetAttribute(&cus, hipDeviceAttributeMultiprocessorCount, dev) != hipSuccess) { grid = -1; return; }
        if (hipFuncSetAttribute((const void*)fwd_kernel, hipFuncAttributeMaxDynamicSharedMemorySize, LDS_BYTES) != hipSuccess) { fprintf(stderr, "kernel_launch: hipFuncSetAttribute failed\n"); grid = -1; return; }
        if (hipOccupancyMaxActiveBlocksPerMultiprocessor(&per_cu, (const void*)fwd_kernel, NWG_THREADS, LDS_BYTES) != hipSuccess || per_cu < 1) fprintf(stderr, "kernel_launch: occupancy query reports %d\n", per_cu);
        (void)hipGetLastError();
        if (cus < 64) { fprintf(stderr, "kernel_launch: %d CUs, need at least 64\n", cus); grid = -1; return; }
        grid = cus;
    }
    if (grid < 0) return;
    (void)hipMemsetAsync((char*)d_ws + WS_SYNC, 0, SYNC_BYTES, stream);
    Params p{};
    for (int i = 0; i < 26; ++i) p.in[i] = (const float*)d_in[i];
    p.out = (float*)d_out; p.ws = (unsigned char*)d_ws; p.ph_lo = 0; p.ph_hi = 0;
    hipLaunchKernelGGL(fwd_kernel, dim3(grid), dim3(NWG_THREADS), LDS_BYTES, stream, p);
}
```

```cpp
#include <hip/hip_runtime.h>
#include <stdint.h>
#include <stdio.h>

#define DI __device__ __forceinline__
#ifndef MFMA_GEMM
#define MFMA_GEMM 15
#endif
#ifndef DUP_PH
#define DUP_PH -1
#endif
#ifndef DUP_L
#define DUP_L 0
#endif
#ifndef MFMA_ATTN
#define MFMA_ATTN 1
#endif
#ifndef ATTN_PIPE
#define ATTN_PIPE 2
#endif
typedef unsigned short bf16_t;
typedef float f32x4 __attribute__((ext_vector_type(4)));
typedef unsigned u32x4 __attribute__((ext_vector_type(4)));
typedef unsigned u32x2 __attribute__((ext_vector_type(2)));

constexpr int D = 1024, NB = 4, SEQ = 8192, NLAT = NB * SEQ, CTXL = 256, NCTX = NB * CTXL, NT = NLAT + NCTX;
constexpr int KEYS = CTXL + SEQ;
constexpr int INW = 2560, QKW = 1792, VW = 768;
constexpr int NKH = 12;
constexpr int NBUCKET = 24, MAXTILES = 156, MAXSLOTS = MAXTILES * 256;
constexpr int NWG_THREADS = 512;
constexpr int LDS_BYTES = 163840;

constexpr size_t al256(size_t x) { return (x + 255) & ~(size_t)255; }
constexpr size_t WS_SYNC = 0;
constexpr size_t SYNC_BYTES = 65536;
constexpr size_t KMAX_OFF_WORDS = 4096 + 64;
constexpr size_t QMAX_OFF_WORDS = 4096 + 192;
constexpr size_t CNT_OFF_WORDS = 4096;
constexpr size_t WS_MOD = WS_SYNC + SYNC_BYTES;
constexpr size_t WS_ROPEB = WS_MOD + al256((size_t)2 * 5 * 6144 * 4);
constexpr size_t WS_ROPEC = WS_ROPEB + 128 * 8 * 2 * 4;
constexpr size_t WS_LAM = WS_ROPEC + 128 * 16 * 2 * 4;
constexpr size_t WS_TOKINFO = WS_LAM + 256;
constexpr size_t WS_TOKSLOT = WS_TOKINFO + (size_t)NT * 16;
constexpr size_t WS_SLOTTOK = WS_TOKSLOT + (size_t)NT * 4;
constexpr size_t WS_SLOTW = WS_SLOTTOK + (size_t)MAXSLOTS * 4;
constexpr size_t WS_XC = WS_SLOTW + (size_t)MAXSLOTS * 8;
constexpr size_t WS_WINT = WS_XC + (size_t)NCTX * D * 4;
constexpr size_t WS_WOUTT = WS_WINT + (size_t)2 * INW * D * 2;
constexpr size_t WS_WGU = WS_WOUTT + (size_t)2 * D * D * 2;
constexpr size_t WS_WDT = WS_WGU + (size_t)2 * 16 * 1024 * 1024 * 2;
constexpr size_t WS_ACT = WS_WDT + (size_t)2 * 16 * 1024 * 512 * 2;
constexpr size_t WS_BIG = WS_ACT + (size_t)MAXSLOTS * D * 2;
constexpr size_t BIG_PROJ = 0;
constexpr size_t BIG_KPOST = BIG_PROJ + (size_t)NT * QKW * 2;
constexpr size_t BIG_VT = BIG_KPOST + (size_t)NB * NKH * KEYS * 64 * 2;
constexpr size_t BIG_Y16 = (size_t)MAXSLOTS * D * 2;
constexpr size_t BIG_END = BIG_VT + (size_t)NB * NKH * KEYS * 64 * 2;
constexpr size_t WS_END = WS_BIG + BIG_END;
static_assert((size_t)MAXSLOTS * 2048 * 2 <= BIG_END && (size_t)NT * D * 4 <= BIG_END, "alias");
constexpr size_t WS_XB = WS_END;
constexpr int SPCAP = NT;
constexpr size_t WS_SPTOK = WS_XB + (size_t)NT * D * 2;
constexpr size_t WS_SPW = WS_SPTOK + (size_t)NBUCKET * SPCAP * 4;
constexpr size_t WS_RWT = WS_SPW + (size_t)NBUCKET * SPCAP * 8;
constexpr size_t WS_END2 = WS_RWT + (size_t)2 * 20 * 1024 * 4;
static_assert(WS_END2 <= (size_t)512 * 1024 * 1024, "workspace");

struct Params {
    const float* in[26];
    float* out;
    unsigned char* ws;
    int ph_lo, ph_hi;
};

DI float bf2f(bf16_t v) { return __uint_as_float((unsigned)v << 16); }
DI bf16_t f2bf(float f) { unsigned u = __float_as_uint(f); u += 0x7fffu + ((u >> 16) & 1u); return (bf16_t)(u >> 16); }
DI unsigned pack2(float a, float b) { return (unsigned)f2bf(a) | ((unsigned)f2bf(b) << 16); }
DI float dpp_row_sum(float s) {
    s += __int_as_float(__builtin_amdgcn_update_dpp(0, __float_as_int(s), 0xB1, 0xF, 0xF, false));
    s += __int_as_float(__builtin_amdgcn_update_dpp(0, __float_as_int(s), 0x4E, 0xF, 0xF, false));
    s += __int_as_float(__builtin_amdgcn_update_dpp(0, __float_as_int(s), 0x141, 0xF, 0xF, false));
    s += __int_as_float(__builtin_amdgcn_update_dpp(0, __float_as_int(s), 0x140, 0xF, 0xF, false));
    return s;
}
DI float swap32_sum(float a, float b) { const auto r = __builtin_amdgcn_permlane32_swap(__float_as_uint(a), __float_as_uint(b), false, false); return __uint_as_float(r[0]) + __uint_as_float(r[1]); }
DI float swap16_sum(float a, float b) { const auto r = __builtin_amdgcn_permlane16_swap(__float_as_uint(a), __float_as_uint(b), false, false); return __uint_as_float(r[0]) + __uint_as_float(r[1]); }
DI float wave_sum(float v) { const float a = swap32_sum(v, v); return dpp_row_sum(swap16_sum(a, a)); }
DI int clampi(int v, int lo, int hi) { return v < lo ? lo : (v > hi ? hi : v); }

#define XB_TMO      128
#define XB_XCNT(j)  (256  + 64 * (j))
#define XB_XSUB(j)  (1280 + 64 * (j))
#define XB_XGEN(j)  (2304 + 64 * (j))
#define XB_TOP      3328
#define XB_TOPGEN   3392
#define XCD_BAR_WORDS 3456
#define XB_SPIN_CAP (1u << 18)
typedef float f32x2 __attribute__((ext_vector_type(2)));
#define LAS __attribute__((address_space(3)))
#define GAS __attribute__((address_space(1)))
DI unsigned xb_ld(unsigned* p)              { return __hip_atomic_load(p, __ATOMIC_RELAXED, __HIP_MEMORY_SCOPE_AGENT); }
DI unsigned xb_add(unsigned* p, unsigned v) { return __hip_atomic_fetch_add(p, v, __ATOMIC_RELAXED, __HIP_MEMORY_SCOPE_AGENT); }
DI unsigned xb_xcc_id() { return (unsigned)__builtin_amdgcn_s_getreg((3 << 11) | 20) & 0xFu; }
#define XB_SPIN(cond, bar) do { unsigned _sp = 0; while (cond) { __builtin_amdgcn_s_sleep(1); \
    if ((++_sp & 255u) == 0u) { if (xb_ld(&(bar)[XB_TMO])) break; if (_sp > XB_SPIN_CAP) { atomicAdd(&(bar)[XB_TMO], 1u); break; } } } } while (0)
struct XcdBarrier { unsigned* bar; unsigned x; volatile LAS unsigned* st; };
DI XcdBarrier xcd_barrier_post(unsigned* bar, volatile LAS unsigned* st) {
    XcdBarrier b; b.bar = bar; b.x = xb_xcc_id(); b.st = st;
    if (threadIdx.x == 0) (void)xb_add(&bar[XB_XCNT(b.x)], 1u);
    return b;
}
DI void xcd_barrier_complete(unsigned* bar, unsigned x, unsigned& nloc, unsigned& nx) {
    const unsigned G = gridDim.x * gridDim.y * gridDim.z;
    unsigned sum, cnt, mine, sp = 0u;
    for (;;) {
        sum = 0u; cnt = 0u; mine = 0u;
#pragma unroll
        for (unsigned j = 0; j < 16; ++j) { const unsigned c = xb_ld(&bar[XB_XCNT(j)]); sum += c; cnt += (c > 0u) ? 1u : 0u; mine = (j == x) ? c : mine; }
        if (sum == G) break;
        __builtin_amdgcn_s_sleep(1);
        if ((++sp & 255u) == 0u) { if (xb_ld(&bar[XB_TMO])) break; if (sp > XB_SPIN_CAP) { atomicAdd(&bar[XB_TMO], 1u); break; } }
    }
    nloc = mine > 0u ? mine : 1u; nx = cnt > 0u ? cnt : 1u;
}
DI void xcd_barrier(const XcdBarrier& b) {
    asm volatile("s_waitcnt vmcnt(0)" ::: "memory");
    __syncthreads();
    if (threadIdx.x == 0) {
        unsigned* bar = b.bar;
        __builtin_amdgcn_s_waitcnt(0);
        unsigned nloc = b.st[0], nx = b.st[1];
        if (nloc == 0u) { xcd_barrier_complete(bar, b.x, nloc, nx); b.st[0] = nloc; b.st[1] = nx; }
        const unsigned old = xb_add(&bar[XB_XSUB(b.x)], 1u);
        const unsigned gen = old / nloc;
        if (old + 1u == (gen + 1u) * nloc) {
            __builtin_amdgcn_fence(__ATOMIC_RELEASE, "agent");
            asm volatile("s_waitcnt vmcnt(0)" ::: "memory");
            const unsigned og = xb_add(&bar[XB_TOP], 1u);
            const unsigned tg = og / nx;
            if (og + 1u == (tg + 1u) * nx) xb_add(&bar[XB_TOPGEN], 1u);
            else XB_SPIN(xb_ld(&bar[XB_TOPGEN]) == tg, bar);
            __builtin_amdgcn_fence(__ATOMIC_ACQUIRE, "agent");
            xb_add(&bar[XB_XGEN(b.x)], 1u);
            asm volatile("s_waitcnt vmcnt(0)" ::: "memory");
        } else {
            XB_SPIN(xb_ld(&bar[XB_XGEN(b.x)]) == gen, bar);
            __builtin_amdgcn_fence(__ATOMIC_ACQUIRE, "agent");
            asm volatile("s_waitcnt vmcnt(0)" ::: "memory");
        }
    }
    __syncthreads();
}

typedef const Params __attribute__((address_space(4)))* KParams;
DI const float* gin(KParams p, int i) { GAS const float* g = (GAS const float*)p->in[i]; asm volatile("" : "+s"(g)); return (const float*)g; }
DI float* gout(KParams p) { GAS float* g = (GAS float*)p->out; asm volatile("" : "+s"(g)); return (float*)g; }
struct Frame {
    KParams p; GAS unsigned char* ws; float* lds; int tid, wid, lane, wg, nwg;
    template <class T> DI T* wsp(size_t off) const { return (T*)(GAS T*)(ws + off); }
};
DI const float* mod_row(const Frame& F, int l, int mrow) { return F.wsp<float>(WS_MOD) + ((size_t)l * 5 + mrow) * 6144; }
DI int tok_modrow(int t) { return t < NLAT ? (t >> 13) : 4; }
DI int tok_batch(int t) { return t < NLAT ? (t >> 13) : ((t - NLAT) >> 8); }
DI int tok_key(int t) { return t < NLAT ? CTXL + (t & (SEQ - 1)) : ((t - NLAT) & (CTXL - 1)); }
DI bf16_t* xres_row(const Frame& F, int t) { return F.wsp<bf16_t>(WS_XB) + (size_t)t * D; }
DI const float* xin_row(const Frame& F, int t) { return t < NLAT ? gin(F.p, 0) + (size_t)t * D : gin(F.p, 2) + (size_t)(t - NLAT) * D; }
DI double lam_init_of(int l) { return l == 0 ? 0.8 - 0.6 : 0.8 - 0.6 * 0.74081822068171786607; }
DI void sincos_d(double a, double& s, double& c) {
    const double n = __builtin_rint(a * 0.63661977236758134308);
    const double r = (a - n * 1.57079632673412561417e+00) - n * 6.07710050650619224932e-11;
    const double r2 = r * r;
    double ts = 1.0, tc = 1.0;
#pragma unroll
    for (int k = 12; k >= 1; --k) { ts = 1.0 - ts * r2 * (1.0 / (double)((2 * k) * (2 * k + 1))); tc = 1.0 - tc * r2 * (1.0 / (double)((2 * k - 1) * (2 * k))); }
    const double sr = r * ts, cr = tc;
    const int q = ((int)n) & 3;
    s = q == 0 ? sr : (q == 1 ? cr : (q == 2 ? -sr : -cr));
    c = q == 0 ? cr : (q == 1 ? -sr : (q == 2 ? -cr : sr));
}
DI double exp_d(double x) { double t = 1.0;
#pragma unroll
    for (int k = 40; k >= 1; --k) t = 1.0 + t * x * (1.0 / (double)k);
    return t; }

DI int win_rowmap(int c) {
    int hs, e; bool isb = false;
    if (c < 384) { hs = c >> 6; e = c & 63; }
    else if (c < 768) { hs = 6 + ((c - 384) >> 6); e = c & 63; }
    else if (c < 1152) return QKW + (c - 768);
    else if (c < 1408) { hs = 12 + ((c - 1152) >> 6); e = (c - 1152) & 63; isb = true; }
    else if (c < 1664) { hs = 16 + ((c - 1408) >> 6); e = (c - 1408) & 63; isb = true; }
    else if (c < 1920) return QKW + 384 + (c - 1664);
    else if (c < 2304) { hs = 20 + ((c - 1920) >> 6); e = (c - 1920) & 63; }
    else if (c < 2432) { hs = 26 + ((c - 2304) >> 6); e = (c - 2304) & 63; }
    else return QKW + 640 + (c - 2432);
    int bj, fq; const int j = e & 7;
    if (!isb) { bj = e >> 5; fq = (e >> 3) & 3; } else { const int mp = e >> 5, i = e & 31; bj = i >> 4; fq = 2 * mp + ((i >> 3) & 1); }
    return 256 * (hs >> 2) + 128 * bj + 32 * (hs & 3) + 8 * fq + j;
}
DI void cvt_tile(const Frame& F, const float* src, int C, int k0, int n0, bf16_t* dst, int ldd, int mode) {
    float* t = F.lds;
    __syncthreads();
    { const int kk = F.tid >> 3, nn = (F.tid & 7) * 8;
      const float* s = src + (size_t)(k0 + kk) * C + n0 + nn;
      const f32x4 a = *(const f32x4*)s, b = *(const f32x4*)(s + 4);
      float* d = t + kk * 65 + nn;
      d[0] = a[0]; d[1] = a[1]; d[2] = a[2]; d[3] = a[3]; d[4] = b[0]; d[5] = b[1]; d[6] = b[2]; d[7] = b[3]; }
    __syncthreads();
    { const int nn = F.tid >> 3, kk0 = (F.tid & 7) * 8;
      u32x4 o;
#pragma unroll
      for (int j = 0; j < 4; ++j) o[j] = pack2(t[(kk0 + 2 * j) * 65 + nn], t[(kk0 + 2 * j + 1) * 65 + nn]);
      const int c = n0 + nn; const int orow = mode == 0 ? c : (mode == 1 ? win_rowmap(c) : (mode == 2 ? 2 * c : 2 * c + 1));
      *(u32x4*)(dst + (size_t)orow * ldd + k0 + kk0) = o; }
}
struct CvtJob { const float* src; bf16_t* dst; int C, k0, n0, ldd, mode; };
DI CvtJob cvt_job(const Frame& F, int ug) {
    const KParams Pp = F.p;
    const int T0 = 1280, T1 = T0 + 512, T2 = T1 + 4096, T3 = T2 + 4096;
    const int u = ug * 4;
    CvtJob J;
    if (u < T0) { const int l = u / 640, r = u % 640, kt = r / 40, nt = r % 40;
        J.src = gin(Pp, 8) + (size_t)l * D * INW; J.C = INW; J.k0 = kt * 64; J.n0 = nt * 64; J.dst = F.wsp<bf16_t>(WS_WINT) + (size_t)l * INW * D; J.ldd = D; J.mode = 1;
    } else if (u < T1) { const int v = u - T0, l = v / 256, r = v % 256, kt = r / 16, nt = r % 16;
        J.src = gin(Pp, 9) + (size_t)l * D * D; J.C = D; J.k0 = kt * 64; J.n0 = nt * 64; J.dst = F.wsp<bf16_t>(WS_WOUTT) + (size_t)l * D * D; J.ldd = D; J.mode = 0;
    } else if (u < T3) { const bool up = u >= T2; const int v = u - (up ? T2 : T1), le = v / 128, r = v % 128, kt = r / 8, nt = r % 8;
        J.src = (up ? gin(Pp, 23) : gin(Pp, 22)) + (size_t)le * D * 512; J.C = 512; J.k0 = kt * 64; J.n0 = nt * 64; J.dst = F.wsp<bf16_t>(WS_WGU) + (size_t)le * 1024 * 1024; J.ldd = D; J.mode = up ? 3 : 2;
    } else { const int v = u - T3, le = v / 128, r = v % 128, kt = r / 16, nt = r % 16;
        J.src = gin(Pp, 24) + (size_t)le * 512 * D; J.C = D; J.k0 = kt * 64; J.n0 = nt * 64; J.dst = F.wsp<bf16_t>(WS_WDT) + (size_t)le * 1024 * 512; J.ldd = 512; J.mode = 0;
    }
    return J;
}
DI void phase_prologue(const Frame& F) {
    const KParams Pp = F.p;
    {
        constexpr int NG = (1280 + 512 + 3 * 4096) / 4;
        float* t = F.lds;
        const int kk = F.tid >> 3, nn = (F.tid & 7) * 8;
        const int tn = F.tid >> 3, kk0 = (F.tid & 7) * 8;
        int ug = F.wg;
        CvtJob J = cvt_job(F, ug < NG ? ug : 0);
        f32x4 a[4], b[4];
#define CVT_ISSUE() { const float* sp = J.src + (size_t)(J.k0 + kk) * J.C + J.n0 + nn; \
        _Pragma("unroll") for (int q = 0; q < 4; ++q) { a[q] = *(const f32x4*)(sp + 64 * q); b[q] = *(const f32x4*)(sp + 64 * q + 4); } }
        if (ug < NG) CVT_ISSUE()
        while (ug < NG) {
            __syncthreads();
#pragma unroll
            for (int q = 0; q < 4; ++q) { float* d = t + q * (64 * 65) + kk * 65 + nn;
                d[0] = a[q][0]; d[1] = a[q][1]; d[2] = a[q][2]; d[3] = a[q][3]; d[4] = b[q][0]; d[5] = b[q][1]; d[6] = b[q][2]; d[7] = b[q][3]; }
            __syncthreads();
            const CvtJob Jc = J; const int un = ug + F.nwg;
            if (un < NG) { J = cvt_job(F, un); CVT_ISSUE() }
#pragma unroll
            for (int q = 0; q < 4; ++q) { const float* tq = t + q * (64 * 65);
                u32x4 o;
#pragma unroll
                for (int j = 0; j < 4; ++j) o[j] = pack2(tq[(kk0 + 2 * j) * 65 + tn], tq[(kk0 + 2 * j + 1) * 65 + tn]);
                const int c = Jc.n0 + 64 * q + tn; const int orow = Jc.mode == 0 ? c : (Jc.mode == 1 ? win_rowmap(c) : (Jc.mode == 2 ? 2 * c : 2 * c + 1));
                *(u32x4*)(Jc.dst + (size_t)orow * Jc.ldd + Jc.k0 + kk0) = o; }
            ug = un;
        }
#undef CVT_ISSUE
    }
    __syncthreads();
    {
        float* sc = F.lds;
        float* red = F.lds + 5 * 1024;
        { float cv[10];
#pragma unroll
          for (int it = 0; it < 10; ++it) { const int k = (F.tid + NWG_THREADS * it) & 1023; cv[it] = (it >> 1) < 4 ? gin(Pp, 1)[(it >> 1) * 1024 + k] : gin(Pp, 3)[k]; }
#pragma unroll
          for (int it = 0; it < 10; ++it) sc[F.tid + NWG_THREADS * it] = cv[it] / (1.f + expf(-cv[it])); }
        __syncthreads();
        for (int u = F.wg; u < 192; u += F.nwg) {
            const int l = u / 96, j0 = (u % 96) * 64, kg = F.tid >> 4, jq = (F.tid & 15) * 4;
            const float* w = gin(Pp, 4) + (size_t)l * D * 6144 + j0 + jq + (size_t)(kg * 32) * 6144;
            f32x4 acc[5];
#pragma unroll
            for (int r = 0; r < 5; ++r) acc[r] = (f32x4){0.f, 0.f, 0.f, 0.f};
#pragma unroll
            for (int kb = 0; kb < 32; kb += 16) {
                f32x4 wv[16];
#pragma unroll
                for (int e = 0; e < 16; ++e) wv[e] = *(const f32x4*)(w + (size_t)(kb + e) * 6144);
#pragma unroll
                for (int e = 0; e < 16; ++e) { const int k = kg * 32 + kb + e;
#pragma unroll
                    for (int r = 0; r < 5; ++r) acc[r] += wv[e] * sc[r * 1024 + k]; } }
#pragma unroll
            for (int r = 0; r < 5; ++r) *(f32x4*)(red + (kg * 5 + r) * 64 + jq) = acc[r];
            __syncthreads();
            if (F.tid < 320) { const int r = F.tid >> 6, jj = F.tid & 63; float s = 0; for (int g = 0; g < 32; ++g) s += red[(g * 5 + r) * 64 + jj]; F.wsp<float>(WS_MOD)[((size_t)l * 5 + r) * 6144 + j0 + jj] = s + gin(Pp, 5)[l * 6144 + j0 + jj]; }
            __syncthreads();
        }
    }
    for (int i = F.wg * NWG_THREADS + F.tid; i < 2 * 20480; i += F.nwg * NWG_THREADS) { const int l = i / 20480, r = i % 20480, j = r >> 10, k = r & 1023;
        F.wsp<float>(WS_RWT)[i] = j < 4 ? gin(Pp, 18)[(size_t)l * 4096 + k * 4 + j] : gin(Pp, 20)[(size_t)l * 16384 + k * 16 + (j - 4)]; }
    const bool rev = F.nwg >= 32; const int rwg = rev ? F.nwg - 1 - F.wg : F.wg, qoff = rev ? 8 : 0, lamwg = rev ? 24 : 0;
    for (int i = rwg * NWG_THREADS + F.tid; i < 128 * 8 + 128 * 16; i += F.nwg * NWG_THREADS) {
        const bool isb = i < 1024; const int v = isb ? i : i - 1024, pos = isb ? v >> 3 : v >> 4, j = isb ? v & 7 : v & 15;
        const double base = isb ? 0.31622776601683793320 : 0.56234132519034908039;
        double f = 1.0; for (int k = 0; k < j; ++k) f *= base;
        double sn, cs; sincos_d((double)pos * f, sn, cs);
        float* dst = isb ? F.wsp<float>(WS_ROPEB) : F.wsp<float>(WS_ROPEC);
        dst[v * 2] = (float)cs; dst[v * 2 + 1] = (float)sn;
    }
    for (int q = rwg - qoff; q >= 0 && q < 12; q += F.nwg) {
        float bm = F.tid < 465 ? fabsf(gin(Pp, 10)[(size_t)q * 465 + F.tid]) : 0.f;
#pragma unroll
        for (int of = 32; of; of >>= 1) bm = fmaxf(bm, __shfl_xor(bm, of));
        __syncthreads();
        if (F.lane == 0) F.lds[F.wid] = bm;
        __syncthreads();
        if (F.tid == 0) { float m = F.lds[0]; for (int i = 1; i < 8; ++i) m = fmaxf(m, F.lds[i]); F.wsp<float>(WS_LAM)[16 + q] = m * 1.4426950408889634f; }
        __syncthreads(); }
    if (F.wg == F.nwg - 1 && F.wid == 1) {
#pragma unroll
        for (int l = 0; l < 2; ++l) { float g = fabsf(gin(Pp, 16)[l * 64 + F.lane]);
#pragma unroll
            for (int of = 32; of; of >>= 1) g = fmaxf(g, __shfl_xor(g, of));
            if (F.lane == 0) F.wsp<float>(WS_LAM)[32 + l] = g; } }
    if (rwg == lamwg && F.wid == 0) {
#pragma unroll
        for (int l = 0; l < 2; ++l) { double s1 = 0.0, s2 = 0.0;
            if (F.lane < 32) { s1 = (double)gin(Pp, 11)[l * 32 + F.lane] * (double)gin(Pp, 12)[l * 32 + F.lane]; s2 = (double)gin(Pp, 13)[l * 32 + F.lane] * (double)gin(Pp, 14)[l * 32 + F.lane]; }
#pragma unroll
            for (int of = 16; of; of >>= 1) { s1 += __shfl_xor(s1, of); s2 += __shfl_xor(s2, of); }
            if (F.lane == 0) { const double li = lam_init_of(l); F.wsp<float>(WS_LAM)[l * 2] = (float)(exp_d(s1) - exp_d(s2) + li); F.wsp<float>(WS_LAM)[l * 2 + 1] = (float)li; } } }
}

DI f32x4 bf4_to_f32(u32x2 v) { return (f32x4){__uint_as_float(v[0] << 16), __uint_as_float(v[0] & 0xffff0000u), __uint_as_float(v[1] << 16), __uint_as_float(v[1] & 0xffff0000u)}; }
DI unsigned cvtpk_rne(float lo, float hi) { unsigned r; asm volatile("s_nop 0\n\tv_cvt_pk_bf16_f32 %0, %1, %2" : "=v"(r) : "v"(lo), "v"(hi)); return r; }
DI int build_tiles(const Frame& F, int l, int* tile_bucket, int* boff);
DI void phase_norm1(const Frame& F, int l) {
    const KParams Pp = F.p;
    const float* gain = gin(Pp, 6) + l * D;
    bf16_t* act = F.wsp<bf16_t>(WS_ACT);
    const bf16_t* y16 = F.wsp<bf16_t>(WS_BIG + BIG_Y16); const int4* tokinfo = F.wsp<int4>(WS_TOKINFO);
    int* tile_bucket = (int*)F.lds; int* boff = tile_bucket + MAXTILES;
    if (l != 0) build_tiles(F, l - 1, tile_bucket, boff);
    const int stride = F.nwg * 8;
    f32x4 rxf[2][4]; u32x2 rxb[2][4], ryb[2][4]; int nsl[2] = {0, 0};
#pragma unroll
    for (int r = 0; r < 2; ++r)
#pragma unroll
        for (int i = 0; i < 4; ++i) { rxf[r][i] = (f32x4){0.f, 0.f, 0.f, 0.f}; rxb[r][i] = (u32x2){0u, 0u}; ryb[r][i] = (u32x2){0u, 0u}; }
#define N1_SLOTS(T0) if (l != 0 && (T0) < NT) { const int2 i0_ = *(const int2*)(tokinfo + (T0)), i1_ = *(const int2*)(tokinfo + (T0) + 1); nsl[0] = boff[i0_.x] * 256 + i0_.y; nsl[1] = boff[i1_.x] * 256 + i1_.y; }
#define N1_ISSUE(T0) if ((T0) < NT) { \
        _Pragma("unroll") for (int r = 0; r < 2; ++r) { \
            if (l == 0) { const float* s_ = xin_row(F, (T0) + r); _Pragma("unroll") for (int i = 0; i < 4; ++i) rxf[r][i] = *(const f32x4*)(s_ + (i * 64 + F.lane) * 4); } \
            else { const bf16_t* s_ = xres_row(F, (T0) + r); const bf16_t* yr_ = y16 + (size_t)nsl[r] * D; \
                _Pragma("unroll") for (int i = 0; i < 4; ++i) { const int k = (i * 64 + F.lane) * 4; rxb[r][i] = *(const u32x2*)(s_ + k); ryb[r][i] = *(const u32x2*)(yr_ + k); } } } }
    const int tfirst = 2 * (F.wg * 8 + F.wid);
    N1_SLOTS(tfirst)
    N1_ISSUE(tfirst)
    N1_SLOTS(tfirst + 2 * stride)
    for (int t0 = tfirst; t0 < NT; t0 += 2 * stride) {
        const int tt[2] = {t0, t0 + 1};
        const float* m = mod_row(F, l, tok_modrow(t0));
        f32x4 v[2][4], g2v[4];
        if (l != 0) { const float* g2 = mod_row(F, l - 1, tok_modrow(t0)) + 5120;
#pragma unroll
            for (int i = 0; i < 4; ++i) g2v[i] = *(const f32x4*)(g2 + (i * 64 + F.lane) * 4); }
        f32x4 gsv[4], shv[4], scv[4];
#pragma unroll
        for (int i = 0; i < 4; ++i) { const int k = (i * 64 + F.lane) * 4; gsv[i] = *(const f32x4*)(gain + k); shv[i] = *(const f32x4*)(m + k); scv[i] = *(const f32x4*)(m + 1024 + k); }
        if (l == 0) {
#pragma unroll
            for (int r = 0; r < 2; ++r)
#pragma unroll
                for (int i = 0; i < 4; ++i) v[r][i] = rxf[r][i];
        } else {
#pragma unroll
            for (int r = 0; r < 2; ++r) { bf16_t* s = xres_row(F, tt[r]);
#pragma unroll
                for (int i = 0; i < 4; ++i) { const int k = (i * 64 + F.lane) * 4; v[r][i] = bf4_to_f32(rxb[r][i]) + g2v[i] * bf4_to_f32(ryb[r][i]);
                    u32x2 xo; xo[0] = cvtpk_rne(v[r][i][0], v[r][i][1]); xo[1] = cvtpk_rne(v[r][i][2], v[r][i][3]); *(u32x2*)(s + k) = xo; } }
        }
        __builtin_amdgcn_sched_barrier(0);
        N1_ISSUE(t0 + 2 * stride)
        N1_SLOTS(t0 + 4 * stride)
        __builtin_amdgcn_sched_barrier(0);
        float ss[2] = {0.f, 0.f};
#pragma unroll
        for (int r = 0; r < 2; ++r)
#pragma unroll
            for (int i = 0; i < 4; ++i) ss[r] += v[r][i][0] * v[r][i][0] + v[r][i][1] * v[r][i][1] + v[r][i][2] * v[r][i][2] + v[r][i][3] * v[r][i][3];
#pragma unroll
        for (int i = 0; i < 4; ++i) gsv[i] = gsv[i] * (scv[i] + 1.f);
        ss[0] = wave_sum(ss[0]); ss[1] = wave_sum(ss[1]);
#pragma unroll
        for (int r = 0; r < 2; ++r) { const int t = tt[r];
            const float rstd = rsqrtf(ss[r] * (1.f / D) + 1e-6f);
#pragma unroll
            for (int i = 0; i < 4; ++i) { const int k = (i * 64 + F.lane) * 4;
                const f32x4 h = v[r][i] * rstd * gsv[i] + shv[i];
                u32x2 o; o[0] = cvtpk_rne(h[0], h[1]); o[1] = cvtpk_rne(h[2], h[3]);
                *(u32x2*)(act + (size_t)t * D + k) = o; } }
    }
#undef N1_ISSUE
#undef N1_SLOTS
}

namespace pg8 {
typedef short bf16x8 __attribute__((ext_vector_type(8)));
constexpr int BM = 256, BK = 64, HALF = 128, HTB = HALF * BK * 2, STAGE_BYTES = 8 * HTB;
DI int lds_byte(int r, int c) { const int st = (r >> 4) * 2 + (c >> 5), rr = r & 15, cc = c & 31, ob = rr * 64 + cc * 2; return st * 1024 + (ob ^ (((ob >> 9) & 1) << 5)); }
DI void stage_rc(int b, int& R, int& C) { const int st = b / 1024, sb = b % 1024, swz = sb ^ (((sb >> 9) & 1) << 5); R = (st >> 1) * 16 + swz / 64; C = (st & 1) * 32 + (swz % 64) / 2; }
DI int perm32(int rho) { const int n = rho >> 4, i = rho & 15; return 8 * (i >> 2) + 4 * n + (i & 3); }
struct Unit { int pm, pn, aux; };
DI unsigned cvt_pk_bf16(float lo, float hi) { unsigned r; asm volatile("v_cvt_pk_bf16_f32 %0, %1, %2" : "=v"(r) : "v"(lo), "v"(hi)); return r; }

template <class Epi, class Sched>
DI void gemm_phase(LAS unsigned char* lds, const int K, const int lda, const int ldb, const Sched& S, const Epi& E) {
    int tid = threadIdx.x; asm volatile("" : "+v"(tid));
    const int wid = __builtin_amdgcn_readfirstlane(tid >> 6), lane = tid & 63, wr = wid >> 2, wc = wid & 3, fr = lane & 15, fq = lane >> 4;
    const int nt = K / BK, tps = nt / Sched::NSEG;
    int RA[2], CA[2]; unsigned voffB[2];
#pragma unroll
    for (int i = 0; i < 2; ++i) { int R, C; stage_rc(tid * 16 + i * 8192, R, C); const int Rb = Epi::PERM ? ((R & ~31) + perm32(R & 31)) : R; RA[i] = R; CA[i] = C; voffB[i] = (unsigned)(Rb * ldb + C) * 2u; }
    const size_t kstep = (size_t)(BK * 2);
    const size_t hstepB = (size_t)HALF * ldb * 2;
    const unsigned ldsw = (unsigned)wid * 1024u;
    const int aoff = lds_byte(wr * 64 + fr, fq * 8), boff = lds_byte(wc * 32 + fr, fq * 8);
#define PG8_SA(b, h) (((b) * 2 + (h)) * HTB)
#define PG8_SB(b, h) ((4 + (b) * 2 + (h)) * HTB)
#define PG8_STAGE(bufoff, gbase, voff) do { _Pragma("unroll") for (int _i = 0; _i < 2; ++_i) \
        __builtin_amdgcn_global_load_lds((const unsigned*)((const char*)(gbase) + (voff)[_i]), (LAS unsigned*)(lds + (bufoff) + ldsw + _i * 8192), 16, 0, 0); } while (0)
#define PG8_LDA(dst, b, h) do { _Pragma("unroll") for (int m = 0; m < 4; ++m) _Pragma("unroll") for (int k = 0; k < 2; ++k) dst[m][k] = *(const LAS bf16x8*)(lds + PG8_SA(b, h) + aoff + m * 2048 + k * 1024); } while (0)
#define PG8_LDB(dst, b, h) do { _Pragma("unroll") for (int n = 0; n < 2; ++n) _Pragma("unroll") for (int k = 0; k < 2; ++k) dst[n][k] = *(const LAS bf16x8*)(lds + PG8_SB(b, h) + boff + n * 2048 + k * 1024); } while (0)
#define PG8_MMA(ai, bj, At, Bt) do { __builtin_amdgcn_s_setprio(1); _Pragma("unroll") for (int m = 0; m < 4; ++m) _Pragma("unroll") for (int n = 0; n < 2; ++n) _Pragma("unroll") for (int k = 0; k < 2; ++k) \
        acc[ai][bj][m][n] = __builtin_amdgcn_mfma_f32_16x16x32_bf16(Bt[n][k], At[m][k], acc[ai][bj][m][n], 0, 0, 0); __builtin_amdgcn_s_setprio(0); } while (0)
#define PG8_WAIT_V(n) asm volatile("s_waitcnt vmcnt(" #n ")" ::: "memory")
#define PG8_WAIT_L(n) asm volatile("s_waitcnt lgkmcnt(" #n ")" ::: "memory")
#define PG8_BAR __builtin_amdgcn_s_barrier()
#define PG8_SCHED __builtin_amdgcn_sched_barrier(0)
    Unit cur, nxt; int ui = 0;
    if (!S.next(0, cur)) return;
    f32x4 acc[2][2][4][2];
#pragma unroll
    for (int a = 0; a < 2; ++a)
#pragma unroll
        for (int b = 0; b < 2; ++b)
#pragma unroll
            for (int m = 0; m < 4; ++m)
#pragma unroll
                for (int n = 0; n < 2; ++n) acc[a][b][m][n] = (f32x4){0.f, 0.f, 0.f, 0.f};
    bf16x8 At[4][2], B0[2][2], B1[2][2];
    float epre[8] = {0.f, 0.f, 0.f, 0.f, 0.f, 0.f, 0.f, 0.f};
    unsigned vA[2][2], nvA[2][2];
#pragma unroll
    for (int h = 0; h < 2; ++h) { int r0 = h * HALF + RA[0], r1 = h * HALF + RA[1]; if (Sched::GATHER) S.a_rows(cur, r0, r1);
        vA[h][0] = (unsigned)(r0 * lda + CA[0]) * 2u; vA[h][1] = (unsigned)(r1 * lda + CA[1]) * 2u; nvA[h][0] = vA[h][0]; nvA[h][1] = vA[h][1]; }
    constexpr int GTAB_OFF = STAGE_BYTES + 1024, WTAB_OFF = STAGE_BYTES + 3072;
#define PG8_TABDMA(gsrc, ldsoff, n) do { _Pragma("unroll") for (int q_ = 0; q_ < (n); ++q_) \
        __builtin_amdgcn_global_load_lds((const unsigned*)((const char*)(gsrc) + q_ * 1024 + lane * 16), (LAS unsigned*)(lds + (ldsoff) + q_ * 1024), 16, 0, 0); } while (0)
    if (Epi::WTAB && wid == 1) PG8_TABDMA(E.w_ptr(cur), WTAB_OFF, 2);
    const char* cA = S.a_base(cur); const char* cB0 = S.b_base(cur, 0); const char* cB1 = Sched::NSEG > 1 ? S.b_base(cur, 1) : cB0;
#define PG8_BPTR(b0, b1, t) ((Sched::NSEG > 1 && (t) >= tps) ? (b1) + (size_t)((t) - tps) * kstep : (b0) + (size_t)(t) * kstep)
    PG8_STAGE(PG8_SB(0, 0), cB0, voffB); PG8_STAGE(PG8_SA(0, 0), cA, vA[0]); PG8_STAGE(PG8_SB(0, 1), cB0 + hstepB, voffB); PG8_STAGE(PG8_SA(0, 1), cA, vA[1]);
    if (wr == 1) PG8_BAR;
    PG8_WAIT_V(4); PG8_BAR;
    PG8_STAGE(PG8_SB(1, 0), cB0 + kstep, voffB); PG8_STAGE(PG8_SA(1, 0), cA + kstep, vA[0]); PG8_STAGE(PG8_SB(1, 1), cB0 + hstepB + kstep, voffB);
    PG8_WAIT_V(6); PG8_BAR;
    for (;;) {
        const bool has_next = S.next(ui + 1, nxt);
        const char* nA = has_next ? S.a_base(nxt) : cA; const char* nB0 = has_next ? S.b_base(nxt, 0) : cB0; const char* nB1 = has_next ? (Sched::NSEG > 1 ? S.b_base(nxt, 1) : nB0) : cB1;
        if (Sched::GATHER && has_next && wid == 0) PG8_TABDMA(S.rows_ptr(nxt), GTAB_OFF + ((ui + 1) & 1) * 1024, 1);
        if (Epi::WTAB && ui > 0 && wid == 1) PG8_TABDMA(E.w_ptr(cur), WTAB_OFF + (ui & 1) * 2048, 2);
        for (int t = 0; t < nt; t += 2) {
            const bool last = (t == nt - 2);
            const char* a1 = cA + (size_t)(t + 1) * kstep;
            const char* a2 = last ? nA : cA + (size_t)(t + 2) * kstep; const char* b2 = last ? nB0 : PG8_BPTR(cB0, cB1, t + 2);
            const char* a3 = a2 + kstep; const char* b3 = b2 + kstep;
            if (last) {
                if (Sched::GATHER && has_next) { const LAS int* gt = (const LAS int*)(lds + GTAB_OFF + ((ui + 1) & 1) * 1024); const int lim = S.rows_lim(nxt);
#pragma unroll
                    for (int h = 0; h < 2; ++h) { const int q0 = h * HALF + RA[0], q1 = h * HALF + RA[1]; const int r0 = gt[q0 < lim ? q0 : lim], r1 = gt[q1 < lim ? q1 : lim];
                        nvA[h][0] = (unsigned)(r0 * lda + CA[0]) * 2u; nvA[h][1] = (unsigned)(r1 * lda + CA[1]) * 2u; } }
                if (Epi::WTAB) E.pre_lds(cur, wr, fr, (const LAS float*)(lds + WTAB_OFF + (ui & 1) * 2048), epre);
            }
            unsigned w0[2], w1[2];
            w0[0] = last ? nvA[0][0] : vA[0][0]; w0[1] = last ? nvA[0][1] : vA[0][1]; w1[0] = last ? nvA[1][0] : vA[1][0]; w1[1] = last ? nvA[1][1] : vA[1][1];
            PG8_LDB(B0, 0, 0); PG8_SCHED; PG8_LDA(At, 0, 0); PG8_STAGE(PG8_SA(1, 1), a1, vA[1]);
            PG8_WAIT_L(8); PG8_BAR; PG8_WAIT_L(0); PG8_MMA(0, 0, At, B0); PG8_BAR; PG8_SCHED;
            PG8_LDB(B1, 0, 1); PG8_STAGE(PG8_SB(0, 0), b2, voffB);
            PG8_BAR; PG8_WAIT_L(0); PG8_MMA(0, 1, At, B1); PG8_BAR;
            PG8_LDA(At, 0, 1); PG8_STAGE(PG8_SA(0, 0), a2, w0);
            PG8_BAR; PG8_WAIT_L(0); PG8_MMA(1, 0, At, B0); PG8_BAR; PG8_SCHED;
            PG8_STAGE(PG8_SB(0, 1), b2 + hstepB, voffB);
            PG8_WAIT_V(6); PG8_BAR; PG8_MMA(1, 1, At, B1); PG8_BAR;
            PG8_LDB(B0, 1, 0); PG8_SCHED; PG8_LDA(At, 1, 0); PG8_STAGE(PG8_SA(0, 1), a2, w1);
            PG8_WAIT_L(8); PG8_BAR; PG8_WAIT_L(0); PG8_MMA(0, 0, At, B0); PG8_BAR; PG8_SCHED;
            PG8_LDB(B1, 1, 1); PG8_STAGE(PG8_SB(1, 0), b3, voffB);
            PG8_BAR; PG8_WAIT_L(0); PG8_MMA(0, 1, At, B1); PG8_BAR;
            PG8_LDA(At, 1, 1); PG8_STAGE(PG8_SA(1, 0), a3, w0);
            PG8_BAR; PG8_WAIT_L(0); PG8_MMA(1, 0, At, B0); PG8_BAR; PG8_SCHED;
            PG8_STAGE(PG8_SB(1, 1), b3 + hstepB, voffB);
            PG8_WAIT_V(6); PG8_BAR; PG8_MMA(1, 1, At, B1); PG8_BAR;
        }
        asm volatile("s_nop 7\n\ts_nop 7\n\ts_nop 3" ::: "memory");
        E(acc, cur, wr, wc, fr, fq, epre);
        if (!has_next) break;
#pragma unroll
        for (int a = 0; a < 2; ++a)
#pragma unroll
            for (int b = 0; b < 2; ++b)
#pragma unroll
                for (int m = 0; m < 4; ++m)
#pragma unroll
                    for (int n = 0; n < 2; ++n) acc[a][b][m][n] = (f32x4){0.f, 0.f, 0.f, 0.f};
        cur = nxt; cA = nA; cB0 = nB0; cB1 = nB1; ++ui;
#pragma unroll
        for (int h = 0; h < 2; ++h) { vA[h][0] = nvA[h][0]; vA[h][1] = nvA[h][1]; }
    }
    PG8_WAIT_V(0);
    if (wr == 0) PG8_BAR;
    PG8_BAR;
#undef PG8_SA
#undef PG8_SB
#undef PG8_STAGE
#undef PG8_LDA
#undef PG8_LDB
#undef PG8_MMA
#undef PG8_WAIT_V
#undef PG8_WAIT_L
#undef PG8_BAR
#undef PG8_SCHED
#undef PG8_BPTR
#undef PG8_TABDMA
}
struct EpiBf16 {
    static constexpr bool PERM = true;
    bf16_t* O; int ldc; int mode;
    static constexpr bool WTAB = false;
    DI const float* w_ptr(const Unit&) const { return nullptr; }
    DI void pre_lds(const Unit&, int, int, const LAS float*, float (&)[8]) const {}
    DI void operator()(const f32x4 (&acc)[2][2][4][2], const Unit& u, int wr, int wc, int fr, int fq, const float (&)[8]) const {
        const int row0 = u.pm * BM + wr * 64 + fr, colt = u.pn * BM;
        bf16_t* base;
        if (mode == 0) base = O + colt;
        else { const int t0 = colt, b = tok_batch(t0), key0 = tok_key(t0); base = O + (size_t)b * 768 * KEYS + key0; }
        const int col0 = wc * 32 + 8 * fq;
#pragma unroll
        for (int ai = 0; ai < 2; ++ai)
#pragma unroll
            for (int m = 0; m < 4; ++m) { bf16_t* rowp = base + (size_t)(row0 + ai * HALF + m * 16) * ldc + col0;
#pragma unroll
                for (int bj = 0; bj < 2; ++bj) { const f32x4 v0 = acc[ai][bj][m][0], v1 = acc[ai][bj][m][1];
                    u32x4 w; w.x = cvt_pk_bf16(v0[0], v0[1]); w.y = cvt_pk_bf16(v0[2], v0[3]); w.z = cvt_pk_bf16(v1[0], v1[1]); w.w = cvt_pk_bf16(v1[2], v1[3]);
                    *(u32x4*)(rowp + bj * HALF) = w; } }
    }
};
struct DenseSched {
    static constexpr bool GATHER = false; static constexpr int NSEG = 1;
    const char* A; const char* B; int lda, ldb, nM, nN, G, c;
    DI bool next(int i, Unit& u) const { const int L = i * G + c; if (L >= nM * nN) return false;
        const int grp = L / (8 * nN), rem = L % (8 * nN), fm = grp * 8, gsz = (nM - fm) < 8 ? (nM - fm) : 8; u.pm = fm + rem % gsz; u.pn = rem / gsz; u.aux = 0; return true; }
    DI const char* a_base(const Unit& u) const { return A + (size_t)u.pm * BM * lda * 2; }
    DI const char* b_base(const Unit& u, int) const { return B + (size_t)u.pn * BM * ldb * 2; }
    DI void a_rows(const Unit&, int&, int&) const {}
    DI const int* rows_ptr(const Unit&) const { return nullptr; }
    DI int rows_lim(const Unit&) const { return 0; }
};
}

DI int build_tiles(const Frame& F, int l, int* tile_bucket  , int* boff  ) {
    const unsigned* cnt = F.wsp<unsigned>(WS_SYNC) + CNT_OFF_WORDS + l * 32;
    int* ntl = boff + NBUCKET + 1;
    __syncthreads();
    if (F.tid < NBUCKET) { const int c_ = (int)cnt[F.tid]; ntl[F.tid] = (c_ + 255) >> 8; ntl[NBUCKET + F.tid] = c_; }
    __syncthreads();
    if (F.tid <= NBUCKET) { int o = 0;
#pragma unroll
        for (int k = 0; k < NBUCKET; ++k) { const int v_ = ntl[k]; o += k < F.tid ? v_ : 0; }
        boff[F.tid] = o; }
    __syncthreads();
    if (F.tid < MAXTILES) { int b = 0;
#pragma unroll
        for (int k = 1; k < NBUCKET; ++k) b += F.tid >= boff[k] ? 1 : 0;
        tile_bucket[F.tid] = b; }
    __syncthreads();
    return boff[NBUCKET];
}
DI void bucket_experts(int bucket, int& elo, int& ehi) { const int g = bucket / 6, pr = bucket % 6; const int lo = pr < 3 ? 0 : (pr < 5 ? 1 : 2), hi = pr < 3 ? pr + 1 : (pr < 5 ? pr - 1 : 3); elo = g * 4 + lo; ehi = g * 4 + hi; }

typedef short bf16x8 __attribute__((ext_vector_type(8)));
typedef float f32x16 __attribute__((ext_vector_type(16)));
#define MFMA32(a, b, c) __builtin_amdgcn_mfma_f32_32x32x16_bf16((a), (b), (c), 0, 0, 0)
constexpr float LOG2E = 1.4426950408889634f;
DI int swap23(int x) { return (x & 0x13) | ((x & 4) << 1) | ((x & 8) >> 1); }
DI unsigned cvtpk(float lo, float hi) { unsigned r; asm volatile("s_nop 0\n\tv_cvt_pk_bf16_f32 %0, %1, %2" : "=v"(r) : "v"(lo), "v"(hi)); return r; }
DI void softmax_tile(f32x16 (&st)[2], float& m, float& ls, f32x16& oa, f32x16& ob, bf16x8 (&pf)[2][2]) {
    float mx = st[0][0];
#pragma unroll
    for (int i = 1; i < 16; ++i) mx = fmaxf(mx, st[0][i]);
#pragma unroll
    for (int i = 0; i < 16; ++i) mx = fmaxf(mx, st[1][i]);
    mx = fmaxf(mx, __shfl_xor(mx, 32));
    const bool need = mx > m + 8.f;
    if (__any(need)) { const float mn = need ? mx : m; const float al = __builtin_amdgcn_exp2f(m - mn); m = mn; ls *= al; oa *= al; ob *= al; }
    float ps = 0.f;
#pragma unroll
    for (int s = 0; s < 2; ++s)
#pragma unroll
        for (int i = 0; i < 16; ++i) { const float p = __builtin_amdgcn_exp2f(st[s][i] - m); ps += p; st[s][i] = p; }
    ls += ps;
#pragma unroll
    for (int s = 0; s < 2; ++s)
#pragma unroll
        for (int k = 0; k < 2; ++k) { u32x4 w; w[0] = cvtpk(st[s][8 * k], st[s][8 * k + 1]); w[1] = cvtpk(st[s][8 * k + 2], st[s][8 * k + 3]); w[2] = cvtpk(st[s][8 * k + 4], st[s][8 * k + 5]); w[3] = cvtpk(st[s][8 * k + 6], st[s][8 * k + 7]);
            pf[s][k] = __builtin_bit_cast(bf16x8, w); }
}
template <int MODE, bool CTXQ> DI void attn_mfma_unit(const Frame& F, int l, int b, int head, int qblk) {
    const KParams Pp = F.p;
    LAS unsigned char* lds = (LAS unsigned char*)F.lds;
    LAS float* rpb = (LAS float*)(lds + 32768);
    const int lane = F.lane, r = lane & 31, h = lane >> 5, w = F.wid;
    const bf16_t* proj = F.wsp<bf16_t>(WS_BIG + BIG_PROJ);
    const int kh = MODE == 0 ? head : (MODE == 1 ? 6 + head : 10 + head / 3);
    const bf16_t* KP = F.wsp<bf16_t>(WS_BIG + BIG_KPOST) + (size_t)(b * NKH + kh) * KEYS * 64;
    const bf16_t* VT = F.wsp<bf16_t>(WS_BIG + BIG_VT) + (size_t)(b * NKH + kh) * 64 * KEYS;
    const int sq = CTXQ ? 0 : qblk * 256 + w * 32 + r;
    const int t = CTXQ ? NLAT + b * CTXL + w * 32 + r : b * SEQ + sq;
    const int qrow = sq >> 6, qcol = sq & 63;
    __syncthreads();
    if (MODE == 0 && !CTXQ) for (int i = F.tid; i < 15 * 31; i += NWG_THREADS) rpb[i] = gin(Pp, 10)[((size_t)l * 6 + head) * 465 + i] * LOG2E;
    bf16x8 qf[4];
    { const bf16_t* src = proj + (size_t)t * 1024 + ((MODE == 0 ? 0 : (MODE == 1 ? 6 : 10)) + head) * 64 + 8 * h;
#pragma unroll
      for (int ks = 0; ks < 4; ++ks) qf[ks] = *(const bf16x8*)(src + 16 * ks); }
    int ntile, rlo = 0;
    if (CTXQ) ntile = 4;
    else if (MODE == 0) { const int R0 = qblk * 4; rlo = clampi(R0 - 4, 0, 120); const int rhi = clampi(R0 + 3 - 4, 0, 120) + 7; ntile = 4 + (rhi - rlo + 1); }
    else ntile = KEYS / 64;
    const int wrow = CTXQ ? 0 : (qblk * 256 + w * 32) >> 6;
    const int r0w = clampi(wrow - 4, 0, 120), c0 = clampi(qcol - 8, 0, 48);
    const int srow = F.tid >> 3, schunk = F.tid & 7;
    const unsigned sdst = (unsigned)(srow * 128 + ((schunk ^ ((srow >> 1) & 7)) << 4));
    const bf16_t* kg = KP + (size_t)srow * 64 + schunk * 8;
    const bf16_t* vg = VT + (size_t)srow * KEYS + schunk * 8;
#define TILE_KEY0(ti) ((MODE == 0 && !CTXQ && (ti) >= 4) ? CTXL + (rlo + (ti) - 4) * 64 : (ti) * 64)
    u32x4 kreg, vreg;
    { const int k0 = TILE_KEY0(0); kreg = *(const u32x4*)(kg + (size_t)k0 * 64); vreg = *(const u32x4*)(vg + k0); }
    *(LAS u32x4*)(lds + sdst) = kreg; *(LAS u32x4*)(lds + 16384 + sdst) = vreg;
    __syncthreads();
    constexpr int NO = MODE == 1 ? 4 : 2;
    f32x16 o[NO];
#pragma unroll
    for (int i = 0; i < NO; ++i)
#pragma unroll
        for (int j = 0; j < 16; ++j) o[i][j] = 0.f;
    float m1 = -1e30f, l1 = 0.f, m2 = -1e30f, l2 = 0.f;
    const unsigned krd = (unsigned)(swap23(r) * 128), vrd = (unsigned)(r * 128);
    const int kswz = (swap23(r) >> 1) & 7, vswz = (r >> 1) & 7;
#pragma unroll 1
    for (int ti = 0; ti < ntile; ++ti) {
        const int buf = ti & 1;
        if (ti + 1 < ntile) { const int k0 = TILE_KEY0(ti + 1); kreg = *(const u32x4*)(kg + (size_t)k0 * 64); vreg = *(const u32x4*)(vg + k0); }
        bool relevant = true; int krow = 0;
        if (MODE == 0 && !CTXQ && ti >= 4) { krow = rlo + ti - 4; relevant = krow >= r0w && krow < r0w + 8; }
        if (relevant) {
            LAS unsigned char* kb = lds + buf * 8192; LAS unsigned char* vb = lds + 16384 + buf * 8192;
#pragma unroll
            for (int pass = 0; pass < (MODE == 1 ? 2 : 1); ++pass) {
                if (pass == 1) __builtin_amdgcn_sched_barrier(0);
                f32x16 st[2];
#pragma unroll
                for (int s = 0; s < 2; ++s)
#pragma unroll
                    for (int j = 0; j < 16; ++j) st[s][j] = 0.f;
#pragma unroll
                for (int kk = 0; kk < (MODE == 1 ? 2 : 4); ++kk) { const int ks = MODE == 1 ? pass * 2 + kk : kk;
#pragma unroll
                    for (int s = 0; s < 2; ++s) { const bf16x8 kf = *(const LAS bf16x8*)(kb + s * 4096 + krd + (((2 * ks + h) ^ kswz) << 4)); st[s] = MFMA32(kf, qf[ks], st[s]); } }
                if (MODE == 0 && !CTXQ && ti >= 4) { const int dr = krow - wrow + 7;
#pragma unroll
                    for (int s = 0; s < 2; ++s)
#pragma unroll
                        for (int i = 0; i < 16; ++i) { const int kc = s * 32 + 16 * (i >> 3) + 8 * h + (i & 7); const int dc = clampi(kc - qcol + 15, 0, 30); const bool valid = kc >= c0 && kc < c0 + 16;
                            st[s][i] = valid ? st[s][i] + rpb[dr * 31 + dc] : -3e38f; } }
                bf16x8 pf[2][2];
                if (pass == 0) softmax_tile(st, m1, l1, o[0], o[1], pf); else softmax_tile(st, m2, l2, o[NO - 2], o[NO - 1], pf);
#pragma unroll
                for (int ds = 0; ds < 2; ++ds)
#pragma unroll
                    for (int s = 0; s < 2; ++s)
#pragma unroll
                        for (int k = 0; k < 2; ++k) { const bf16x8 vf = *(const LAS bf16x8*)(vb + ds * 4096 + vrd + (((4 * s + 2 * k + h) ^ vswz) << 4)); o[pass * 2 + ds] = MFMA32(vf, pf[s][k], o[pass * 2 + ds]); }
            }
        }
        if (ti + 1 < ntile) { *(LAS u32x4*)(lds + (buf ^ 1) * 8192 + sdst) = kreg; *(LAS u32x4*)(lds + 16384 + (buf ^ 1) * 8192 + sdst) = vreg; }
        __syncthreads();
    }
#undef TILE_KEY0
    l1 += __shfl_xor(l1, 32); const float inv1 = 1.f / l1;
    if (MODE == 1) { l2 += __shfl_xor(l2, 32); const float inv2 = 1.f / l2;
        const float lam = F.wsp<float>(WS_LAM)[l * 2], li = F.wsp<float>(WS_LAM)[l * 2 + 1]; const float c2 = lam * inv2; float ss = 0.f;
#pragma unroll
        for (int ds = 0; ds < 2; ++ds)
#pragma unroll
            for (int i = 0; i < 16; ++i) { const float v = o[ds][i] * inv1 - c2 * o[2 + ds][i]; o[ds][i] = v; ss += v * v; }
        ss += __shfl_xor(ss, 32);
        const float rstd = rsqrtf(ss * (1.f / 64) + 1e-6f) * (1.f - li); const float* sub = gin(Pp, 15) + l * 64;
#pragma unroll
        for (int ds = 0; ds < 2; ++ds)
#pragma unroll
            for (int i = 0; i < 16; ++i) o[ds][i] = o[ds][i] * rstd * sub[32 * ds + (i & 3) + 8 * (i >> 2) + 4 * h];
    } else {
#pragma unroll
        for (int ds = 0; ds < 2; ++ds)
#pragma unroll
            for (int i = 0; i < 16; ++i) o[ds][i] *= inv1;
    }
    bf16_t* dst = F.wsp<bf16_t>(WS_ACT) + (size_t)t * D + (MODE == 0 ? 0 : (MODE == 1 ? 384 : 640)) + head * 64 + 4 * h;
#pragma unroll
    for (int ds = 0; ds < 2; ++ds)
#pragma unroll
        for (int g = 0; g < 4; ++g) { u32x2 wv; wv[0] = cvtpk(o[ds][4 * g], o[ds][4 * g + 1]); wv[1] = cvtpk(o[ds][4 * g + 2], o[ds][4 * g + 3]); *(u32x2*)(dst + 32 * ds + 8 * g) = wv; }
}
DI float xhalf_sum(float v) { const auto r = __builtin_amdgcn_permlane32_swap(__float_as_uint(v), __float_as_uint(v), false, false); return __uint_as_float(r[0]) + __uint_as_float(r[1]); }
DI unsigned exp2_acc_pack(float x0, float x1, float& ps0, float& ps1) {
    float p0, p1; unsigned pk;
    asm volatile("v_exp_f32 %0, %5\n\tv_exp_f32 %1, %6\n\tv_add_f32 %2, %0, %2\n\tv_add_f32 %3, %1, %3\n\tv_cvt_pk_bf16_f32 %4, %0, %1"
                 : "=&v"(p0), "=&v"(p1), "+v"(ps0), "+v"(ps1), "=&v"(pk) : "v"(x0), "v"(x1));
    return pk;
}
DI void exp2_pair(float x0, float x1, float& p0, float& p1) { asm volatile("v_exp_f32 %0, %2\n\tv_exp_f32 %1, %3" : "=&v"(p0), "=&v"(p1) : "v"(x0), "v"(x1)); }
DI unsigned acc_pack2(float p0, float p1, float& ps0, float& ps1) {
    unsigned pk; asm volatile("v_add_f32 %0, %3, %0\n\tv_add_f32 %1, %4, %1\n\tv_cvt_pk_bf16_f32 %2, %3, %4" : "+v"(ps0), "+v"(ps1), "=&v"(pk) : "v"(p0), "v"(p1)); return pk; }
template <int NKS> DI void attn_stream_core(LAS unsigned char* lds, const int w, const int lane, const bf16_t* KP, const bf16_t* VT, const bf16x8 (&qf)[NKS], const int kc0, f32x16 (&o)[2], float& ls) {
    const int r = lane & 31, h = lane >> 5;
    const int drow = 8 * w + (lane >> 3), dch = (lane & 7) ^ ((drow >> 1) & 7);
    const bf16_t* kg = KP + (size_t)drow * 64 + dch * 8;
    const bf16_t* vg = VT + (size_t)drow * KEYS + dch * 8;
    LAS unsigned char* kdst = lds + w * 1024; LAS unsigned char* vdst = lds + 32768 + w * 1024;
#define DMA_K(ti, off) __builtin_amdgcn_global_load_lds((const unsigned*)(kg + (size_t)(ti) * 64 * 64), (LAS unsigned*)(kdst + (off)), 16, 0, 0)
#define DMA_V(ti, off) __builtin_amdgcn_global_load_lds((const unsigned*)(vg + (size_t)(ti) * 64), (LAS unsigned*)(vdst + (off)), 16, 0, 0)
    const unsigned krd = (unsigned)(swap23(r) * 128), vrd = (unsigned)(r * 128);
    const int kswz = (swap23(r) >> 1) & 7, vswz = (r >> 1) & 7;
#define KFRAG(kb, s, ks) (*(const LAS bf16x8*)((kb) + (s) * 4096 + krd + (((kc0 + 2 * (ks) + h) ^ kswz) << 4)))
#define VFRAG(vb, ds, s, k) (*(const LAS bf16x8*)((vb) + (ds) * 4096 + vrd + (((4 * (s) + 2 * (k) + h) ^ vswz) << 4)))
#define PIN __builtin_amdgcn_sched_barrier(0)
    constexpr int ntile = KEYS / 64, nstage = ntile / 2;
    const f32x16 zero16 = {0.f, 0.f, 0.f, 0.f, 0.f, 0.f, 0.f, 0.f, 0.f, 0.f, 0.f, 0.f, 0.f, 0.f, 0.f, 0.f};
    o[0] = zero16; o[1] = zero16;
    float ps0 = 0.f, ps1 = 0.f;
    DMA_K(0, 16384 + 8192); DMA_K(1, 0); DMA_K(2, 8192); DMA_V(0, 0); DMA_V(1, 8192);
    asm volatile("s_waitcnt vmcnt(0)" ::: "memory");
    __syncthreads();
    f32x16 sa[2], sb[2];
#pragma unroll
    for (int s = 0; s < 2; ++s) { sa[s] = MFMA32(KFRAG(lds + 16384 + 8192, s, 0), qf[0], zero16);
#pragma unroll
        for (int ks = 1; ks < NKS; ++ks) sa[s] = MFMA32(KFRAG(lds + 16384 + 8192, s, ks), qf[ks], sa[s]); }
    sb[0] = zero16; sb[1] = zero16;
    bf16x8 pfh[2], vfh[2][2];
    { const bf16x8 z8 = {0, 0, 0, 0, 0, 0, 0, 0}; pfh[0] = z8; pfh[1] = z8; vfh[0][0] = z8; vfh[0][1] = z8; vfh[1][0] = z8; vfh[1][1] = z8; }
    __syncthreads();
#define STREAM_TILE(SC, SN, kbn, vb) do { \
        bf16x8 kf0[NKS], kf1[NKS], vf0[2][2]; u32x4 pw0[2], pw1[2]; \
        _Pragma("unroll") for (int ks = 0; ks < NKS; ++ks) kf0[ks] = KFRAG(kbn, 0, ks); \
        _Pragma("unroll") for (int ds = 0; ds < 2; ++ds) _Pragma("unroll") for (int k = 0; k < 2; ++k) vf0[ds][k] = VFRAG(vb, ds, 0, k); \
        PIN; \
          \
        _Pragma("unroll") for (int g = 0; g < 8; ++g) { float e0, e1; \
            exp2_pair(SC[0][2 * g], SC[0][2 * g + 1], e0, e1); PIN; \
            if (g < 4) o[g & 1] = MFMA32(vfh[g & 1][g >> 1], pfh[g >> 1], o[g & 1]); \
            else if (g - 4 < NKS) SN[0] = MFMA32(kf0[g - 4], qf[g - 4], g == 4 ? zero16 : SN[0]); \
            if (g == 4) { _Pragma("unroll") for (int ks = 0; ks < NKS; ++ks) kf1[ks] = KFRAG(kbn, 1, ks); } \
            PIN; pw0[g >> 2][g & 3] = acc_pack2(e0, e1, ps0, ps1); \
            PIN; } \
          \
        _Pragma("unroll") for (int g = 0; g < 8; ++g) { float e0, e1; \
            exp2_pair(SC[1][2 * g], SC[1][2 * g + 1], e0, e1); PIN; \
            if (g < NKS) SN[1] = MFMA32(kf1[g], qf[g], g == 0 ? zero16 : SN[1]); \
            else if (g - NKS < 4) o[(g - NKS) & 1] = MFMA32(vf0[(g - NKS) & 1][(g - NKS) >> 1], __builtin_bit_cast(bf16x8, pw0[(g - NKS) >> 1]), o[(g - NKS) & 1]); \
            if (g == 1) { _Pragma("unroll") for (int ds = 0; ds < 2; ++ds) _Pragma("unroll") for (int k = 0; k < 2; ++k) vfh[ds][k] = VFRAG(vb, ds, 1, k); } \
            PIN; pw1[g >> 2][g & 3] = acc_pack2(e0, e1, ps0, ps1); \
            PIN; } \
        pfh[0] = __builtin_bit_cast(bf16x8, pw1[0]); pfh[1] = __builtin_bit_cast(bf16x8, pw1[1]); \
    } while (0)
    if (w >= 4) __builtin_amdgcn_s_setprio(1);
#pragma unroll 1
    for (int st = 0; st < nstage; ++st) {
        const int cur = (st & 1) * 16384, nxt = 16384 - cur;
        if (st + 1 < nstage) { DMA_K(2 * st + 3, nxt); if (2 * st + 4 < ntile) DMA_K(2 * st + 4, nxt + 8192); DMA_V(2 * st + 2, nxt); DMA_V(2 * st + 3, nxt + 8192); }
        STREAM_TILE(sa, sb, lds + cur, lds + 32768 + cur);
        STREAM_TILE(sb, sa, lds + cur + 8192, lds + 32768 + cur + 8192);
        asm volatile("s_waitcnt vmcnt(0)" ::: "memory");
        __syncthreads();
    }
#undef STREAM_TILE
    __builtin_amdgcn_s_setprio(0);
#pragma unroll
    for (int g = 0; g < 4; ++g) o[g & 1] = MFMA32(vfh[g & 1][g >> 1], pfh[g >> 1], o[g & 1]);
    ls = ps0 + ps1;
#undef DMA_K
#undef DMA_V
#undef KFRAG
#undef VFRAG
#undef PIN
}
DI void store_o64(LAS unsigned char* stg, bf16_t* gbase  , const f32x16 (&o)[2], int lane) {
    const int r = lane & 31, h = lane >> 5;
#pragma unroll
    for (int ds = 0; ds < 2; ++ds)
#pragma unroll
        for (int g = 0; g < 4; ++g) { u32x2 wv; wv[0] = cvtpk(o[ds][4 * g], o[ds][4 * g + 1]); wv[1] = cvtpk(o[ds][4 * g + 2], o[ds][4 * g + 3]);
            *(LAS u32x2*)(stg + r * 128 + (((4 * ds + g) ^ (r & 7)) << 4) + 8 * h) = wv; }
#pragma unroll
    for (int i = 0; i < 4; ++i) { const int idx = lane + 64 * i, row = idx >> 3, ch = idx & 7;
        const u32x4 v = *(const LAS u32x4*)(stg + row * 128 + ((ch ^ (row & 7)) << 4));
        *(u32x4*)(gbase + (size_t)row * D + ch * 8) = v; }
}
constexpr int OSTG_OFF = 65536 + 1024 + 32768;
DI void attn_fast_unit_c(const Frame& F, int l, int b, int head, int qblk) {
    const KParams Pp = F.p;
    LAS unsigned char* lds = (LAS unsigned char*)F.lds;
    const int lane = F.lane, r = lane & 31, h = lane >> 5, w = F.wid, kh = 10 + head / 3;
    const bf16_t* KP = F.wsp<bf16_t>(WS_BIG + BIG_KPOST) + (size_t)(b * NKH + kh) * KEYS * 64;
    const bf16_t* VT = F.wsp<bf16_t>(WS_BIG + BIG_VT) + (size_t)(b * NKH + kh) * 64 * KEYS;
    const int sq = qblk * 256 + w * 32 + r, t = b * SEQ + sq, qrow = sq >> 6, qcol = sq & 63;
    bf16x8 qf[4];
    { const bf16_t* src = F.wsp<bf16_t>(WS_BIG + BIG_PROJ) + (size_t)t * 1024 + (10 + head) * 64 + 8 * h;
#pragma unroll
      for (int ks = 0; ks < 4; ++ks) qf[ks] = *(const bf16x8*)(src + 16 * ks); }
    f32x16 o[2]; float ls;
    __syncthreads();
    attn_stream_core<4>(lds, w, lane, KP, VT, qf, 0, o, ls);
    ls = xhalf_sum(ls); const float inv = 1.f / ls;
#pragma unroll
    for (int ds = 0; ds < 2; ++ds)
#pragma unroll
        for (int i = 0; i < 16; ++i) o[ds][i] *= inv;
    store_o64(lds + OSTG_OFF + w * 4096, F.wsp<bf16_t>(WS_ACT) + (size_t)(b * SEQ + qblk * 256 + w * 32) * D + 640 + head * 64, o, lane);
}
DI bool gqa_fast_ok(const Frame& F, int l, int b, int kvh) {
    const float g = F.wsp<float>(WS_LAM)[32 + l];
    const float qb = 8.f * g * 1.0001f * 0.125f * LOG2E * 1.01f;
    const float k2 = __uint_as_float(F.wsp<unsigned>(WS_SYNC)[KMAX_OFF_WORDS + l * 48 + b * NKH + 10 + kvh]);
    return qb * qb * k2 < 3600.f;
}
DI bool attn_fast_unit_b(const Frame& F, int l, int b, int head, int qblk) {
    const KParams Pp = F.p;
    LAS unsigned char* lds = (LAS unsigned char*)F.lds;
    LAS float* wmax = (LAS float*)(lds + 65536);
    LAS float* exch = (LAS float*)(lds + 65536 + 1024);
    const int lane = F.lane, r = lane & 31, h = lane >> 5, w = F.wid, stream = w >> 2, qw = w & 3, kh = 6 + head;
    const bf16_t* KP = F.wsp<bf16_t>(WS_BIG + BIG_KPOST) + (size_t)(b * NKH + kh) * KEYS * 64;
    const bf16_t* VT = F.wsp<bf16_t>(WS_BIG + BIG_VT) + (size_t)(b * NKH + kh) * 64 * KEYS;
    const float* ropeB = F.wsp<float>(WS_ROPEB);
    const bf16_t* qsrc = F.wsp<bf16_t>(WS_BIG + BIG_PROJ) + (size_t)(b * SEQ + qblk * 256 + qw * 32 + r) * 1024 + (6 + head) * 64 + stream * 32 + 8 * h;
    float qn2 = 0.f;
#pragma unroll
    for (int half = 0; half < 2; ++half) {
        const bf16_t* src = qsrc + (size_t)half * 128 * 1024;
        float na = 0.f;
#pragma unroll
        for (int ks = 0; ks < 2; ++ks) { const u32x4 wv = *(const u32x4*)(src + 16 * ks);
#pragma unroll
            for (int j = 0; j < 4; ++j) { const float x = __uint_as_float(wv[j] << 16), y = __uint_as_float(wv[j] & 0xffff0000u); na += x * x + y * y; } }
        qn2 = fmaxf(qn2, xhalf_sum(na));
    }
#pragma unroll
    for (int of = 16; of; of >>= 1) qn2 = fmaxf(qn2, __shfl_xor(qn2, of));
    __syncthreads();
    if (lane == 0) wmax[w] = qn2;
    __syncthreads();
    bool fast;
    { float q2 = wmax[0];
#pragma unroll
      for (int i = 1; i < 8; ++i) q2 = fmaxf(q2, wmax[i]);
      const float k2 = __uint_as_float(F.wsp<unsigned>(WS_SYNC)[KMAX_OFF_WORDS + l * 48 + b * NKH + kh]);
      fast = q2 * k2 < 3600.f; }
    if (!fast) return false;
    const float lam = F.wsp<float>(WS_LAM)[l * 2], li = F.wsp<float>(WS_LAM)[l * 2 + 1];
#pragma unroll 1
    for (int half = 0; half < 2; ++half) {
        f32x16 o[2]; float ls;
        if (half) __syncthreads();
        bf16x8 qh[2]; qh[0] = *(const bf16x8*)(qsrc + (size_t)half * 128 * 1024); qh[1] = *(const bf16x8*)(qsrc + (size_t)half * 128 * 1024 + 16);
        attn_stream_core<2>(lds, w, lane, KP, VT, qh, stream * 4, o, ls);
        ls = xhalf_sum(ls);
        if (stream == 1) { const float c2 = lam / ls;
#pragma unroll
            for (int ds = 0; ds < 2; ++ds)
#pragma unroll
                for (int i = 0; i < 16; ++i) exch[(qw * 32 + ds * 16 + i) * 64 + lane] = o[ds][i] * c2; }
        f32x4 subv[2][4];
        if (stream == 0) { const float* sub = gin(Pp, 15) + l * 64 + 4 * h;
#pragma unroll
            for (int ds = 0; ds < 2; ++ds)
#pragma unroll
                for (int g = 0; g < 4; ++g) subv[ds][g] = *(const f32x4*)(sub + 32 * ds + 8 * g); }
        __syncthreads();
        if (stream == 0) { const float inv = 1.f / ls; float ss = 0.f;
#pragma unroll
            for (int ds = 0; ds < 2; ++ds)
#pragma unroll
                for (int i = 0; i < 16; ++i) { const float v = o[ds][i] * inv - exch[(qw * 32 + ds * 16 + i) * 64 + lane]; o[ds][i] = v; ss += v * v; }
            ss = xhalf_sum(ss);
            const float rstd = rsqrtf(ss * (1.f / 64) + 1e-6f) * (1.f - li);
#pragma unroll
            for (int ds = 0; ds < 2; ++ds)
#pragma unroll
                for (int i = 0; i < 16; ++i) o[ds][i] = o[ds][i] * rstd * subv[ds][i >> 2][i & 3];
            store_o64(lds + OSTG_OFF + w * 4096, F.wsp<bf16_t>(WS_ACT) + (size_t)(b * SEQ + qblk * 256 + half * 128 + qw * 32) * D + 384 + head * 64, o, lane); }
    }
    return true;
}
DI void attn_na_fast_unit(const Frame& F, int l, int b, int head, int qblk) {
    const KParams Pp = F.p;
    LAS unsigned char* lds = (LAS unsigned char*)F.lds;
    LAS float* rpb = (LAS float*)(lds + 65536);
    const int lane = F.lane, r = lane & 31, h = lane >> 5, w = F.wid;
    const bf16_t* KP = F.wsp<bf16_t>(WS_BIG + BIG_KPOST) + (size_t)(b * NKH + head) * KEYS * 64;
    const bf16_t* VT = F.wsp<bf16_t>(WS_BIG + BIG_VT) + (size_t)(b * NKH + head) * 64 * KEYS;
    const int sq = qblk * 256 + w * 32 + r, qcol = sq & 63;
    __syncthreads();
    for (int i = F.tid; i < 15 * 31; i += NWG_THREADS) rpb[i] = gin(Pp, 10)[((size_t)l * 6 + head) * 465 + i] * LOG2E;
    bf16x8 qf[4];
    { const bf16_t* src = F.wsp<bf16_t>(WS_BIG + BIG_PROJ) + (size_t)(b * SEQ + sq) * 1024 + head * 64 + 8 * h;
#pragma unroll
      for (int ks = 0; ks < 4; ++ks) qf[ks] = *(const bf16x8*)(src + 16 * ks); }
    const int R0 = qblk * 4, rlo = clampi(R0 - 4, 0, 120), rhi = clampi(R0 + 3 - 4, 0, 120) + 7, ntile = 4 + (rhi - rlo + 1);
    const int wrow = (qblk * 256 + w * 32) >> 6, r0w = clampi(wrow - 4, 0, 120), c0 = clampi(qcol - 8, 0, 48);
    const int tbase = 8 * h - c0;
    const int drow = 8 * w + (lane >> 3), dch = (lane & 7) ^ ((drow >> 1) & 7);
    const bf16_t* kg = KP + (size_t)drow * 64 + dch * 8;
    const bf16_t* vg = VT + (size_t)drow * KEYS + dch * 8;
    LAS unsigned char* kdst = lds + w * 1024; LAS unsigned char* vdst = lds + 32768 + w * 1024;
#define NA_KEY0(ti) ((ti) >= 4 ? CTXL + (rlo + (ti) - 4) * 64 : (ti) * 64)
#define NA_DMA(ti) do { const int k0_ = NA_KEY0(ti); __builtin_amdgcn_global_load_lds((const unsigned*)(kg + (size_t)k0_ * 64), (LAS unsigned*)(kdst + ((ti) & 3) * 8192), 16, 0, 0); \
                         __builtin_amdgcn_global_load_lds((const unsigned*)(vg + k0_), (LAS unsigned*)(vdst + ((ti) & 3) * 8192), 16, 0, 0); } while (0)
    const unsigned krd = (unsigned)(swap23(r) * 128), vrd = (unsigned)(r * 128);
    const int kswz = (swap23(r) >> 1) & 7, vswz = (r >> 1) & 7;
    const f32x16 zero16 = {0.f, 0.f, 0.f, 0.f, 0.f, 0.f, 0.f, 0.f, 0.f, 0.f, 0.f, 0.f, 0.f, 0.f, 0.f, 0.f};
    f32x16 o[2] = {zero16, zero16};
    float ps0 = 0.f, ps1 = 0.f;
    NA_DMA(0); NA_DMA(1); NA_DMA(2);
    asm volatile("s_waitcnt vmcnt(4) lgkmcnt(0)" ::: "memory");
    __builtin_amdgcn_s_barrier(); asm volatile("" ::: "memory");
#pragma unroll 1
    for (int ti = 0; ti < ntile; ++ti) {
        if (ti + 3 < ntile) NA_DMA(ti + 3);
        const int krow = rlo + ti - 4;
        const bool relevant = ti < 4 || (krow >= r0w && krow < r0w + 8);
        if (relevant) {
            LAS unsigned char* kb = lds + (ti & 3) * 8192; LAS unsigned char* vb = lds + 32768 + (ti & 3) * 8192;
            f32x16 st[2];
#pragma unroll
            for (int s_ = 0; s_ < 2; ++s_) { st[s_] = MFMA32(*(const LAS bf16x8*)(kb + s_ * 4096 + krd + (((0 + h) ^ kswz) << 4)), qf[0], zero16);
#pragma unroll
                for (int ks = 1; ks < 4; ++ks) st[s_] = MFMA32(*(const LAS bf16x8*)(kb + s_ * 4096 + krd + (((2 * ks + h) ^ kswz) << 4)), qf[ks], st[s_]); }
            if (ti >= 4) { LAS const float* brow = rpb + (krow - wrow + 7) * 31 + (8 * h - qcol + 15);
                float bv[2][16];
#pragma unroll
                for (int s_ = 0; s_ < 2; ++s_)
#pragma unroll
                    for (int i = 0; i < 16; ++i) { bv[s_][i] = brow[s_ * 32 + 16 * (i >> 3) + (i & 7)]; }
#pragma unroll
                for (int s_ = 0; s_ < 2; ++s_)
#pragma unroll
                    for (int i = 0; i < 16; ++i) asm volatile("" : "+v"(bv[s_][i]));
#pragma unroll
                for (int s_ = 0; s_ < 2; ++s_)
#pragma unroll
                    for (int i = 0; i < 16; ++i) { const int kcc = s_ * 32 + 16 * (i >> 3) + (i & 7); const bool valid = (unsigned)(kcc + tbase) < 16u; st[s_][i] = valid ? st[s_][i] + bv[s_][i] : -3e38f; }
            } else asm volatile("s_nop 7\n\ts_nop 7" ::: "memory");
            u32x4 pw[2][2];
#pragma unroll
            for (int s_ = 0; s_ < 2; ++s_)
#pragma unroll
                for (int g = 0; g < 8; ++g) pw[s_][g >> 2][g & 3] = exp2_acc_pack(st[s_][2 * g], st[s_][2 * g + 1], ps0, ps1);
            asm volatile("s_nop 1" ::: "memory");
#pragma unroll
            for (int ds = 0; ds < 2; ++ds)
#pragma unroll
                for (int s_ = 0; s_ < 2; ++s_)
#pragma unroll
                    for (int k = 0; k < 2; ++k) o[ds] = MFMA32(*(const LAS bf16x8*)(vb + ds * 4096 + vrd + (((4 * s_ + 2 * k + h) ^ vswz) << 4)), __builtin_bit_cast(bf16x8, pw[s_][k]), o[ds]);
        }
        if (ti + 3 < ntile) asm volatile("s_waitcnt vmcnt(4) lgkmcnt(0)" ::: "memory"); else asm volatile("s_waitcnt vmcnt(0) lgkmcnt(0)" ::: "memory");
        __builtin_amdgcn_s_barrier(); asm volatile("" ::: "memory");
    }
#undef NA_DMA
#undef NA_KEY0
    const float ls = xhalf_sum(ps0 + ps1), inv = 1.f / ls;
#pragma unroll
    for (int ds = 0; ds < 2; ++ds)
#pragma unroll
        for (int i = 0; i < 16; ++i) o[ds][i] *= inv;
    store_o64(lds + OSTG_OFF + w * 4096, F.wsp<bf16_t>(WS_ACT) + (size_t)(b * SEQ + qblk * 256 + w * 32) * D + head * 64, o, lane);
}
DI bool na_fast_ok(const Frame& F, int l, int b, int head) {
    const float q2 = __uint_as_float(F.wsp<unsigned>(WS_SYNC)[QMAX_OFF_WORDS + l * 64 + b * 16 + head]), k2 = __uint_as_float(F.wsp<unsigned>(WS_SYNC)[KMAX_OFF_WORDS + l * 48 + b * NKH + head]);
    const float bm = F.wsp<float>(WS_LAM)[16 + l * 6 + head];
    return sqrtf(q2 * k2) * 1.01f + bm < 60.f;
}
DI Frame relaunder(const Frame& F0) {
    Frame F = F0; int tid = F0.tid; asm volatile("" : "+v"(tid)); asm volatile("" : "+s"(F.ws), "+s"(F.p));
    F.tid = tid; F.wid = __builtin_amdgcn_readfirstlane(tid >> 6); F.lane = tid & 63; return F;
}
DI void phase_attn_mfma(const Frame& F0, int l) {
    unsigned slow_b = 0u, slow_c = 0u;
    { const Frame F = relaunder(F0); int it = 0;
      for (int u = F.wg; u < 512; u += F.nwg, ++it) { const int xs = u & 7, idx = u >> 3, pr = xs * 2 + (idx >> 5); if (!attn_fast_unit_b(F, l, pr >> 2, pr & 3, idx & 31)) slow_b |= 1u << it; } }
    if (slow_b) { const Frame F = relaunder(F0); int it = 0;
      for (int u = F.wg; u < 512; u += F.nwg, ++it) { const int xs = u & 7, idx = u >> 3, pr = xs * 2 + (idx >> 5); if (slow_b >> it & 1u) attn_mfma_unit<1, false>(F, l, pr >> 2, pr & 3, idx & 31); } }
    { const Frame F = relaunder(F0); int it = 0;
      const bool okc = gqa_fast_ok(F, l, (F.wg & 7) >> 1, F.wg & 1);
      for (int u = F.wg; u < 768; u += F.nwg, ++it) { const int xs = u & 7, idx = u >> 3; if ((F.nwg & 7) == 0 ? okc : gqa_fast_ok(F, l, xs >> 1, xs & 1)) attn_fast_unit_c(F, l, xs >> 1, (xs & 1) * 3 + (idx >> 5), idx & 31); else slow_c |= 1u << it; } }
    if (slow_c) { const Frame F = relaunder(F0); int it = 0;
      for (int u = F.wg; u < 768; u += F.nwg, ++it) { const int xs = u & 7, idx = u >> 3; if (slow_c >> it & 1u) attn_mfma_unit<2, false>(F, l, xs >> 1, (xs & 1) * 3 + (idx >> 5), idx & 31); } }
    unsigned slow_a = 0u;
    { const Frame F = relaunder(F0); int it = 0;
      unsigned oka = 0u;
      { int j = 0; for (int u = F.wg; u < 768 && j < 8; u += F.nwg, ++j) { const int pr = (u & 7) * 3 + ((u >> 3) >> 5); oka |= (na_fast_ok(F, l, pr / 6, pr % 6) ? 1u : 0u) << j; } }
      for (int u = F.wg; u < 768; u += F.nwg, ++it) { const int xs = u & 7, idx = u >> 3, pr = xs * 3 + (idx >> 5); if (it < 8 ? (oka >> it & 1u) != 0u : na_fast_ok(F, l, pr / 6, pr % 6)) attn_na_fast_unit(F, l, pr / 6, pr % 6, idx & 31); else slow_a |= 1u << it; } }
    if (slow_a) { const Frame F = relaunder(F0); int it = 0;
      for (int u = F.wg; u < 768; u += F.nwg, ++it) { const int xs = u & 7, idx = u >> 3, pr = xs * 3 + (idx >> 5); if (slow_a >> it & 1u) attn_mfma_unit<0, false>(F, l, pr / 6, pr % 6, idx & 31); } }
    if (l == 0) {
        { const Frame F = relaunder(F0); for (int u = F.wg; u < 24; u += F.nwg) attn_mfma_unit<0, true>(F, l, u / 6, u % 6, 0); }
        { const Frame F = relaunder(F0); for (int u = F.wg - 24; u >= 0 && u < 16; u += F.nwg) attn_mfma_unit<1, true>(F, l, u / 4, u % 4, 0); }
        { const Frame F = relaunder(F0); for (int u = F.wg - 40; u >= 0 && u < 24; u += F.nwg) attn_mfma_unit<2, true>(F, l, u / 6, u % 6, 0); }
    }
}

DI void phase_norm2(const Frame& F, int l) {
    const KParams Pp = F.p;
    const int M = l == 0 ? NT : NLAT;
    float* rw = F.lds;
    __syncthreads();
    for (int i = F.tid; i < 1024 * 20 / 4; i += NWG_THREADS) *(f32x4*)(rw + 4 * i) = *(const f32x4*)(F.wsp<float>(WS_RWT) + (size_t)l * 20480 + 4 * i);
    __syncthreads();
    int* sp_tok = F.wsp<int>(WS_SPTOK); float* sp_w = F.wsp<float>(WS_SPW);
    const float* gain = gin(Pp, 7) + l * D;
    bf16_t* act = F.wsp<bf16_t>(WS_ACT);
    const bf16_t* tmp16 = F.wsp<bf16_t>(WS_BIG);
    unsigned* cnt = F.wsp<unsigned>(WS_SYNC) + CNT_OFF_WORDS + l * 32;
    int4* tokinfo = F.wsp<int4>(WS_TOKINFO);
    const int stride = F.nwg * 8;
    float* lgs = rw + 20 * 1024 + F.wid * 1280;
    int nrow = 0;
    for (int t0 = 2 * (F.wg * 8 + F.wid); t0 < M; t0 += 2 * stride) {
      const int tt[2] = {t0, t0 + 1};
      const float* m = mod_row(F, l, tok_modrow(t0));
      f32x4 g1v[4], rxf[2][4]; u32x2 rxb[2][4], rtr[2][4];
#pragma unroll
      for (int i = 0; i < 4; ++i) g1v[i] = *(const f32x4*)(m + 2048 + (i * 64 + F.lane) * 4);
#pragma unroll
      for (int r = 0; r < 2; ++r) { const int t = tt[r]; const float* xs = xin_row(F, t); const bf16_t* xq = xres_row(F, t); const bf16_t* tr = tmp16 + (size_t)t * D;
#pragma unroll
          for (int i = 0; i < 4; ++i) { const int k = (i * 64 + F.lane) * 4;
              if (l == 0) rxf[r][i] = *(const f32x4*)(xs + k); else rxb[r][i] = *(const u32x2*)(xq + k);
              rtr[r][i] = *(const u32x2*)(tr + k); } }
      f32x4 gsv[4], shv[4];
#pragma unroll
      for (int i = 0; i < 4; ++i) { const int k = (i * 64 + F.lane) * 4; gsv[i] = *(const f32x4*)(gain + k); shv[i] = *(const f32x4*)(m + 3072 + k); }
      f32x4 scv[4];
#pragma unroll
      for (int i = 0; i < 4; ++i) scv[i] = *(const f32x4*)(m + 4096 + (i * 64 + F.lane) * 4);
      f32x4 vv[2][4]; float ssq[2] = {0.f, 0.f};
#pragma unroll
      for (int r = 0; r < 2; ++r) { bf16_t* xd = xres_row(F, tt[r]);
#pragma unroll
          for (int i = 0; i < 4; ++i) { const int k = (i * 64 + F.lane) * 4;
              const f32x4 xv = l == 0 ? rxf[r][i] : bf4_to_f32(rxb[r][i]);
              vv[r][i] = xv + g1v[i] * bf4_to_f32(rtr[r][i]);
              { u32x2 xo; xo[0] = cvtpk_rne(vv[r][i][0], vv[r][i][1]); xo[1] = cvtpk_rne(vv[r][i][2], vv[r][i][3]); *(u32x2*)(xd + k) = xo; }
              ssq[r] += vv[r][i][0] * vv[r][i][0] + vv[r][i][1] * vv[r][i][1] + vv[r][i][2] * vv[r][i][2] + vv[r][i][3] * vv[r][i][3]; } }
#pragma unroll
      for (int i = 0; i < 4; ++i) gsv[i] = gsv[i] * (scv[i] + 1.f);
      ssq[0] = wave_sum(ssq[0]); ssq[1] = wave_sum(ssq[1]);
#pragma unroll
      for (int r = 0; r < 2; ++r) {
        const int t = tt[r];
        const float rstd = rsqrtf(ssq[r] * (1.f / D) + 1e-6f);
        float lg[20];
        f32x2 lgp[20];
#pragma unroll
        for (int j = 0; j < 20; ++j) lgp[j] = (f32x2){0.f, 0.f};
#pragma unroll
        for (int i = 0; i < 4; ++i) { const int k = (i * 64 + F.lane) * 4;
            const f32x4 h = vv[r][i] * rstd * gsv[i] + shv[i];
            u32x2 o; o[0] = cvtpk_rne(h[0], h[1]); o[1] = cvtpk_rne(h[2], h[3]);
            *(u32x2*)(act + (size_t)t * D + k) = o;
            const f32x2 h01 = {h[0], h[1]}, h23 = {h[2], h[3]};
#pragma unroll
            for (int j = 0; j < 20; ++j) { const f32x4 w = *(const f32x4*)(rw + j * 1024 + k);
                lgp[j] = __builtin_elementwise_fma(h01, (f32x2){w[0], w[1]}, lgp[j]); lgp[j] = __builtin_elementwise_fma(h23, (f32x2){w[2], w[3]}, lgp[j]); }
            __builtin_amdgcn_sched_barrier(0); }
#pragma unroll
        for (int j = 0; j < 20; ++j) lg[j] = lgp[j][0] + lgp[j][1];
        float ra[10], rb[5];
#pragma unroll
        for (int j = 0; j < 10; ++j) ra[j] = swap32_sum(lg[j], lg[j + 10]);
#pragma unroll
        for (int j = 0; j < 5; ++j) rb[j] = dpp_row_sum(swap16_sum(ra[j], ra[j + 5]));
        if ((F.lane & 15) == 0) {
#pragma unroll
            for (int j = 0; j < 5; ++j) lgs[nrow * 20 + 5 * (F.lane >> 4) + j] = rb[j]; }
        ++nrow;
      }
    }
    if (F.lane < nrow) {
        const int t = 2 * (F.wg * 8 + F.wid) + (F.lane >> 1) * 2 * stride + (F.lane & 1);
        float lg[20];
#pragma unroll
        for (int q = 0; q < 5; ++q) { const f32x4 v = *(const f32x4*)(lgs + F.lane * 20 + 4 * q); lg[4 * q] = v[0]; lg[4 * q + 1] = v[1]; lg[4 * q + 2] = v[2]; lg[4 * q + 3] = v[3]; }
        {
            float bge[20];
#pragma unroll
            for (int j = 0; j < 4; ++j) bge[j] = gin(Pp, 19)[l * 4 + j];
#pragma unroll
            for (int j = 0; j < 16; ++j) bge[4 + j] = gin(Pp, 21)[l * 16 + j];
#pragma unroll
            for (int j = 0; j < 20; ++j) asm volatile("" : "+v"(bge[j]));
            float gl[4];
#pragma unroll
            for (int j = 0; j < 4; ++j) gl[j] = lg[j] + bge[j];
            int gs = 0; float gmax = gl[0];
#pragma unroll
            for (int j = 1; j < 4; ++j) if (gl[j] > gmax) { gmax = gl[j]; gs = j; }
            float den = 0.f;
#pragma unroll
            for (int j = 0; j < 4; ++j) den += expf(gl[j] - gmax);
            const float pg = 1.f / den;
            float ev[4];
#pragma unroll
            for (int j = 0; j < 4; ++j) { float x = 0.f;
#pragma unroll
                for (int g2 = 0; g2 < 4; ++g2) x = (g2 == gs) ? lg[4 + g2 * 4 + j] + bge[4 + g2 * 4 + j] : x;
                ev[j] = x; }
            int i1 = 0; float v1 = ev[0];
#pragma unroll
            for (int j = 1; j < 4; ++j) if (ev[j] > v1) { v1 = ev[j]; i1 = j; }
            int i2 = -1; float v2 = 0.f;
#pragma unroll
            for (int j = 0; j < 4; ++j) if (j != i1 && (i2 < 0 || ev[j] > v2)) { v2 = ev[j]; i2 = j; }
            const float w1 = 1.f / (1.f + expf(v2 - v1)), w2 = 1.f - w1;
            const int lo = i1 < i2 ? i1 : i2, hi = i1 < i2 ? i2 : i1;
            const float wlo = (i1 < i2 ? w1 : w2) * pg, whi = (i1 < i2 ? w2 : w1) * pg;
            const int pr = lo == 0 ? hi - 1 : (lo == 1 ? hi + 1 : 5);
            const int bucket = gs * 6 + pr;
            const unsigned rank = atomicAdd(&cnt[bucket], 1u);
            tokinfo[t] = make_int4(bucket, (int)rank, __float_as_int(wlo), __float_as_int(whi));
            { const size_t sp = (size_t)bucket * SPCAP + rank; sp_tok[sp] = t; *(float2*)(sp_w + 2 * sp) = make_float2(wlo, whi); }
        }
    }
}

DI void phase_scatter(const Frame& F, int l) {
    const int M = l == 0 ? NT : NLAT;
    int* tile_bucket = (int*)F.lds; int* boff = tile_bucket + MAXTILES;
    build_tiles(F, l, tile_bucket, boff);
    const int4* tokinfo = F.wsp<int4>(WS_TOKINFO);
    int* slot_tok = F.wsp<int>(WS_SLOTTOK); int* tok_slot = F.wsp<int>(WS_TOKSLOT); float* slot_w = F.wsp<float>(WS_SLOTW);
    for (int t = F.wg * NWG_THREADS + F.tid; t < M; t += F.nwg * NWG_THREADS) {
        const int4 ti = tokinfo[t];
        const int slot = boff[ti.x] * 256 + ti.y;
        slot_tok[slot] = t; tok_slot[t] = slot; slot_w[slot * 2] = __int_as_float(ti.z); slot_w[slot * 2 + 1] = __int_as_float(ti.w);
    }
}

constexpr int TAB_OFF = pg8::STAGE_BYTES;
struct InSched {
    static constexpr bool GATHER = false; static constexpr int NSEG = 1;
    const char* act; const char* W; int G, c;
    DI bool next(int i, pg8::Unit& u) const { const int L = i * G + c; if (L >= 1320) return false;
        const int grp = L / 80, rem = L % 80, fm = grp * 8, gsz = (132 - fm) < 8 ? (132 - fm) : 8, panel = fm + rem % gsz, slot = rem / gsz;
        if (slot < 7) { u.pm = panel; u.pn = slot; u.aux = 0; } else { u.pm = slot - 7; u.pn = panel; u.aux = 1; }
        return true; }
    DI const char* a_base(const pg8::Unit& u) const { return u.aux == 0 ? act + (size_t)u.pm * 256 * D * 2 : W + (size_t)(QKW + u.pm * 256) * D * 2; }
    DI const char* b_base(const pg8::Unit& u, int) const { return u.aux == 0 ? W + (size_t)u.pn * 256 * D * 2 : act + (size_t)u.pn * 256 * D * 2; }
    DI void a_rows(const pg8::Unit&, int&, int&) const {}
    DI const int* rows_ptr(const pg8::Unit&) const { return nullptr; }
    DI int rows_lim(const pg8::Unit&) const { return 0; }
};
struct InEpi {
    static constexpr bool PERM = true;
    bf16_t* qpost; bf16_t* kpost; bf16_t* VT; LAS const float* ropeB; LAS const float* ropeC; LAS const float* qn; LAS const float* kn; LAS unsigned* lmax;
    static constexpr bool WTAB = false;
    DI const float* w_ptr(const pg8::Unit&) const { return nullptr; }
    DI void pre_lds(const pg8::Unit&, int, int, const LAS float*, float (&)[8]) const {}
    DI void operator()(const f32x4 (&acc)[2][2][4][2], const pg8::Unit& u, int wr, int wc, int fr, int fq, const float (&epre)[8]) const {
        if (u.aux != 0) { pg8::EpiBf16 e{VT, KEYS, 1}; e(acc, u, wr, wc, fr, fq, epre); return; }
        const int hs = 4 * u.pn + wc;
        const bool isq = hs < 6 || (hs >= 12 && hs < 16) || (hs >= 20 && hs < 26), isb = hs >= 12 && hs < 20, isc = hs >= 20;
        const int hh = hs < 6 ? hs : (hs < 12 ? hs - 6 : (hs < 16 ? hs - 12 : (hs < 20 ? hs - 16 : (hs < 26 ? hs - 20 : hs - 26))));
        const int hidx = (isb ? 6 : (isc ? 10 : 0)) + hh;
        const int t0 = u.pm * 256; const bool lat = t0 < NLAT; const int b = lat ? (t0 >> 13) : ((t0 - NLAT) >> 8);
        const int elo = isb ? 32 * (fq >> 1) + 8 * (fq & 1) : 8 * fq, ehi = isb ? elo + 16 : elo + 32;
        f32x4 glo[2], ghi[2];
        if (isc) { LAS const float* g = isq ? qn : kn; glo[0] = *(LAS const f32x4*)(g + elo); glo[1] = *(LAS const f32x4*)(g + elo + 4); ghi[0] = *(LAS const f32x4*)(g + ehi); ghi[1] = *(LAS const f32x4*)(g + ehi + 4); }
        const float qscale = (isb ? 0.17677669529663689f : 0.125f) * LOG2E;
        float kmx = 0.f;
#pragma unroll
        for (int ai = 0; ai < 2; ++ai)
#pragma unroll
            for (int m = 0; m < 4; ++m) {
                const int t = t0 + 128 * ai + 64 * wr + 16 * m + fr, sp = t & (SEQ - 1), grow = sp >> 6, gcol = sp & 63;
                f32x4 lo[2] = {acc[ai][0][m][0], acc[ai][0][m][1]}, hi[2] = {acc[ai][1][m][0], acc[ai][1][m][1]};
                if (isc) { float ss = 0.f;
#pragma unroll
                    for (int q = 0; q < 2; ++q) ss += lo[q][0] * lo[q][0] + lo[q][1] * lo[q][1] + lo[q][2] * lo[q][2] + lo[q][3] * lo[q][3] + hi[q][0] * hi[q][0] + hi[q][1] * hi[q][1] + hi[q][2] * hi[q][2] + hi[q][3] * hi[q][3];
                    ss = swap16_sum(ss, ss); ss = swap32_sum(ss, ss);
                    const float rstd = rsqrtf(ss * (1.f / 64) + 1e-6f);
#pragma unroll
                    for (int q = 0; q < 2; ++q) { lo[q] = lo[q] * rstd * glo[q]; hi[q] = hi[q] * rstd * ghi[q]; } }
                if ((isb || isc) && lat) {
                    LAS const float* tab = isb ? ropeB + (((fq & 1) == 0 ? grow : gcol) * 8) * 2 : ropeC + ((fq < 2 ? grow : gcol) * 16 + 8 * (fq & 1)) * 2;
#pragma unroll
                    for (int q = 0; q < 2; ++q) { const f32x4 c0 = *(LAS const f32x4*)(tab + 8 * q), c1 = *(LAS const f32x4*)(tab + 8 * q + 4);
                        const f32x4 x1 = lo[q], x2 = hi[q];
                        lo[q] = (f32x4){x1[0] * c0[0] - x2[0] * c0[1], x1[1] * c0[2] - x2[1] * c0[3], x1[2] * c1[0] - x2[2] * c1[1], x1[3] * c1[2] - x2[3] * c1[3]};
                        hi[q] = (f32x4){x2[0] * c0[0] + x1[0] * c0[1], x2[1] * c0[2] + x1[1] * c0[3], x2[2] * c1[0] + x1[2] * c1[1], x2[3] * c1[2] + x1[3] * c1[3]}; } }
                if (isq) {
#pragma unroll
                    for (int q = 0; q < 2; ++q) { lo[q] = lo[q] * qscale; hi[q] = hi[q] * qscale; } }
                u32x4 wl, wh;
                wl[0] = cvtpk(lo[0][0], lo[0][1]); wl[1] = cvtpk(lo[0][2], lo[0][3]); wl[2] = cvtpk(lo[1][0], lo[1][1]); wl[3] = cvtpk(lo[1][2], lo[1][3]);
                wh[0] = cvtpk(hi[0][0], hi[0][1]); wh[1] = cvtpk(hi[0][2], hi[0][3]); wh[2] = cvtpk(hi[1][0], hi[1][1]); wh[3] = cvtpk(hi[1][2], hi[1][3]);
                bf16_t* dst;
                if (isq) dst = qpost + (size_t)t * 1024 + hidx * 64;
                else { const int key = lat ? CTXL + sp : ((t - NLAT) & (CTXL - 1)); dst = kpost + ((size_t)(b * NKH + hidx) * KEYS + key) * 64; }
                *(u32x4*)(dst + elo) = wl; *(u32x4*)(dst + ehi) = wh;
                { float n2 = 0.f;
#pragma unroll
                    for (int q = 0; q < 4; ++q) { const float a0 = __uint_as_float(wl[q] << 16), a1 = __uint_as_float(wl[q] & 0xffff0000u), b0 = __uint_as_float(wh[q] << 16), b1 = __uint_as_float(wh[q] & 0xffff0000u); n2 += a0 * a0 + a1 * a1 + b0 * b0 + b1 * b1; }
                    n2 = swap16_sum(n2, n2);
                    if (!isb) n2 = swap32_sum(n2, n2);
                    kmx = fmaxf(kmx, n2); }
            }
        {
#pragma unroll
            for (int of = 32; of; of >>= 1) kmx = fmaxf(kmx, __shfl_xor(kmx, of));
            if (fr == 0 && fq == 0) __hip_atomic_fetch_max(isq ? lmax + 48 + b * 16 + hidx : lmax + b * NKH + hidx, __float_as_uint(kmx), __ATOMIC_RELAXED, __HIP_MEMORY_SCOPE_WORKGROUP); }
    }
};
DI void phase_gemm_in_mfma(const Frame& F, int l) {
    const char* act = (const char*)F.wsp<bf16_t>(WS_ACT);
    const char* W = (const char*)(F.wsp<bf16_t>(WS_WINT) + (size_t)l * INW * D);
    InSched S{act, W, F.nwg, F.wg};
    LAS float* rl = (LAS float*)((LAS char*)F.lds + TAB_OFF);
    __syncthreads();
    static_assert(WS_ROPEC == WS_ROPEB + 2048 * 4, "rope tables contiguous");
    for (int i = F.tid; i < (2048 + 4096) / 4; i += NWG_THREADS) *(LAS f32x4*)(rl + 4 * i) = *(const f32x4*)(F.wsp<float>(WS_ROPEB) + 4 * i);
    if (F.tid < 128) rl[6144 + 112 + F.tid] = F.tid < 64 ? gin(F.p, 16)[l * 64 + F.tid] : gin(F.p, 17)[l * 64 + F.tid - 64];
    LAS unsigned* lmax = (LAS unsigned*)(rl + 6144);
    if (F.tid < 112) lmax[F.tid] = 0u;
    __syncthreads();
    InEpi E{F.wsp<bf16_t>(WS_BIG + BIG_PROJ), F.wsp<bf16_t>(WS_BIG + BIG_KPOST), F.wsp<bf16_t>(WS_BIG + BIG_VT), rl, rl + 2048, rl + 6144 + 112, rl + 6144 + 112 + 64, lmax};
    pg8::gemm_phase((LAS unsigned char*)F.lds, D, D, D, S, E);
    __syncthreads();
    if (F.tid < 112) { const unsigned v = lmax[F.tid];
        if (v != 0u) atomicMax(F.tid < 48 ? F.wsp<unsigned>(WS_SYNC) + KMAX_OFF_WORDS + l * 48 + F.tid : F.wsp<unsigned>(WS_SYNC) + QMAX_OFF_WORDS + l * 64 + (F.tid - 48), v); }
}
DI void phase_gemm_out_mfma(const Frame& F, int l) {
    const int M = l == 0 ? NT : NLAT;
    pg8::DenseSched S{(const char*)F.wsp<bf16_t>(WS_ACT), (const char*)(F.wsp<bf16_t>(WS_WOUTT) + (size_t)l * D * D), D, D, M / 256, 4, F.nwg, F.wg};
    pg8::EpiBf16 E{F.wsp<bf16_t>(WS_BIG), D, 0};
    pg8::gemm_phase((LAS unsigned char*)F.lds, D, D, D, S, E);
}
struct EpiMoe1 {
    static constexpr bool PERM = true;
    bf16_t* hid; const float* sp_w; const int* boff;
    static constexpr bool WTAB = true;
    DI const float* w_ptr(const pg8::Unit& u) const { const int b = u.aux; return sp_w + ((size_t)b * SPCAP + (size_t)(u.pm - boff[b]) * 256) * 2; }
    DI void pre_lds(const pg8::Unit& u, int wr, int fr, const LAS float* tab, float (&epre)[8]) const {
        const int b = u.aux, lim = boff[NBUCKET + 1 + NBUCKET + b] - 1 - (u.pm - boff[b]) * 256, j = u.pn >> 2, r = wr * 64 + fr;
#pragma unroll
        for (int ai = 0; ai < 2; ++ai)
#pragma unroll
            for (int m = 0; m < 4; ++m) { const int i_ = r + ai * 128 + m * 16; const float w_ = tab[(i_ < lim ? i_ : lim) * 2 + j]; epre[ai * 4 + m] = i_ <= lim ? w_ : 0.f; } }
    DI void operator()(const f32x4 (&acc)[2][2][4][2], const pg8::Unit& u, int wr, int wc, int fr, int fq, const float (&epre)[8]) const {
        const int row0 = u.pm * 256 + wr * 64 + fr, j = u.pn >> 2, colb = j * 512 + (u.pn & 3) * 128 + 16 * wc + 4 * fq;
#pragma unroll
        for (int ai = 0; ai < 2; ++ai)
#pragma unroll
            for (int m = 0; m < 4; ++m) { const int slot = row0 + ai * 128 + m * 16; const float w = epre[ai * 4 + m];
#pragma unroll
                for (int bj = 0; bj < 2; ++bj) { const f32x4 v0 = acc[ai][bj][m][0], v1 = acc[ai][bj][m][1];
                    const float h0 = v0[0] * __builtin_amdgcn_rcpf(1.f + __builtin_amdgcn_exp2f(-v0[0] * LOG2E)) * v0[1] * w, h1 = v0[2] * __builtin_amdgcn_rcpf(1.f + __builtin_amdgcn_exp2f(-v0[2] * LOG2E)) * v0[3] * w;
                    const float h2 = v1[0] * __builtin_amdgcn_rcpf(1.f + __builtin_amdgcn_exp2f(-v1[0] * LOG2E)) * v1[1] * w, h3 = v1[2] * __builtin_amdgcn_rcpf(1.f + __builtin_amdgcn_exp2f(-v1[2] * LOG2E)) * v1[3] * w;
                    u32x2 o; o[0] = pg8::cvt_pk_bf16(h0, h1); o[1] = pg8::cvt_pk_bf16(h2, h3);
                    *(u32x2*)(hid + (size_t)slot * D + colb + 64 * bj) = o; } }
    }
};
struct Moe1Sched {
    static constexpr bool GATHER = true; static constexpr int NSEG = 1;
    const char* act; const char* W; const int* sp_tok; const int* tile_bucket; const int* boff; int ntiles, G, c;
    DI bool next(int i, pg8::Unit& u) const { const int U = ntiles * 8, x = c & 7, nper = (G - 1 - x) / 8 + 1, lo = (x * U) >> 3, hi = ((x + 1) * U) >> 3, j = lo + i * nper + (c >> 3);
        if (j >= hi) return false; u.pm = j >> 3; u.pn = j & 7; u.aux = tile_bucket[u.pm]; return true; }
    DI const char* a_base(const pg8::Unit&) const { return act; }
    DI const char* b_base(const pg8::Unit& u, int) const { int elo, ehi; bucket_experts(u.aux, elo, ehi); const int e = u.pn < 4 ? elo : ehi; return W + ((size_t)e * 1024 + (u.pn & 3) * 256) * D * 2; }
    DI const int* rows_ptr(const pg8::Unit& u) const { const int b = u.aux; return sp_tok + (size_t)b * SPCAP + (size_t)(u.pm - boff[b]) * 256; }
    DI int rows_lim(const pg8::Unit& u) const { const int b = u.aux; return boff[NBUCKET + 1 + NBUCKET + b] - 1 - (u.pm - boff[b]) * 256; }
    DI void a_rows(const pg8::Unit& u, int& r0, int& r1) const { const int b = u.aux, base = (u.pm - boff[b]) * 256, cm = boff[NBUCKET + 1 + NBUCKET + b] - 1; const int* st = sp_tok + (size_t)b * SPCAP;
        const int i0 = base + r0, i1 = base + r1; r0 = st[i0 < cm ? i0 : cm]; r1 = st[i1 < cm ? i1 : cm]; }
};
struct Moe2Sched {
    static constexpr bool GATHER = false; static constexpr int NSEG = 2;
    const char* hid; const char* W; const int* tile_bucket; int ntiles, G, c;
    DI bool next(int i, pg8::Unit& u) const { const int U = ntiles * 4, x = c & 7, nper = (G - 1 - x) / 8 + 1, lo = (x * U) >> 3, hi = ((x + 1) * U) >> 3, j = lo + i * nper + (c >> 3);
        if (j >= hi) return false; u.pm = j >> 2; u.pn = j & 3; u.aux = tile_bucket[u.pm]; return true; }
    DI const char* a_base(const pg8::Unit& u) const { return hid + (size_t)u.pm * 256 * D * 2; }
    DI const char* b_base(const pg8::Unit& u, int seg) const { int elo, ehi; bucket_experts(u.aux, elo, ehi); return W + ((size_t)(seg == 0 ? elo : ehi) * 1024 + u.pn * 256) * 512 * 2; }
    DI void a_rows(const pg8::Unit&, int&, int&) const {}
    DI const int* rows_ptr(const pg8::Unit&) const { return nullptr; }
    DI int rows_lim(const pg8::Unit&) const { return 0; }
};
DI void phase_gemm1_mfma(const Frame& F, int l) {
    int* tile_bucket = (int*)((char*)F.lds + TAB_OFF); int* boff = tile_bucket + MAXTILES;
    const int ntiles = build_tiles(F, l, tile_bucket, boff);
    Moe1Sched S{(const char*)F.wsp<bf16_t>(WS_ACT), (const char*)(F.wsp<bf16_t>(WS_WGU) + (size_t)l * 16 * 1024 * 1024), F.wsp<int>(WS_SPTOK), tile_bucket, boff, ntiles, F.nwg, F.wg};
    EpiMoe1 E{F.wsp<bf16_t>(WS_BIG), F.wsp<float>(WS_SPW), boff};
    pg8::gemm_phase((LAS unsigned char*)F.lds, D, D, D, S, E);
}
DI void phase_gemm2_mfma(const Frame& F, int l) {
    int* tile_bucket = (int*)((char*)F.lds + TAB_OFF); int* boff = tile_bucket + MAXTILES;
    const int ntiles = build_tiles(F, l, tile_bucket, boff);
    Moe2Sched S{(const char*)F.wsp<bf16_t>(WS_BIG), (const char*)(F.wsp<bf16_t>(WS_WDT) + (size_t)l * 16 * 1024 * 512), tile_bucket, ntiles, F.nwg, F.wg};
    pg8::EpiBf16 E{F.wsp<bf16_t>(WS_BIG + BIG_Y16), D, 0};
    pg8::gemm_phase((LAS unsigned char*)F.lds, D, D, 512, S, E);
}

DI void phase_final(const Frame& F) {
    const KParams Pp = F.p;
    const bf16_t* y16 = F.wsp<bf16_t>(WS_BIG + BIG_Y16); const int4* tokinfo = F.wsp<int4>(WS_TOKINFO);
    int* tile_bucket = (int*)F.lds; int* boff = tile_bucket + MAXTILES;
    build_tiles(F, 1, tile_bucket, boff);
    const int stride = F.nwg * 8;
    u32x2 rxb[2][4], ryb[2][4]; int nsl[2] = {0, 0};
#pragma unroll
    for (int r = 0; r < 2; ++r)
#pragma unroll
        for (int i = 0; i < 4; ++i) { rxb[r][i] = (u32x2){0u, 0u}; ryb[r][i] = (u32x2){0u, 0u}; }
#define FN_SLOTS(T0) if ((T0) < NLAT) { const int2 i0_ = *(const int2*)(tokinfo + (T0)), i1_ = *(const int2*)(tokinfo + (T0) + 1); nsl[0] = boff[i0_.x] * 256 + i0_.y; nsl[1] = boff[i1_.x] * 256 + i1_.y; }
#define FN_ISSUE(T0) if ((T0) < NLAT) { \
        _Pragma("unroll") for (int r = 0; r < 2; ++r) { const bf16_t* s_ = xres_row(F, (T0) + r); const bf16_t* yr_ = y16 + (size_t)nsl[r] * D; \
            _Pragma("unroll") for (int i = 0; i < 4; ++i) { const int k = (i * 64 + F.lane) * 4; rxb[r][i] = *(const u32x2*)(s_ + k); ryb[r][i] = *(const u32x2*)(yr_ + k); } } }
    const int tfirst = 2 * (F.wg * 8 + F.wid);
    FN_SLOTS(tfirst)
    FN_ISSUE(tfirst)
    FN_SLOTS(tfirst + 2 * stride)
    f32x4 gf[4];
#pragma unroll
    for (int i = 0; i < 4; ++i) gf[i] = *(const f32x4*)(gin(Pp, 25) + (i * 64 + F.lane) * 4);
    for (int t0 = tfirst; t0 < NLAT; t0 += 2 * stride) {
        const int tt[2] = {t0, t0 + 1};
        const float* g2 = mod_row(F, 1, t0 >> 13) + 5120;
        f32x4 g2v[4];
#pragma unroll
        for (int i = 0; i < 4; ++i) g2v[i] = *(const f32x4*)(g2 + (i * 64 + F.lane) * 4);
        f32x4 v[2][4]; float ss[2] = {0.f, 0.f};
#pragma unroll
        for (int r = 0; r < 2; ++r)
#pragma unroll
            for (int i = 0; i < 4; ++i) { v[r][i] = bf4_to_f32(rxb[r][i]) + g2v[i] * bf4_to_f32(ryb[r][i]);
                ss[r] += v[r][i][0] * v[r][i][0] + v[r][i][1] * v[r][i][1] + v[r][i][2] * v[r][i][2] + v[r][i][3] * v[r][i][3]; }
        __builtin_amdgcn_sched_barrier(0);
        FN_ISSUE(t0 + 2 * stride)
        FN_SLOTS(t0 + 4 * stride)
        __builtin_amdgcn_sched_barrier(0);
        ss[0] = wave_sum(ss[0]); ss[1] = wave_sum(ss[1]);
#pragma unroll
        for (int r = 0; r < 2; ++r) { float* s = gout(Pp) + (size_t)tt[r] * D;
            const float rstd = rsqrtf(ss[r] * (1.f / D) + 1e-6f);
#pragma unroll
            for (int i = 0; i < 4; ++i) { const int k = (i * 64 + F.lane) * 4; *(f32x4*)(s + k) = v[r][i] * rstd * gf[i]; } }
    }
#undef FN_ISSUE
#undef FN_SLOTS
}

template <int PH> DI void run_phase(unsigned char* lds_raw, int l) {
    KParams kp = (KParams)__builtin_amdgcn_kernarg_segment_ptr();
    asm volatile("" : "+s"(kp));
    GAS unsigned char* ws = (GAS unsigned char*)kp->ws;
    asm volatile("" : "+s"(ws));
    int tid = threadIdx.x; asm volatile("" : "+v"(tid));
    Frame F; F.p = kp; F.ws = ws; F.lds = (float*)(lds_raw + 16); F.tid = tid; F.wid = __builtin_amdgcn_readfirstlane(tid >> 6); F.lane = tid & 63; F.wg = blockIdx.x; F.nwg = gridDim.x;
    if (PH == 0) phase_prologue(F);
    if (PH == 1) phase_norm1(F, l);
    if (PH == 2) phase_gemm_in_mfma(F, l);
    if (PH == 4) phase_attn_mfma(F, l);
    if (PH == 5) phase_gemm_out_mfma(F, l);
    if (PH == 6) phase_norm2(F, l);
    if (PH == 7) phase_scatter(F, l);
    if (PH == 8) phase_gemm1_mfma(F, l);
    if (PH == 9) phase_gemm2_mfma(F, l);
    if (PH == 10) phase_final(F);
}
DI void grid_sync(unsigned char* lds_raw) {
    KParams kp = (KParams)__builtin_amdgcn_kernarg_segment_ptr();
    asm volatile("" : "+s"(kp));
    XcdBarrier b; b.bar = (unsigned*)kp->ws; b.x = xb_xcc_id(); b.st = (volatile LAS unsigned*)lds_raw;
    xcd_barrier(b);
}
__global__ void __launch_bounds__(NWG_THREADS, 2) fwd_kernel(Params p) {
    extern __shared__ __attribute__((aligned(16))) unsigned char lds_raw[];
    if (threadIdx.x == 0) *(uint4*)lds_raw = make_uint4(0u, 0u, 0u, 0u);
    __syncthreads();
    (void)xcd_barrier_post((unsigned*)p.ws, (volatile LAS unsigned*)lds_raw);
#define RUN(PH, l) run_phase<PH>(lds_raw, l); grid_sync(lds_raw); if (DUP_PH == PH && DUP_L == l) { run_phase<PH>(lds_raw, l); grid_sync(lds_raw); }
    RUN(0, 0)
    RUN(1, 0) RUN(2, 0) RUN(4, 0) RUN(5, 0) RUN(6, 0) RUN(8, 0) RUN(9, 0)
    RUN(1, 1) RUN(2, 1) RUN(4, 1) RUN(5, 1) RUN(6, 1) RUN(8, 1) RUN(9, 1)
    run_phase<10>(lds_raw, 0);
#undef RUN
}

extern "C" void kernel_launch(void* const* d_in, const int* in_sizes, int n_in, void* d_out, int out_size, void* d_ws, size_t ws_size, hipStream_t stream) {
    static int grid = 0;
    if (grid == 0) {
        if (n_in != 26 || out_size != NLAT * D || ws_size < WS_END2) { fprintf(stderr, "kernel_launch: unexpected shapes n_in %d out %d ws %zu (need %zu)\n", n_in, out_size, ws_size, (size_t)WS_END2); grid = -1; return; }
        int dev = 0, cus = 0, per_cu = 0;
        if (hipGetDevice(&dev) != hipSuccess || hipDeviceGetAttribute(&cus, hipDeviceAttributeMultiprocessorCount, dev) != hipSuccess) { grid = -1; return; }
        if (hipFuncSetAttribute((const void*)fwd_kernel, hipFuncAttributeMaxDynamicSharedMemorySize, LDS_BYTES) != hipSuccess) { fprintf(stderr, "kernel_launch: hipFuncSetAttribute failed\n"); grid = -1; return; }
        if (hipOccupancyMaxActiveBlocksPerMultiprocessor(&per_cu, (const void*)fwd_kernel, NWG_THREADS, LDS_BYTES) != hipSuccess || per_cu < 1) fprintf(stderr, "kernel_launch: occupancy query reports %d\n", per_cu);
        (void)hipGetLastError();
        if (cus < 64) { fprintf(stderr, "kernel_launch: %d CUs, need at least 64\n", cus); grid = -1; return; }
        grid = cus;
    }
    if (grid < 0) return;
    (void)hipMemsetAsync((char*)d_ws + WS_SYNC, 0, SYNC_BYTES, stream);
    Params p{};
    for (int i = 0; i < 26; ++i) p.in[i] = (const float*)d_in[i];
    p.out = (float*)d_out; p.ws = (unsigned char*)d_ws; p.ph_lo = 0; p.ph_hi = 0;
    hipLaunchKernelGGL(fwd_kernel, dim3(grid), dim3(NWG_THREADS), LDS_BYTES, stream, p);
}
```

```cpp
#include <hip/hip_runtime.h>
#include <stdint.h>
#include <stdio.h>

#define DI __device__ __forceinline__
#ifndef MFMA_GEMM
#define MFMA_GEMM 15
#endif
#ifndef DUP_PH
#define DUP_PH -1
#endif
#ifndef DUP_L
#define DUP_L 0
#endif
#ifndef MFMA_ATTN
#define MFMA_ATTN 1
#endif
#ifndef ATTN_PIPE
#define ATTN_PIPE 2
#endif
typedef unsigned short bf16_t;
typedef float f32x4 __attribute__((ext_vector_type(4)));
typedef unsigned u32x4 __attribute__((ext_vector_type(4)));
typedef unsigned u32x2 __attribute__((ext_vector_type(2)));

constexpr int D = 1024, NB = 4, SEQ = 8192, NLAT = NB * SEQ, CTXL = 256, NCTX = NB * CTXL, NT = NLAT + NCTX;
constexpr int KEYS = CTXL + SEQ;
constexpr int INW = 2560, QKW = 1792, VW = 768;
constexpr int NKH = 12;
constexpr int NBUCKET = 24, MAXTILES = 156, MAXSLOTS = MAXTILES * 256;
constexpr int NWG_THREADS = 512;
constexpr int LDS_BYTES = 163840;

constexpr size_t al256(size_t x) { return (x + 255) & ~(size_t)255; }
constexpr size_t WS_SYNC = 0;
constexpr size_t SYNC_BYTES = 65536;
constexpr size_t KMAX_OFF_WORDS = 4096 + 64;
constexpr size_t QMAX_OFF_WORDS = 4096 + 192;
constexpr size_t CNT_OFF_WORDS = 4096;
constexpr size_t WS_MOD = WS_SYNC + SYNC_BYTES;
constexpr size_t WS_ROPEB = WS_MOD + al256((size_t)2 * 5 * 6144 * 4);
constexpr size_t WS_ROPEC = WS_ROPEB + 128 * 8 * 2 * 4;
constexpr size_t WS_LAM = WS_ROPEC + 128 * 16 * 2 * 4;
constexpr size_t WS_TOKINFO = WS_LAM + 256;
constexpr size_t WS_TOKSLOT = WS_TOKINFO + (size_t)NT * 16;
constexpr size_t WS_SLOTTOK = WS_TOKSLOT + (size_t)NT * 4;
constexpr size_t WS_SLOTW = WS_SLOTTOK + (size_t)MAXSLOTS * 4;
constexpr size_t WS_XC = WS_SLOTW + (size_t)MAXSLOTS * 8;
constexpr size_t WS_WINT = WS_XC + (size_t)NCTX * D * 4;
constexpr size_t WS_WOUTT = WS_WINT + (size_t)2 * INW * D * 2;
constexpr size_t WS_WGU = WS_WOUTT + (size_t)2 * D * D * 2;
constexpr size_t WS_WDT = WS_WGU + (size_t)2 * 16 * 1024 * 1024 * 2;
constexpr size_t WS_ACT = WS_WDT + (size_t)2 * 16 * 1024 * 512 * 2;
constexpr size_t WS_BIG = WS_ACT + (size_t)MAXSLOTS * D * 2;
constexpr size_t BIG_PROJ = 0;
constexpr size_t BIG_KPOST = BIG_PROJ + (size_t)NT * QKW * 2;
constexpr size_t BIG_VT = BIG_KPOST + (size_t)NB * NKH * KEYS * 64 * 2;
constexpr size_t BIG_Y16 = (size_t)MAXSLOTS * D * 2;
constexpr size_t BIG_END = BIG_VT + (size_t)NB * NKH * KEYS * 64 * 2;
constexpr size_t WS_END = WS_BIG + BIG_END;
static_assert((size_t)MAXSLOTS * 2048 * 2 <= BIG_END && (size_t)NT * D * 4 <= BIG_END, "alias");
constexpr size_t WS_XB = WS_END;
constexpr int SPCAP = NT;
constexpr size_t WS_SPTOK = WS_XB + (size_t)NT * D * 2;
constexpr size_t WS_SPW = WS_SPTOK + (size_t)NBUCKET * SPCAP * 4;
constexpr size_t WS_RWT = WS_SPW + (size_t)NBUCKET * SPCAP * 8;
constexpr size_t WS_END2 = WS_RWT + (size_t)2 * 20 * 1024 * 4;
static_assert(WS_END2 <= (size_t)512 * 1024 * 1024, "workspace");

struct Params {
    const float* in[26];
    float* out;
    unsigned char* ws;
    int ph_lo, ph_hi;
};

DI float bf2f(bf16_t v) { return __uint_as_float((unsigned)v << 16); }
DI bf16_t f2bf(float f) { unsigned u = __float_as_uint(f); u += 0x7fffu + ((u >> 16) & 1u); return (bf16_t)(u >> 16); }
DI unsigned pack2(float a, float b) { return (unsigned)f2bf(a) | ((unsigned)f2bf(b) << 16); }
DI float dpp_row_sum(float s) {
    s += __int_as_float(__builtin_amdgcn_update_dpp(0, __float_as_int(s), 0xB1, 0xF, 0xF, false));
    s += __int_as_float(__builtin_amdgcn_update_dpp(0, __float_as_int(s), 0x4E, 0xF, 0xF, false));
    s += __int_as_float(__builtin_amdgcn_update_dpp(0, __float_as_int(s), 0x141, 0xF, 0xF, false));
    s += __int_as_float(__builtin_amdgcn_update_dpp(0, __float_as_int(s), 0x140, 0xF, 0xF, false));
    return s;
}
DI float swap32_sum(float a, float b) { const auto r = __builtin_amdgcn_permlane32_swap(__float_as_uint(a), __float_as_uint(b), false, false); return __uint_as_float(r[0]) + __uint_as_float(r[1]); }
DI float swap16_sum(float a, float b) { const auto r = __builtin_amdgcn_permlane16_swap(__float_as_uint(a), __float_as_uint(b), false, false); return __uint_as_float(r[0]) + __uint_as_float(r[1]); }
DI float wave_sum(float v) { const float a = swap32_sum(v, v); return dpp_row_sum(swap16_sum(a, a)); }
DI int clampi(int v, int lo, int hi) { return v < lo ? lo : (v > hi ? hi : v); }

#define XB_TMO      128
#define XB_XCNT(j)  (256  + 64 * (j))
#define XB_XSUB(j)  (1280 + 64 * (j))
#define XB_XGEN(j)  (2304 + 64 * (j))
#define XB_TOP      3328
#define XB_TOPGEN   3392
#define XCD_BAR_WORDS 3456
#define XB_SPIN_CAP (1u << 18)
typedef float f32x2 __attribute__((ext_vector_type(2)));
#define LAS __attribute__((address_space(3)))
#define GAS __attribute__((address_space(1)))
DI unsigned xb_ld(unsigned* p)              { return __hip_atomic_load(p, __ATOMIC_RELAXED, __HIP_MEMORY_SCOPE_AGENT); }
DI unsigned xb_add(unsigned* p, unsigned v) { return __hip_atomic_fetch_add(p, v, __ATOMIC_RELAXED, __HIP_MEMORY_SCOPE_AGENT); }
DI unsigned xb_xcc_id() { return (unsigned)__builtin_amdgcn_s_getreg((3 << 11) | 20) & 0xFu; }
#define XB_SPIN(cond, bar) do { unsigned _sp = 0; while (cond) { __builtin_amdgcn_s_sleep(1); \
    if ((++_sp & 255u) == 0u) { if (xb_ld(&(bar)[XB_TMO])) break; if (_sp > XB_SPIN_CAP) { atomicAdd(&(bar)[XB_TMO], 1u); break; } } } } while (0)
struct XcdBarrier { unsigned* bar; unsigned x; volatile LAS unsigned* st; };
DI XcdBarrier xcd_barrier_post(unsigned* bar, volatile LAS unsigned* st) {
    XcdBarrier b; b.bar = bar; b.x = xb_xcc_id(); b.st = st;
    if (threadIdx.x == 0) (void)xb_add(&bar[XB_XCNT(b.x)], 1u);
    return b;
}
DI void xcd_barrier_complete(unsigned* bar, unsigned x, unsigned& nloc, unsigned& nx) {
    const unsigned G = gridDim.x * gridDim.y * gridDim.z;
    unsigned sum, cnt, mine, sp = 0u;
    for (;;) {
        sum = 0u; cnt = 0u; mine = 0u;
#pragma unroll
        for (unsigned j = 0; j < 16; ++j) { const unsigned c = xb_ld(&bar[XB_XCNT(j)]); sum += c; cnt += (c > 0u) ? 1u : 0u; mine = (j == x) ? c : mine; }
        if (sum == G) break;
        __builtin_amdgcn_s_sleep(1);
        if ((++sp & 255u) == 0u) { if (xb_ld(&bar[XB_TMO])) break; if (sp > XB_SPIN_CAP) { atomicAdd(&bar[XB_TMO], 1u); break; } }
    }
    nloc = mine > 0u ? mine : 1u; nx = cnt > 0u ? cnt : 1u;
}
DI void xcd_barrier(const XcdBarrier& b) {
    asm volatile("s_waitcnt vmcnt(0)" ::: "memory");
    __syncthreads();
    if (threadIdx.x == 0) {
        unsigned* bar = b.bar;
        __builtin_amdgcn_s_waitcnt(0);
        unsigned nloc = b.st[0], nx = b.st[1];
        if (nloc == 0u) { xcd_barrier_complete(bar, b.x, nloc, nx); b.st[0] = nloc; b.st[1] = nx; }
        const unsigned old = xb_add(&bar[XB_XSUB(b.x)], 1u);
        const unsigned gen = old / nloc;
        if (old + 1u == (gen + 1u) * nloc) {
            __builtin_amdgcn_fence(__ATOMIC_RELEASE, "agent");
            asm volatile("s_waitcnt vmcnt(0)" ::: "memory");
            const unsigned og = xb_add(&bar[XB_TOP], 1u);
            const unsigned tg = og / nx;
            if (og + 1u == (tg + 1u) * nx) xb_add(&bar[XB_TOPGEN], 1u);
            else XB_SPIN(xb_ld(&bar[XB_TOPGEN]) == tg, bar);
            __builtin_amdgcn_fence(__ATOMIC_ACQUIRE, "agent");
            xb_add(&bar[XB_XGEN(b.x)], 1u);
            asm volatile("s_waitcnt vmcnt(0)" ::: "memory");
        } else {
            XB_SPIN(xb_ld(&bar[XB_XGEN(b.x)]) == gen, bar);
            __builtin_amdgcn_fence(__ATOMIC_ACQUIRE, "agent");
            asm volatile("s_waitcnt vmcnt(0)" ::: "memory");
        }
    }
    __syncthreads();
}

typedef const Params __attribute__((address_space(4)))* KParams;
DI const float* gin(KParams p, int i) { GAS const float* g = (GAS const float*)p->in[i]; asm volatile("" : "+s"(g)); return (const float*)g; }
DI float* gout(KParams p) { GAS float* g = (GAS float*)p->out; asm volatile("" : "+s"(g)); return (float*)g; }
struct Frame {
    KParams p; GAS unsigned char* ws; float* lds; int tid, wid, lane, wg, nwg;
    template <class T> DI T* wsp(size_t off) const { return (T*)(GAS T*)(ws + off); }
};
DI const float* mod_row(const Frame& F, int l, int mrow) { return F.wsp<float>(WS_MOD) + ((size_t)l * 5 + mrow) * 6144; }
DI int tok_modrow(int t) { return t < NLAT ? (t >> 13) : 4; }
DI int tok_batch(int t) { return t < NLAT ? (t >> 13) : ((t - NLAT) >> 8); }
DI int tok_key(int t) { return t < NLAT ? CTXL + (t & (SEQ - 1)) : ((t - NLAT) & (CTXL - 1)); }
DI bf16_t* xres_row(const Frame& F, int t) { return F.wsp<bf16_t>(WS_XB) + (size_t)t * D; }
DI const float* xin_row(const Frame& F, int t) { return t < NLAT ? gin(F.p, 0) + (size_t)t * D : gin(F.p, 2) + (size_t)(t - NLAT) * D; }
DI double lam_init_of(int l) { return l == 0 ? 0.8 - 0.6 : 0.8 - 0.6 * 0.74081822068171786607; }
DI void sincos_d(double a, double& s, double& c) {
    const double n = __builtin_rint(a * 0.63661977236758134308);
    const double r = (a - n * 1.57079632673412561417e+00) - n * 6.07710050650619224932e-11;
    const double r2 = r * r;
    double ts = 1.0, tc = 1.0;
#pragma unroll
    for (int k = 12; k >= 1; --k) { ts = 1.0 - ts * r2 * (1.0 / (double)((2 * k) * (2 * k + 1))); tc = 1.0 - tc * r2 * (1.0 / (double)((2 * k - 1) * (2 * k))); }
    const double sr = r * ts, cr = tc;
    const int q = ((int)n) & 3;
    s = q == 0 ? sr : (q == 1 ? cr : (q == 2 ? -sr : -cr));
    c = q == 0 ? cr : (q == 1 ? -sr : (q == 2 ? -cr : sr));
}
DI double exp_d(double x) { double t = 1.0;
#pragma unroll
    for (int k = 40; k >= 1; --k) t = 1.0 + t * x * (1.0 / (double)k);
    return t; }

DI int win_rowmap(int c) {
    int hs, e; bool isb = false;
    if (c < 384) { hs = c >> 6; e = c & 63; }
    else if (c < 768) { hs = 6 + ((c - 384) >> 6); e = c & 63; }
    else if (c < 1152) return QKW + (c - 768);
    else if (c < 1408) { hs = 12 + ((c - 1152) >> 6); e = (c - 1152) & 63; isb = true; }
    else if (c < 1664) { hs = 16 + ((c - 1408) >> 6); e = (c - 1408) & 63; isb = true; }
    else if (c < 1920) return QKW + 384 + (c - 1664);
    else if (c < 2304) { hs = 20 + ((c - 1920) >> 6); e = (c - 1920) & 63; }
    else if (c < 2432) { hs = 26 + ((c - 2304) >> 6); e = (c - 2304) & 63; }
    else return QKW + 640 + (c - 2432);
    int bj, fq; const int j = e & 7;
    if (!isb) { bj = e >> 5; fq = (e >> 3) & 3; } else { const int mp = e >> 5, i = e & 31; bj = i >> 4; fq = 2 * mp + ((i >> 3) & 1); }
    return 256 * (hs >> 2) + 128 * bj + 32 * (hs & 3) + 8 * fq + j;
}
DI void cvt_tile(const Frame& F, const float* src, int C, int k0, int n0, bf16_t* dst, int ldd, int mode) {
    float* t = F.lds;
    __syncthreads();
    { const int kk = F.tid >> 3, nn = (F.tid & 7) * 8;
      const float* s = src + (size_t)(k0 + kk) * C + n0 + nn;
      const f32x4 a = *(const f32x4*)s, b = *(const f32x4*)(s + 4);
      float* d = t + kk * 65 + nn;
      d[0] = a[0]; d[1] = a[1]; d[2] = a[2]; d[3] = a[3]; d[4] = b[0]; d[5] = b[1]; d[6] = b[2]; d[7] = b[3]; }
    __syncthreads();
    { const int nn = F.tid >> 3, kk0 = (F.tid & 7) * 8;
      u32x4 o;
#pragma unroll
      for (int j = 0; j < 4; ++j) o[j] = pack2(t[(kk0 + 2 * j) * 65 + nn], t[(kk0 + 2 * j + 1) * 65 + nn]);
      const int c = n0 + nn; const int orow = mode == 0 ? c : (mode == 1 ? win_rowmap(c) : (mode == 2 ? 2 * c : 2 * c + 1));
      *(u32x4*)(dst + (size_t)orow * ldd + k0 + kk0) = o; }
}
struct CvtJob { const float* src; bf16_t* dst; int C, k0, n0, ldd, mode; };
DI CvtJob cvt_job(const Frame& F, int ug) {
    const KParams Pp = F.p;
    const int T0 = 1280, T1 = T0 + 512, T2 = T1 + 4096, T3 = T2 + 4096;
    const int u = ug * 4;
    CvtJob J;
    if (u < T0) { const int l = u / 640, r = u % 640, kt = r / 40, nt = r % 40;
        J.src = gin(Pp, 8) + (size_t)l * D * INW; J.C = INW; J.k0 = kt * 64; J.n0 = nt * 64; J.dst = F.wsp<bf16_t>(WS_WINT) + (size_t)l * INW * D; J.ldd = D; J.mode = 1;
    } else if (u < T1) { const int v = u - T0, l = v / 256, r = v % 256, kt = r / 16, nt = r % 16;
        J.src = gin(Pp, 9) + (size_t)l * D * D; J.C = D; J.k0 = kt * 64; J.n0 = nt * 64; J.dst = F.wsp<bf16_t>(WS_WOUTT) + (size_t)l * D * D; J.ldd = D; J.mode = 0;
    } else if (u < T3) { const bool up = u >= T2; const int v = u - (up ? T2 : T1), le = v / 128, r = v % 128, kt = r / 8, nt = r % 8;
        J.src = (up ? gin(Pp, 23) : gin(Pp, 22)) + (size_t)le * D * 512; J.C = 512; J.k0 = kt * 64; J.n0 = nt * 64; J.dst = F.wsp<bf16_t>(WS_WGU) + (size_t)le * 1024 * 1024; J.ldd = D; J.mode = up ? 3 : 2;
    } else { const int v = u - T3, le = v / 128, r = v % 128, kt = r / 16, nt = r % 16;
        J.src = gin(Pp, 24) + (size_t)le * 512 * D; J.C = D; J.k0 = kt * 64; J.n0 = nt * 64; J.dst = F.wsp<bf16_t>(WS_WDT) + (size_t)le * 1024 * 512; J.ldd = 512; J.mode = 0;
    }
    return J;
}
DI void phase_prologue(const Frame& F) {
    const KParams Pp = F.p;
    {
        constexpr int NG = (1280 + 512 + 3 * 4096) / 4;
        float* t = F.lds;
        const int kk = F.tid >> 3, nn = (F.tid & 7) * 8;
        const int tn = F.tid >> 3, kk0 = (F.tid & 7) * 8;
        int ug = F.wg;
        CvtJob J = cvt_job(F, ug < NG ? ug : 0);
        f32x4 a[4], b[4];
#define CVT_ISSUE() { const float* sp = J.src + (size_t)(J.k0 + kk) * J.C + J.n0 + nn; \
        _Pragma("unroll") for (int q = 0; q < 4; ++q) { a[q] = *(const f32x4*)(sp + 64 * q); b[q] = *(const f32x4*)(sp + 64 * q + 4); } }
        if (ug < NG) CVT_ISSUE()
        while (ug < NG) {
            __syncthreads();
#pragma unroll
            for (int q = 0; q < 4; ++q) { float* d = t + q * (64 * 65) + kk * 65 + nn;
                d[0] = a[q][0]; d[1] = a[q][1]; d[2] = a[q][2]; d[3] = a[q][3]; d[4] = b[q][0]; d[5] = b[q][1]; d[6] = b[q][2]; d[7] = b[q][3]; }
            __syncthreads();
            const CvtJob Jc = J; const int un = ug + F.nwg;
            if (un < NG) { J = cvt_job(F, un); CVT_ISSUE() }
#pragma unroll
            for (int q = 0; q < 4; ++q) { const float* tq = t + q * (64 * 65);
                u32x4 o;
#pragma unroll
                for (int j = 0; j < 4; ++j) o[j] = pack2(tq[(kk0 + 2 * j) * 65 + tn], tq[(kk0 + 2 * j + 1) * 65 + tn]);
                const int c = Jc.n0 + 64 * q + tn; const int orow = Jc.mode == 0 ? c : (Jc.mode == 1 ? win_rowmap(c) : (Jc.mode == 2 ? 2 * c : 2 * c + 1));
                *(u32x4*)(Jc.dst + (size_t)orow * Jc.ldd + Jc.k0 + kk0) = o; }
            ug = un;
        }
#undef CVT_ISSUE
    }
    __syncthreads();
    {
        float* sc = F.lds;
        float* red = F.lds + 5 * 1024;
        { float cv[10];
#pragma unroll
          for (int it = 0; it < 10; ++it) { const int k = (F.tid + NWG_THREADS * it) & 1023; cv[it] = (it >> 1) < 4 ? gin(Pp, 1)[(it >> 1) * 1024 + k] : gin(Pp, 3)[k]; }
#pragma unroll
          for (int it = 0; it < 10; ++it) sc[F.tid + NWG_THREADS * it] = cv[it] / (1.f + expf(-cv[it])); }
        __syncthreads();
        for (int u = F.wg; u < 192; u += F.nwg) {
            const int l = u / 96, j0 = (u % 96) * 64, kg = F.tid >> 4, jq = (F.tid & 15) * 4;
            const float* w = gin(Pp, 4) + (size_t)l * D * 6144 + j0 + jq + (size_t)(kg * 32) * 6144;
            f32x4 acc[5];
#pragma unroll
            for (int r = 0; r < 5; ++r) acc[r] = (f32x4){0.f, 0.f, 0.f, 0.f};
#pragma unroll
            for (int kb = 0; kb < 32; kb += 16) {
                f32x4 wv[16];
#pragma unroll
                for (int e = 0; e < 16; ++e) wv[e] = *(const f32x4*)(w + (size_t)(kb + e) * 6144);
#pragma unroll
                for (int e = 0; e < 16; ++e) { const int k = kg * 32 + kb + e;
#pragma unroll
                    for (int r = 0; r < 5; ++r) acc[r] += wv[e] * sc[r * 1024 + k]; } }
#pragma unroll
            for (int r = 0; r < 5; ++r) *(f32x4*)(red + (kg * 5 + r) * 64 + jq) = acc[r];
            __syncthreads();
            if (F.tid < 320) { const int r = F.tid >> 6, jj = F.tid & 63; float s = 0; for (int g = 0; g < 32; ++g) s += red[(g * 5 + r) * 64 + jj]; F.wsp<float>(WS_MOD)[((size_t)l * 5 + r) * 6144 + j0 + jj] = s + gin(Pp, 5)[l * 6144 + j0 + jj]; }
            __syncthreads();
        }
    }
    for (int i = F.wg * NWG_THREADS + F.tid; i < 2 * 20480; i += F.nwg * NWG_THREADS) { const int l = i / 20480, r = i % 20480, j = r >> 10, k = r & 1023;
        F.wsp<float>(WS_RWT)[i] = j < 4 ? gin(Pp, 18)[(size_t)l * 4096 + k * 4 + j] : gin(Pp, 20)[(size_t)l * 16384 + k * 16 + (j - 4)]; }
    const bool rev = F.nwg >= 32; const int rwg = rev ? F.nwg - 1 - F.wg : F.wg, qoff = rev ? 8 : 0, lamwg = rev ? 24 : 0;
    for (int i = rwg * NWG_THREADS + F.tid; i < 128 * 8 + 128 * 16; i += F.nwg * NWG_THREADS) {
        const bool isb = i < 1024; const int v = isb ? i : i - 1024, pos = isb ? v >> 3 : v >> 4, j = isb ? v & 7 : v & 15;
        const double base = isb ? 0.31622776601683793320 : 0.56234132519034908039;
        double f = 1.0; for (int k = 0; k < j; ++k) f *= base;
        double sn, cs; sincos_d((double)pos * f, sn, cs);
        float* dst = isb ? F.wsp<float>(WS_ROPEB) : F.wsp<float>(WS_ROPEC);
        dst[v * 2] = (float)cs; dst[v * 2 + 1] = (float)sn;
    }
    for (int q = rwg - qoff; q >= 0 && q < 12; q += F.nwg) {
        float bm = F.tid < 465 ? fabsf(gin(Pp, 10)[(size_t)q * 465 + F.tid]) : 0.f;
#pragma unroll
        for (int of = 32; of; of >>= 1) bm = fmaxf(bm, __shfl_xor(bm, of));
        __syncthreads();
        if (F.lane == 0) F.lds[F.wid] = bm;
        __syncthreads();
        if (F.tid == 0) { float m = F.lds[0]; for (int i = 1; i < 8; ++i) m = fmaxf(m, F.lds[i]); F.wsp<float>(WS_LAM)[16 + q] = m * 1.4426950408889634f; }
        __syncthreads(); }
    if (F.wg == F.nwg - 1 && F.wid == 1) {
#pragma unroll
        for (int l = 0; l < 2; ++l) { float g = fabsf(gin(Pp, 16)[l * 64 + F.lane]);
#pragma unroll
            for (int of = 32; of; of >>= 1) g = fmaxf(g, __shfl_xor(g, of));
            if (F.lane == 0) F.wsp<float>(WS_LAM)[32 + l] = g; } }
    if (rwg == lamwg && F.wid == 0) {
#pragma unroll
        for (int l = 0; l < 2; ++l) { double s1 = 0.0, s2 = 0.0;
            if (F.lane < 32) { s1 = (double)gin(Pp, 11)[l * 32 + F.lane] * (double)gin(Pp, 12)[l * 32 + F.lane]; s2 = (double)gin(Pp, 13)[l * 32 + F.lane] * (double)gin(Pp, 14)[l * 32 + F.lane]; }
#pragma unroll
            for (int of = 16; of; of >>= 1) { s1 += __shfl_xor(s1, of); s2 += __shfl_xor(s2, of); }
            if (F.lane == 0) { const double li = lam_init_of(l); F.wsp<float>(WS_LAM)[l * 2] = (float)(exp_d(s1) - exp_d(s2) + li); F.wsp<float>(WS_LAM)[l * 2 + 1] = (float)li; } } }
}

DI f32x4 bf4_to_f32(u32x2 v) { return (f32x4){__uint_as_float(v[0] << 16), __uint_as_float(v[0] & 0xffff0000u), __uint_as_float(v[1] << 16), __uint_as_float(v[1] & 0xffff0000u)}; }
DI unsigned cvtpk_rne(float lo, float hi) { unsigned r; asm volatile("s_nop 0\n\tv_cvt_pk_bf16_f32 %0, %1, %2" : "=v"(r) : "v"(lo), "v"(hi)); return r; }
DI int build_tiles(const Frame& F, int l, int* tile_bucket, int* boff);
DI void phase_norm1(const Frame& F, int l) {
    const KParams Pp = F.p;
    const float* gain = gin(Pp, 6) + l * D;
    bf16_t* act = F.wsp<bf16_t>(WS_ACT);
    const bf16_t* y16 = F.wsp<bf16_t>(WS_BIG + BIG_Y16); const int4* tokinfo = F.wsp<int4>(WS_TOKINFO);
    int* tile_bucket = (int*)F.lds; int* boff = tile_bucket + MAXTILES;
    if (l != 0) build_tiles(F, l - 1, tile_bucket, boff);
    const int stride = F.nwg * 8;
    f32x4 rxf[2][4]; u32x2 rxb[2][4], ryb[2][4]; int nsl[2] = {0, 0};
#pragma unroll
    for (int r = 0; r < 2; ++r)
#pragma unroll
        for (int i = 0; i < 4; ++i) { rxf[r][i] = (f32x4){0.f, 0.f, 0.f, 0.f}; rxb[r][i] = (u32x2){0u, 0u}; ryb[r][i] = (u32x2){0u, 0u}; }
#define N1_SLOTS(T0) if (l != 0 && (T0) < NT) { const int2 i0_ = *(const int2*)(tokinfo + (T0)), i1_ = *(const int2*)(tokinfo + (T0) + 1); nsl[0] = boff[i0_.x] * 256 + i0_.y; nsl[1] = boff[i1_.x] * 256 + i1_.y; }
#define N1_ISSUE(T0) if ((T0) < NT) { \
        _Pragma("unroll") for (int r = 0; r < 2; ++r) { \
            if (l == 0) { const float* s_ = xin_row(F, (T0) + r); _Pragma("unroll") for (int i = 0; i < 4; ++i) rxf[r][i] = *(const f32x4*)(s_ + (i * 64 + F.lane) * 4); } \
            else { const bf16_t* s_ = xres_row(F, (T0) + r); const bf16_t* yr_ = y16 + (size_t)nsl[r] * D; \
                _Pragma("unroll") for (int i = 0; i < 4; ++i) { const int k = (i * 64 + F.lane) * 4; rxb[r][i] = *(const u32x2*)(s_ + k); ryb[r][i] = *(const u32x2*)(yr_ + k); } } } }
    const int tfirst = 2 * (F.wg * 8 + F.wid);
    N1_SLOTS(tfirst)
    N1_ISSUE(tfirst)
    N1_SLOTS(tfirst + 2 * stride)
    for (int t0 = tfirst; t0 < NT; t0 += 2 * stride) {
        const int tt[2] = {t0, t0 + 1};
        const float* m = mod_row(F, l, tok_modrow(t0));
        f32x4 v[2][4], g2v[4];
        if (l != 0) { const float* g2 = mod_row(F, l - 1, tok_modrow(t0)) + 5120;
#pragma unroll
            for (int i = 0; i < 4; ++i) g2v[i] = *(const f32x4*)(g2 + (i * 64 + F.lane) * 4); }
        f32x4 gsv[4], shv[4], scv[4];
#pragma unroll
        for (int i = 0; i < 4; ++i) { const int k = (i * 64 + F.lane) * 4; gsv[i] = *(const f32x4*)(gain + k); shv[i] = *(const f32x4*)(m + k); scv[i] = *(const f32x4*)(m + 1024 + k); }
        if (l == 0) {
#pragma unroll
            for (int r = 0; r < 2; ++r)
#pragma unroll
                for (int i = 0; i < 4; ++i) v[r][i] = rxf[r][i];
        } else {
#pragma unroll
            for (int r = 0; r < 2; ++r) { bf16_t* s = xres_row(F, tt[r]);
#pragma unroll
                for (int i = 0; i < 4; ++i) { const int k = (i * 64 + F.lane) * 4; v[r][i] = bf4_to_f32(rxb[r][i]) + g2v[i] * bf4_to_f32(ryb[r][i]);
                    u32x2 xo; xo[0] = cvtpk_rne(v[r][i][0], v[r][i][1]); xo[1] = cvtpk_rne(v[r][i][2], v[r][i][3]); *(u32x2*)(s + k) = xo; } }
        }
        __builtin_amdgcn_sched_barrier(0);
        N1_ISSUE(t0 + 2 * stride)
        N1_SLOTS(t0 + 4 * stride)
        __builtin_amdgcn_sched_barrier(0);
        float ss[2] = {0.f, 0.f};
#pragma unroll
        for (int r = 0; r < 2; ++r)
#pragma unroll
            for (int i = 0; i < 4; ++i) ss[r] += v[r][i][0] * v[r][i][0] + v[r][i][1] * v[r][i][1] + v[r][i][2] * v[r][i][2] + v[r][i][3] * v[r][i][3];
#pragma unroll
        for (int i = 0; i < 4; ++i) gsv[i] = gsv[i] * (scv[i] + 1.f);
        ss[0] = wave_sum(ss[0]); ss[1] = wave_sum(ss[1]);
#pragma unroll
        for (int r = 0; r < 2; ++r) { const int t = tt[r];
            const float rstd = rsqrtf(ss[r] * (1.f / D) + 1e-6f);
#pragma unroll
            for (int i = 0; i < 4; ++i) { const int k = (i * 64 + F.lane) * 4;
                const f32x4 h = v[r][i] * rstd * gsv[i] + shv[i];
                u32x2 o; o[0] = cvtpk_rne(h[0], h[1]); o[1] = cvtpk_rne(h[2], h[3]);
                *(u32x2*)(act + (size_t)t * D + k) = o; } }
    }
#undef N1_ISSUE
#undef N1_SLOTS
}

namespace pg8 {
typedef short bf16x8 __attribute__((ext_vector_type(8)));
constexpr int BM = 256, BK = 64, HALF = 128, HTB = HALF * BK * 2, STAGE_BYTES = 8 * HTB;
DI int lds_byte(int r, int c) { const int st = (r >> 4) * 2 + (c >> 5), rr = r & 15, cc = c & 31, ob = rr * 64 + cc * 2; return st * 1024 + (ob ^ (((ob >> 9) & 1) << 5)); }
DI void stage_rc(int b, int& R, int& C) { const int st = b / 1024, sb = b % 1024, swz = sb ^ (((sb >> 9) & 1) << 5); R = (st >> 1) * 16 + swz / 64; C = (st & 1) * 32 + (swz % 64) / 2; }
DI int perm32(int rho) { const int n = rho >> 4, i = rho & 15; return 8 * (i >> 2) + 4 * n + (i & 3); }
struct Unit { int pm, pn, aux; };
DI unsigned cvt_pk_bf16(float lo, float hi) { unsigned r; asm volatile("v_cvt_pk_bf16_f32 %0, %1, %2" : "=v"(r) : "v"(lo), "v"(hi)); return r; }

template <class Epi, class Sched>
DI void gemm_phase(LAS unsigned char* lds, const int K, const int lda, const int ldb, const Sched& S, const Epi& E) {
    int tid = threadIdx.x; asm volatile("" : "+v"(tid));
    const int wid = __builtin_amdgcn_readfirstlane(tid >> 6), lane = tid & 63, wr = wid >> 2, wc = wid & 3, fr = lane & 15, fq = lane >> 4;
    const int nt = K / BK, tps = nt / Sched::NSEG;
    int RA[2], CA[2]; unsigned voffB[2];
#pragma unroll
    for (int i = 0; i < 2; ++i) { int R, C; stage_rc(tid * 16 + i * 8192, R, C); const int Rb = Epi::PERM ? ((R & ~31) + perm32(R & 31)) : R; RA[i] = R; CA[i] = C; voffB[i] = (unsigned)(Rb * ldb + C) * 2u; }
    const size_t kstep = (size_t)(BK * 2);
    const size_t hstepB = (size_t)HALF * ldb * 2;
    const unsigned ldsw = (unsigned)wid * 1024u;
    const int aoff = lds_byte(wr * 64 + fr, fq * 8), boff = lds_byte(wc * 32 + fr, fq * 8);
#define PG8_SA(b, h) (((b) * 2 + (h)) * HTB)
#define PG8_SB(b, h) ((4 + (b) * 2 + (h)) * HTB)
#define PG8_STAGE(bufoff, gbase, voff) do { _Pragma("unroll") for (int _i = 0; _i < 2; ++_i) \
        __builtin_amdgcn_global_load_lds((const unsigned*)((const char*)(gbase) + (voff)[_i]), (LAS unsigned*)(lds + (bufoff) + ldsw + _i * 8192), 16, 0, 0); } while (0)
#define PG8_LDA(dst, b, h) do { _Pragma("unroll") for (int m = 0; m < 4; ++m) _Pragma("unroll") for (int k = 0; k < 2; ++k) dst[m][k] = *(const LAS bf16x8*)(lds + PG8_SA(b, h) + aoff + m * 2048 + k * 1024); } while (0)
#define PG8_LDB(dst, b, h) do { _Pragma("unroll") for (int n = 0; n < 2; ++n) _Pragma("unroll") for (int k = 0; k < 2; ++k) dst[n][k] = *(const LAS bf16x8*)(lds + PG8_SB(b, h) + boff + n * 2048 + k * 1024); } while (0)
#define PG8_MMA(ai, bj, At, Bt) do { __builtin_amdgcn_s_setprio(1); _Pragma("unroll") for (int m = 0; m < 4; ++m) _Pragma("unroll") for (int n = 0; n < 2; ++n) _Pragma("unroll") for (int k = 0; k < 2; ++k) \
        acc[ai][bj][m][n] = __builtin_amdgcn_mfma_f32_16x16x32_bf16(Bt[n][k], At[m][k], acc[ai][bj][m][n], 0, 0, 0); __builtin_amdgcn_s_setprio(0); } while (0)
#define PG8_WAIT_V(n) asm volatile("s_waitcnt vmcnt(" #n ")" ::: "memory")
#define PG8_WAIT_L(n) asm volatile("s_waitcnt lgkmcnt(" #n ")" ::: "memory")
#define PG8_BAR __builtin_amdgcn_s_barrier()
#define PG8_SCHED __builtin_amdgcn_sched_barrier(0)
    Unit cur, nxt; int ui = 0;
    if (!S.next(0, cur)) return;
    f32x4 acc[2][2][4][2];
#pragma unroll
    for (int a = 0; a < 2; ++a)
#pragma unroll
        for (int b = 0; b < 2; ++b)
#pragma unroll
            for (int m = 0; m < 4; ++m)
#pragma unroll
                for (int n = 0; n < 2; ++n) acc[a][b][m][n] = (f32x4){0.f, 0.f, 0.f, 0.f};
    bf16x8 At[4][2], B0[2][2], B1[2][2];
    float epre[8] = {0.f, 0.f, 0.f, 0.f, 0.f, 0.f, 0.f, 0.f};
    unsigned vA[2][2], nvA[2][2];
#pragma unroll
    for (int h = 0; h < 2; ++h) { int r0 = h * HALF + RA[0], r1 = h * HALF + RA[1]; if (Sched::GATHER) S.a_rows(cur, r0, r1);
        vA[h][0] = (unsigned)(r0 * lda + CA[0]) * 2u; vA[h][1] = (unsigned)(r1 * lda + CA[1]) * 2u; nvA[h][0] = vA[h][0]; nvA[h][1] = vA[h][1]; }
    constexpr int GTAB_OFF = STAGE_BYTES + 1024, WTAB_OFF = STAGE_BYTES + 3072;
#define PG8_TABDMA(gsrc, ldsoff, n) do { _Pragma("unroll") for (int q_ = 0; q_ < (n); ++q_) \
        __builtin_amdgcn_global_load_lds((const unsigned*)((const char*)(gsrc) + q_ * 1024 + lane * 16), (LAS unsigned*)(lds + (ldsoff) + q_ * 1024), 16, 0, 0); } while (0)
    if (Epi::WTAB && wid == 1) PG8_TABDMA(E.w_ptr(cur), WTAB_OFF, 2);
    const char* cA = S.a_base(cur); const char* cB0 = S.b_base(cur, 0); const char* cB1 = Sched::NSEG > 1 ? S.b_base(cur, 1) : cB0;
#define PG8_BPTR(b0, b1, t) ((Sched::NSEG > 1 && (t) >= tps) ? (b1) + (size_t)((t) - tps) * kstep : (b0) + (size_t)(t) * kstep)
    PG8_STAGE(PG8_SB(0, 0), cB0, voffB); PG8_STAGE(PG8_SA(0, 0), cA, vA[0]); PG8_STAGE(PG8_SB(0, 1), cB0 + hstepB, voffB); PG8_STAGE(PG8_SA(0, 1), cA, vA[1]);
    if (wr == 1) PG8_BAR;
    PG8_WAIT_V(4); PG8_BAR;
    PG8_STAGE(PG8_SB(1, 0), cB0 + kstep, voffB); PG8_STAGE(PG8_SA(1, 0), cA + kstep, vA[0]); PG8_STAGE(PG8_SB(1, 1), cB0 + hstepB + kstep, voffB);
    PG8_WAIT_V(6); PG8_BAR;
    for (;;) {
        const bool has_next = S.next(ui + 1, nxt);
        const char* nA = has_next ? S.a_base(nxt) : cA; const char* nB0 = has_next ? S.b_base(nxt, 0) : cB0; const char* nB1 = has_next ? (Sched::NSEG > 1 ? S.b_base(nxt, 1) : nB0) : cB1;
        if (Sched::GATHER && has_next && wid == 0) PG8_TABDMA(S.rows_ptr(nxt), GTAB_OFF + ((ui + 1) & 1) * 1024, 1);
        if (Epi::WTAB && ui > 0 && wid == 1) PG8_TABDMA(E.w_ptr(cur), WTAB_OFF + (ui & 1) * 2048, 2);
        for (int t = 0; t < nt; t += 2) {
            const bool last = (t == nt - 2);
            const char* a1 = cA + (size_t)(t + 1) * kstep;
            const char* a2 = last ? nA : cA + (size_t)(t + 2) * kstep; const char* b2 = last ? nB0 : PG8_BPTR(cB0, cB1, t + 2);
            const char* a3 = a2 + kstep; const char* b3 = b2 + kstep;
            if (last) {
                if (Sched::GATHER && has_next) { const LAS int* gt = (const LAS int*)(lds + GTAB_OFF + ((ui + 1) & 1) * 1024); const int lim = S.rows_lim(nxt);
#pragma unroll
                    for (int h = 0; h < 2; ++h) { const int q0 = h * HALF + RA[0], q1 = h * HALF + RA[1]; const int r0 = gt[q0 < lim ? q0 : lim], r1 = gt[q1 < lim ? q1 : lim];
                        nvA[h][0] = (unsigned)(r0 * lda + CA[0]) * 2u; nvA[h][1] = (unsigned)(r1 * lda + CA[1]) * 2u; } }
                if (Epi::WTAB) E.pre_lds(cur, wr, fr, (const LAS float*)(lds + WTAB_OFF + (ui & 1) * 2048), epre);
            }
            unsigned w0[2], w1[2];
            w0[0] = last ? nvA[0][0] : vA[0][0]; w0[1] = last ? nvA[0][1] : vA[0][1]; w1[0] = last ? nvA[1][0] : vA[1][0]; w1[1] = last ? nvA[1][1] : vA[1][1];
            PG8_LDB(B0, 0, 0); PG8_SCHED; PG8_LDA(At, 0, 0); PG8_STAGE(PG8_SA(1, 1), a1, vA[1]);
            PG8_WAIT_L(8); PG8_BAR; PG8_WAIT_L(0); PG8_MMA(0, 0, At, B0); PG8_BAR; PG8_SCHED;
            PG8_LDB(B1, 0, 1); PG8_STAGE(PG8_SB(0, 0), b2, voffB);
            PG8_BAR; PG8_WAIT_L(0); PG8_MMA(0, 1, At, B1); PG8_BAR;
            PG8_LDA(At, 0, 1); PG8_STAGE(PG8_SA(0, 0), a2, w0);
            PG8_BAR; PG8_WAIT_L(0); PG8_MMA(1, 0, At, B0); PG8_BAR; PG8_SCHED;
            PG8_STAGE(PG8_SB(0, 1), b2 + hstepB, voffB);
            PG8_WAIT_V(6); PG8_BAR; PG8_MMA(1, 1, At, B1); PG8_BAR;
            PG8_LDB(B0, 1, 0); PG8_SCHED; PG8_LDA(At, 1, 0); PG8_STAGE(PG8_SA(0, 1), a2, w1);
            PG8_WAIT_L(8); PG8_BAR; PG8_WAIT_L(0); PG8_MMA(0, 0, At, B0); PG8_BAR; PG8_SCHED;
            PG8_LDB(B1, 1, 1); PG8_STAGE(PG8_SB(1, 0), b3, voffB);
            PG8_BAR; PG8_WAIT_L(0); PG8_MMA(0, 1, At, B1); PG8_BAR;
            PG8_LDA(At, 1, 1); PG8_STAGE(PG8_SA(1, 0), a3, w0);
            PG8_BAR; PG8_WAIT_L(0); PG8_MMA(1, 0, At, B0); PG8_BAR; PG8_SCHED;
            PG8_STAGE(PG8_SB(1, 1), b3 + hstepB, voffB);
            PG8_WAIT_V(6); PG8_BAR; PG8_MMA(1, 1, At, B1); PG8_BAR;
        }
        asm volatile("s_nop 7\n\ts_nop 7\n\ts_nop 3" ::: "memory");
        E(acc, cur, wr, wc, fr, fq, epre);
        if (!has_next) break;
#pragma unroll
        for (int a = 0; a < 2; ++a)
#pragma unroll
            for (int b = 0; b < 2; ++b)
#pragma unroll
                for (int m = 0; m < 4; ++m)
#pragma unroll
                    for (int n = 0; n < 2; ++n) acc[a][b][m][n] = (f32x4){0.f, 0.f, 0.f, 0.f};
        cur = nxt; cA = nA; cB0 = nB0; cB1 = nB1; ++ui;
#pragma unroll
        for (int h = 0; h < 2; ++h) { vA[h][0] = nvA[h][0]; vA[h][1] = nvA[h][1]; }
    }
    PG8_WAIT_V(0);
    if (wr == 0) PG8_BAR;
    PG8_BAR;
#undef PG8_SA
#undef PG8_SB
#undef PG8_STAGE
#undef PG8_LDA
#undef PG8_LDB
#undef PG8_MMA
#undef PG8_WAIT_V
#undef PG8_WAIT_L
#undef PG8_BAR
#undef PG8_SCHED
#undef PG8_BPTR
#undef PG8_TABDMA
}
struct EpiBf16 {
    static constexpr bool PERM = true;
    bf16_t* O; int ldc; int mode;
    static constexpr bool WTAB = false;
    DI const float* w_ptr(const Unit&) const { return nullptr; }
    DI void pre_lds(const Unit&, int, int, const LAS float*, float (&)[8]) const {}
    DI void operator()(const f32x4 (&acc)[2][2][4][2], const Unit& u, int wr, int wc, int fr, int fq, const float (&)[8]) const {
        const int row0 = u.pm * BM + wr * 64 + fr, colt = u.pn * BM;
        bf16_t* base;
        if (mode == 0) base = O + colt;
        else { const int t0 = colt, b = tok_batch(t0), key0 = tok_key(t0); base = O + (size_t)b * 768 * KEYS + key0; }
        const int col0 = wc * 32 + 8 * fq;
#pragma unroll
        for (int ai = 0; ai < 2; ++ai)
#pragma unroll
            for (int m = 0; m < 4; ++m) { bf16_t* rowp = base + (size_t)(row0 + ai * HALF + m * 16) * ldc + col0;
#pragma unroll
                for (int bj = 0; bj < 2; ++bj) { const f32x4 v0 = acc[ai][bj][m][0], v1 = acc[ai][bj][m][1];
                    u32x4 w; w.x = cvt_pk_bf16(v0[0], v0[1]); w.y = cvt_pk_bf16(v0[2], v0[3]); w.z = cvt_pk_bf16(v1[0], v1[1]); w.w = cvt_pk_bf16(v1[2], v1[3]);
                    *(u32x4*)(rowp + bj * HALF) = w; } }
    }
};
struct DenseSched {
    static constexpr bool GATHER = false; static constexpr int NSEG = 1;
    const char* A; const char* B; int lda, ldb, nM, nN, G, c;
    DI bool next(int i, Unit& u) const { const int L = i * G + c; if (L >= nM * nN) return false;
        const int grp = L / (8 * nN), rem = L % (8 * nN), fm = grp * 8, gsz = (nM - fm) < 8 ? (nM - fm) : 8; u.pm = fm + rem % gsz; u.pn = rem / gsz; u.aux = 0; return true; }
    DI const char* a_base(const Unit& u) const { return A + (size_t)u.pm * BM * lda * 2; }
    DI const char* b_base(const Unit& u, int) const { return B + (size_t)u.pn * BM * ldb * 2; }
    DI void a_rows(const Unit&, int&, int&) const {}
    DI const int* rows_ptr(const Unit&) const { return nullptr; }
    DI int rows_lim(const Unit&) const { return 0; }
};
}

DI int build_tiles(const Frame& F, int l, int* tile_bucket  , int* boff  ) {
    const unsigned* cnt = F.wsp<unsigned>(WS_SYNC) + CNT_OFF_WORDS + l * 32;
    int* ntl = boff + NBUCKET + 1;
    __syncthreads();
    if (F.tid < NBUCKET) { const int c_ = (int)cnt[F.tid]; ntl[F.tid] = (c_ + 255) >> 8; ntl[NBUCKET + F.tid] = c_; }
    __syncthreads();
    if (F.tid <= NBUCKET) { int o = 0;
#pragma unroll
        for (int k = 0; k < NBUCKET; ++k) { const int v_ = ntl[k]; o += k < F.tid ? v_ : 0; }
        boff[F.tid] = o; }
    __syncthreads();
    if (F.tid < MAXTILES) { int b = 0;
#pragma unroll
        for (int k = 1; k < NBUCKET; ++k) b += F.tid >= boff[k] ? 1 : 0;
        tile_bucket[F.tid] = b; }
    __syncthreads();
    return boff[NBUCKET];
}
DI void bucket_experts(int bucket, int& elo, int& ehi) { const int g = bucket / 6, pr = bucket % 6; const int lo = pr < 3 ? 0 : (pr < 5 ? 1 : 2), hi = pr < 3 ? pr + 1 : (pr < 5 ? pr - 1 : 3); elo = g * 4 + lo; ehi = g * 4 + hi; }

typedef short bf16x8 __attribute__((ext_vector_type(8)));
typedef float f32x16 __attribute__((ext_vector_type(16)));
#define MFMA32(a, b, c) __builtin_amdgcn_mfma_f32_32x32x16_bf16((a), (b), (c), 0, 0, 0)
constexpr float LOG2E = 1.4426950408889634f;
DI int swap23(int x) { return (x & 0x13) | ((x & 4) << 1) | ((x & 8) >> 1); }
DI unsigned cvtpk(float lo, float hi) { unsigned r; asm volatile("s_nop 0\n\tv_cvt_pk_bf16_f32 %0, %1, %2" : "=v"(r) : "v"(lo), "v"(hi)); return r; }
DI void softmax_tile(f32x16 (&st)[2], float& m, float& ls, f32x16& oa, f32x16& ob, bf16x8 (&pf)[2][2]) {
    float mx = st[0][0];
#pragma unroll
    for (int i = 1; i < 16; ++i) mx = fmaxf(mx, st[0][i]);
#pragma unroll
    for (int i = 0; i < 16; ++i) mx = fmaxf(mx, st[1][i]);
    mx = fmaxf(mx, __shfl_xor(mx, 32));
    const bool need = mx > m + 8.f;
    if (__any(need)) { const float mn = need ? mx : m; const float al = __builtin_amdgcn_exp2f(m - mn); m = mn; ls *= al; oa *= al; ob *= al; }
    float ps = 0.f;
#pragma unroll
    for (int s = 0; s < 2; ++s)
#pragma unroll
        for (int i = 0; i < 16; ++i) { const float p = __builtin_amdgcn_exp2f(st[s][i] - m); ps += p; st[s][i] = p; }
    ls += ps;
#pragma unroll
    for (int s = 0; s < 2; ++s)
#pragma unroll
        for (int k = 0; k < 2; ++k) { u32x4 w; w[0] = cvtpk(st[s][8 * k], st[s][8 * k + 1]); w[1] = cvtpk(st[s][8 * k + 2], st[s][8 * k + 3]); w[2] = cvtpk(st[s][8 * k + 4], st[s][8 * k + 5]); w[3] = cvtpk(st[s][8 * k + 6], st[s][8 * k + 7]);
            pf[s][k] = __builtin_bit_cast(bf16x8, w); }
}
template <int MODE, bool CTXQ> DI void attn_mfma_unit(const Frame& F, int l, int b, int head, int qblk) {
    const KParams Pp = F.p;
    LAS unsigned char* lds = (LAS unsigned char*)F.lds;
    LAS float* rpb = (LAS float*)(lds + 32768);
    const int lane = F.lane, r = lane & 31, h = lane >> 5, w = F.wid;
    const bf16_t* proj = F.wsp<bf16_t>(WS_BIG + BIG_PROJ);
    const int kh = MODE == 0 ? head : (MODE == 1 ? 6 + head : 10 + head / 3);
    const bf16_t* KP = F.wsp<bf16_t>(WS_BIG + BIG_KPOST) + (size_t)(b * NKH + kh) * KEYS * 64;
    const bf16_t* VT = F.wsp<bf16_t>(WS_BIG + BIG_VT) + (size_t)(b * NKH + kh) * 64 * KEYS;
    const int sq = CTXQ ? 0 : qblk * 256 + w * 32 + r;
    const int t = CTXQ ? NLAT + b * CTXL + w * 32 + r : b * SEQ + sq;
    const int qrow = sq >> 6, qcol = sq & 63;
    __syncthreads();
    if (MODE == 0 && !CTXQ) for (int i = F.tid; i < 15 * 31; i += NWG_THREADS) rpb[i] = gin(Pp, 10)[((size_t)l * 6 + head) * 465 + i] * LOG2E;
    bf16x8 qf[4];
    { const bf16_t* src = proj + (size_t)t * 1024 + ((MODE == 0 ? 0 : (MODE == 1 ? 6 : 10)) + head) * 64 + 8 * h;
#pragma unroll
      for (int ks = 0; ks < 4; ++ks) qf[ks] = *(const bf16x8*)(src + 16 * ks); }
    int ntile, rlo = 0;
    if (CTXQ) ntile = 4;
    else if (MODE == 0) { const int R0 = qblk * 4; rlo = clampi(R0 - 4, 0, 120); const int rhi = clampi(R0 + 3 - 4, 0, 120) + 7; ntile = 4 + (rhi - rlo + 1); }
    else ntile = KEYS / 64;
    const int wrow = CTXQ ? 0 : (qblk * 256 + w * 32) >> 6;
    const int r0w = clampi(wrow - 4, 0, 120), c0 = clampi(qcol - 8, 0, 48);
    const int srow = F.tid >> 3, schunk = F.tid & 7;
    const unsigned sdst = (unsigned)(srow * 128 + ((schunk ^ ((srow >> 1) & 7)) << 4));
    const bf16_t* kg = KP + (size_t)srow * 64 + schunk * 8;
    const bf16_t* vg = VT + (size_t)srow * KEYS + schunk * 8;
#define TILE_KEY0(ti) ((MODE == 0 && !CTXQ && (ti) >= 4) ? CTXL + (rlo + (ti) - 4) * 64 : (ti) * 64)
    u32x4 kreg, vreg;
    { const int k0 = TILE_KEY0(0); kreg = *(const u32x4*)(kg + (size_t)k0 * 64); vreg = *(const u32x4*)(vg + k0); }
    *(LAS u32x4*)(lds + sdst) = kreg; *(LAS u32x4*)(lds + 16384 + sdst) = vreg;
    __syncthreads();
    constexpr int NO = MODE == 1 ? 4 : 2;
    f32x16 o[NO];
#pragma unroll
    for (int i = 0; i < NO; ++i)
#pragma unroll
        for (int j = 0; j < 16; ++j) o[i][j] = 0.f;
    float m1 = -1e30f, l1 = 0.f, m2 = -1e30f, l2 = 0.f;
    const unsigned krd = (unsigned)(swap23(r) * 128), vrd = (unsigned)(r * 128);
    const int kswz = (swap23(r) >> 1) & 7, vswz = (r >> 1) & 7;
#pragma unroll 1
    for (int ti = 0; ti < ntile; ++ti) {
        const int buf = ti & 1;
        if (ti + 1 < ntile) { const int k0 = TILE_KEY0(ti + 1); kreg = *(const u32x4*)(kg + (size_t)k0 * 64); vreg = *(const u32x4*)(vg + k0); }
        bool relevant = true; int krow = 0;
        if (MODE == 0 && !CTXQ && ti >= 4) { krow = rlo + ti - 4; relevant = krow >= r0w && krow < r0w + 8; }
        if (relevant) {
            LAS unsigned char* kb = lds + buf * 8192; LAS unsigned char* vb = lds + 16384 + buf * 8192;
#pragma unroll
            for (int pass = 0; pass < (MODE == 1 ? 2 : 1); ++pass) {
                if (pass == 1) __builtin_amdgcn_sched_barrier(0);
                f32x16 st[2];
#pragma unroll
                for (int s = 0; s < 2; ++s)
#pragma unroll
                    for (int j = 0; j < 16; ++j) st[s][j] = 0.f;
#pragma unroll
                for (int kk = 0; kk < (MODE == 1 ? 2 : 4); ++kk) { const int ks = MODE == 1 ? pass * 2 + kk : kk;
#pragma unroll
                    for (int s = 0; s < 2; ++s) { const bf16x8 kf = *(const LAS bf16x8*)(kb + s * 4096 + krd + (((2 * ks + h) ^ kswz) << 4)); st[s] = MFMA32(kf, qf[ks], st[s]); } }
                if (MODE == 0 && !CTXQ && ti >= 4) { const int dr = krow - wrow + 7;
#pragma unroll
                    for (int s = 0; s < 2; ++s)
#pragma unroll
                        for (int i = 0; i < 16; ++i) { const int kc = s * 32 + 16 * (i >> 3) + 8 * h + (i & 7); const int dc = clampi(kc - qcol + 15, 0, 30); const bool valid = kc >= c0 && kc < c0 + 16;
                            st[s][i] = valid ? st[s][i] + rpb[dr * 31 + dc] : -3e38f; } }
                bf16x8 pf[2][2];
                if (pass == 0) softmax_tile(st, m1, l1, o[0], o[1], pf); else softmax_tile(st, m2, l2, o[NO - 2], o[NO - 1], pf);
#pragma unroll
                for (int ds = 0; ds < 2; ++ds)
#pragma unroll
                    for (int s = 0; s < 2; ++s)
#pragma unroll
                        for (int k = 0; k < 2; ++k) { const bf16x8 vf = *(const LAS bf16x8*)(vb + ds * 4096 + vrd + (((4 * s + 2 * k + h) ^ vswz) << 4)); o[pass * 2 + ds] = MFMA32(vf, pf[s][k], o[pass * 2 + ds]); }
            }
        }
        if (ti + 1 < ntile) { *(LAS u32x4*)(lds + (buf ^ 1) * 8192 + sdst) = kreg; *(LAS u32x4*)(lds + 16384 + (buf ^ 1) * 8192 + sdst) = vreg; }
        __syncthreads();
    }
#undef TILE_KEY0
    l1 += __shfl_xor(l1, 32); const float inv1 = 1.f / l1;
    if (MODE == 1) { l2 += __shfl_xor(l2, 32); const float inv2 = 1.f / l2;
        const float lam = F.wsp<float>(WS_LAM)[l * 2], li = F.wsp<float>(WS_LAM)[l * 2 + 1]; const float c2 = lam * inv2; float ss = 0.f;
#pragma unroll
        for (int ds = 0; ds < 2; ++ds)
#pragma unroll
            for (int i = 0; i < 16; ++i) { const float v = o[ds][i] * inv1 - c2 * o[2 + ds][i]; o[ds][i] = v; ss += v * v; }
        ss += __shfl_xor(ss, 32);
        const float rstd = rsqrtf(ss * (1.f / 64) + 1e-6f) * (1.f - li); const float* sub = gin(Pp, 15) + l * 64;
#pragma unroll
        for (int ds = 0; ds < 2; ++ds)
#pragma unroll
            for (int i = 0; i < 16; ++i) o[ds][i] = o[ds][i] * rstd * sub[32 * ds + (i & 3) + 8 * (i >> 2) + 4 * h];
    } else {
#pragma unroll
        for (int ds = 0; ds < 2; ++ds)
#pragma unroll
            for (int i = 0; i < 16; ++i) o[ds][i] *= inv1;
    }
    bf16_t* dst = F.wsp<bf16_t>(WS_ACT) + (size_t)t * D + (MODE == 0 ? 0 : (MODE == 1 ? 384 : 640)) + head * 64 + 4 * h;
#pragma unroll
    for (int ds = 0; ds < 2; ++ds)
#pragma unroll
        for (int g = 0; g < 4; ++g) { u32x2 wv; wv[0] = cvtpk(o[ds][4 * g], o[ds][4 * g + 1]); wv[1] = cvtpk(o[ds][4 * g + 2], o[ds][4 * g + 3]); *(u32x2*)(dst + 32 * ds + 8 * g) = wv; }
}
DI float xhalf_sum(float v) { const auto r = __builtin_amdgcn_permlane32_swap(__float_as_uint(v), __float_as_uint(v), false, false); return __uint_as_float(r[0]) + __uint_as_float(r[1]); }
DI unsigned exp2_acc_pack(float x0, float x1, float& ps0, float& ps1) {
    float p0, p1; unsigned pk;
    asm volatile("v_exp_f32 %0, %5\n\tv_exp_f32 %1, %6\n\tv_add_f32 %2, %0, %2\n\tv_add_f32 %3, %1, %3\n\tv_cvt_pk_bf16_f32 %4, %0, %1"
                 : "=&v"(p0), "=&v"(p1), "+v"(ps0), "+v"(ps1), "=&v"(pk) : "v"(x0), "v"(x1));
    return pk;
}
DI void exp2_pair(float x0, float x1, float& p0, float& p1) { asm volatile("v_exp_f32 %0, %2\n\tv_exp_f32 %1, %3" : "=&v"(p0), "=&v"(p1) : "v"(x0), "v"(x1)); }
DI unsigned acc_pack2(float p0, float p1, float& ps0, float& ps1) {
    unsigned pk; asm volatile("v_add_f32 %0, %3, %0\n\tv_add_f32 %1, %4, %1\n\tv_cvt_pk_bf16_f32 %2, %3, %4" : "+v"(ps0), "+v"(ps1), "=&v"(pk) : "v"(p0), "v"(p1)); return pk; }
template <int NKS> DI void attn_stream_core(LAS unsigned char* lds, const int w, const int lane, const bf16_t* KP, const bf16_t* VT, const bf16x8 (&qf)[NKS], const int kc0, f32x16 (&o)[2], float& ls) {
    const int r = lane & 31, h = lane >> 5;
    const int drow = 8 * w + (lane >> 3), dch = (lane & 7) ^ ((drow >> 1) & 7);
    const bf16_t* kg = KP + (size_t)drow * 64 + dch * 8;
    const bf16_t* vg = VT + (size_t)drow * KEYS + dch * 8;
    LAS unsigned char* kdst = lds + w * 1024; LAS unsigned char* vdst = lds + 32768 + w * 1024;
#define DMA_K(ti, off) __builtin_amdgcn_global_load_lds((const unsigned*)(kg + (size_t)(ti) * 64 * 64), (LAS unsigned*)(kdst + (off)), 16, 0, 0)
#define DMA_V(ti, off) __builtin_amdgcn_global_load_lds((const unsigned*)(vg + (size_t)(ti) * 64), (LAS unsigned*)(vdst + (off)), 16, 0, 0)
    const unsigned krd = (unsigned)(swap23(r) * 128), vrd = (unsigned)(r * 128);
    const int kswz = (swap23(r) >> 1) & 7, vswz = (r >> 1) & 7;
#define KFRAG(kb, s, ks) (*(const LAS bf16x8*)((kb) + (s) * 4096 + krd + (((kc0 + 2 * (ks) + h) ^ kswz) << 4)))
#define VFRAG(vb, ds, s, k) (*(const LAS bf16x8*)((vb) + (ds) * 4096 + vrd + (((4 * (s) + 2 * (k) + h) ^ vswz) << 4)))
#define PIN __builtin_amdgcn_sched_barrier(0)
    constexpr int ntile = KEYS / 64, nstage = ntile / 2;
    const f32x16 zero16 = {0.f, 0.f, 0.f, 0.f, 0.f, 0.f, 0.f, 0.f, 0.f, 0.f, 0.f, 0.f, 0.f, 0.f, 0.f, 0.f};
    o[0] = zero16; o[1] = zero16;
    float ps0 = 0.f, ps1 = 0.f;
    DMA_K(0, 16384 + 8192); DMA_K(1, 0); DMA_K(2, 8192); DMA_V(0, 0); DMA_V(1, 8192);
    asm volatile("s_waitcnt vmcnt(0)" ::: "memory");
    __syncthreads();
    f32x16 sa[2], sb[2];
#pragma unroll
    for (int s = 0; s < 2; ++s) { sa[s] = MFMA32(KFRAG(lds + 16384 + 8192, s, 0), qf[0], zero16);
#pragma unroll
        for (int ks = 1; ks < NKS; ++ks) sa[s] = MFMA32(KFRAG(lds + 16384 + 8192, s, ks), qf[ks], sa[s]); }
    sb[0] = zero16; sb[1] = zero16;
    bf16x8 pfh[2], vfh[2][2];
    { const bf16x8 z8 = {0, 0, 0, 0, 0, 0, 0, 0}; pfh[0] = z8; pfh[1] = z8; vfh[0][0] = z8; vfh[0][1] = z8; vfh[1][0] = z8; vfh[1][1] = z8; }
    __syncthreads();
#define STREAM_TILE(SC, SN, kbn, vb) do { \
        bf16x8 kf0[NKS], kf1[NKS], vf0[2][2]; u32x4 pw0[2], pw1[2]; \
        _Pragma("unroll") for (int ks = 0; ks < NKS; ++ks) kf0[ks] = KFRAG(kbn, 0, ks); \
        _Pragma("unroll") for (int ds = 0; ds < 2; ++ds) _Pragma("unroll") for (int k = 0; k < 2; ++k) vf0[ds][k] = VFRAG(vb, ds, 0, k); \
        PIN; \
          \
        _Pragma("unroll") for (int g = 0; g < 8; ++g) { float e0, e1; \
            exp2_pair(SC[0][2 * g], SC[0][2 * g + 1], e0, e1); PIN; \
            if (g < 4) o[g & 1] = MFMA32(vfh[g & 1][g >> 1], pfh[g >> 1], o[g & 1]); \
            else if (g - 4 < NKS) SN[0] = MFMA32(kf0[g - 4], qf[g - 4], g == 4 ? zero16 : SN[0]); \
            if (g == 4) { _Pragma("unroll") for (int ks = 0; ks < NKS; ++ks) kf1[ks] = KFRAG(kbn, 1, ks); } \
            PIN; pw0[g >> 2][g & 3] = acc_pack2(e0, e1, ps0, ps1); \
            PIN; } \
          \
        _Pragma("unroll") for (int g = 0; g < 8; ++g) { float e0, e1; \
            exp2_pair(SC[1][2 * g], SC[1][2 * g + 1], e0, e1); PIN; \
            if (g < NKS) SN[1] = MFMA32(kf1[g], qf[g], g == 0 ? zero16 : SN[1]); \
            else if (g - NKS < 4) o[(g - NKS) & 1] = MFMA32(vf0[(g - NKS) & 1][(g - NKS) >> 1], __builtin_bit_cast(bf16x8, pw0[(g - NKS) >> 1]), o[(g - NKS) & 1]); \
            if (g == 1) { _Pragma("unroll") for (int ds = 0; ds < 2; ++ds) _Pragma("unroll") for (int k = 0; k < 2; ++k) vfh[ds][k] = VFRAG(vb, ds, 1, k); } \
            PIN; pw1[g >> 2][g & 3] = acc_pack2(e0, e1, ps0, ps1); \
            PIN; } \
        pfh[0] = __builtin_bit_cast(bf16x8, pw1[0]); pfh[1] = __builtin_bit_cast(bf16x8, pw1[1]); \
    } while (0)
    if (w >= 4) __builtin_amdgcn_s_setprio(1);
#pragma unroll 1
    for (int st = 0; st < nstage; ++st) {
        const int cur = (st & 1) * 16384, nxt = 16384 - cur;
        if (st + 1 < nstage) { DMA_K(2 * st + 3, nxt); if (2 * st + 4 < ntile) DMA_K(2 * st + 4, nxt + 8192); DMA_V(2 * st + 2, nxt); DMA_V(2 * st + 3, nxt + 8192); }
        STREAM_TILE(sa, sb, lds + cur, lds + 32768 + cur);
        STREAM_TILE(sb, sa, lds + cur + 8192, lds + 32768 + cur + 8192);
        asm volatile("s_waitcnt vmcnt(0)" ::: "memory");
        __syncthreads();
    }
#undef STREAM_TILE
    __builtin_amdgcn_s_setprio(0);
#pragma unroll
    for (int g = 0; g < 4; ++g) o[g & 1] = MFMA32(vfh[g & 1][g >> 1], pfh[g >> 1], o[g & 1]);
    ls = ps0 + ps1;
#undef DMA_K
#undef DMA_V
#undef KFRAG
#undef VFRAG
#undef PIN
}
DI void store_o64(LAS unsigned char* stg, bf16_t* gbase  , const f32x16 (&o)[2], int lane) {
    const int r = lane & 31, h = lane >> 5;
#pragma unroll
    for (int ds = 0; ds < 2; ++ds)
#pragma unroll
        for (int g = 0; g < 4; ++g) { u32x2 wv; wv[0] = cvtpk(o[ds][4 * g], o[ds][4 * g + 1]); wv[1] = cvtpk(o[ds][4 * g + 2], o[ds][4 * g + 3]);
            *(LAS u32x2*)(stg + r * 128 + (((4 * ds + g) ^ (r & 7)) << 4) + 8 * h) = wv; }
#pragma unroll
    for (int i = 0; i < 4; ++i) { const int idx = lane + 64 * i, row = idx >> 3, ch = idx & 7;
        const u32x4 v = *(const LAS u32x4*)(stg + row * 128 + ((ch ^ (row & 7)) << 4));
        *(u32x4*)(gbase + (size_t)row * D + ch * 8) = v; }
}
constexpr int OSTG_OFF = 65536 + 1024 + 32768;
DI void attn_fast_unit_c(const Frame& F, int l, int b, int head, int qblk) {
    const KParams Pp = F.p;
    LAS unsigned char* lds = (LAS unsigned char*)F.lds;
    const int lane = F.lane, r = lane & 31, h = lane >> 5, w = F.wid, kh = 10 + head / 3;
    const bf16_t* KP = F.wsp<bf16_t>(WS_BIG + BIG_KPOST) + (size_t)(b * NKH + kh) * KEYS * 64;
    const bf16_t* VT = F.wsp<bf16_t>(WS_BIG + BIG_VT) + (size_t)(b * NKH + kh) * 64 * KEYS;
    const int sq = qblk * 256 + w * 32 + r, t = b * SEQ + sq, qrow = sq >> 6, qcol = sq & 63;
    bf16x8 qf[4];
    { const bf16_t* src = F.wsp<bf16_t>(WS_BIG + BIG_PROJ) + (size_t)t * 1024 + (10 + head) * 64 + 8 * h;
#pragma unroll
      for (int ks = 0; ks < 4; ++ks) qf[ks] = *(const bf16x8*)(src + 16 * ks); }
    f32x16 o[2]; float ls;
    asm volatile("s_waitcnt lgkmcnt(0)" ::: "memory"); __builtin_amdgcn_s_barrier(); asm volatile("" ::: "memory");
    attn_stream_core<4>(lds, w, lane, KP, VT, qf, 0, o, ls);
    ls = xhalf_sum(ls); const float inv = 1.f / ls;
#pragma unroll
    for (int ds = 0; ds < 2; ++ds)
#pragma unroll
        for (int i = 0; i < 16; ++i) o[ds][i] *= inv;
    store_o64(lds + OSTG_OFF + w * 4096, F.wsp<bf16_t>(WS_ACT) + (size_t)(b * SEQ + qblk * 256 + w * 32) * D + 640 + head * 64, o, lane);
}
DI bool gqa_fast_ok(const Frame& F, int l, int b, int kvh) {
    const float g = F.wsp<float>(WS_LAM)[32 + l];
    const float qb = 8.f * g * 1.0001f * 0.125f * LOG2E * 1.01f;
    const float k2 = __uint_as_float(F.wsp<unsigned>(WS_SYNC)[KMAX_OFF_WORDS + l * 48 + b * NKH + 10 + kvh]);
    return qb * qb * k2 < 3600.f;
}
DI bool attn_fast_unit_b(const Frame& F, int l, int b, int head, int qblk) {
    const KParams Pp = F.p;
    LAS unsigned char* lds = (LAS unsigned char*)F.lds;
    LAS float* wmax = (LAS float*)(lds + 65536);
    LAS float* exch = (LAS float*)(lds + 65536 + 1024);
    const int lane = F.lane, r = lane & 31, h = lane >> 5, w = F.wid, stream = w >> 2, qw = w & 3, kh = 6 + head;
    const bf16_t* KP = F.wsp<bf16_t>(WS_BIG + BIG_KPOST) + (size_t)(b * NKH + kh) * KEYS * 64;
    const bf16_t* VT = F.wsp<bf16_t>(WS_BIG + BIG_VT) + (size_t)(b * NKH + kh) * 64 * KEYS;
    const float* ropeB = F.wsp<float>(WS_ROPEB);
    const bf16_t* qsrc = F.wsp<bf16_t>(WS_BIG + BIG_PROJ) + (size_t)(b * SEQ + qblk * 256 + qw * 32 + r) * 1024 + (6 + head) * 64 + stream * 32 + 8 * h;
    float qn2 = 0.f;
#pragma unroll
    for (int half = 0; half < 2; ++half) {
        const bf16_t* src = qsrc + (size_t)half * 128 * 1024;
        float na = 0.f;
#pragma unroll
        for (int ks = 0; ks < 2; ++ks) { const u32x4 wv = *(const u32x4*)(src + 16 * ks);
#pragma unroll
            for (int j = 0; j < 4; ++j) { const float x = __uint_as_float(wv[j] << 16), y = __uint_as_float(wv[j] & 0xffff0000u); na += x * x + y * y; } }
        qn2 = fmaxf(qn2, xhalf_sum(na));
    }
#pragma unroll
    for (int of = 16; of; of >>= 1) qn2 = fmaxf(qn2, __shfl_xor(qn2, of));
    __syncthreads();
    if (lane == 0) wmax[w] = qn2;
    __syncthreads();
    bool fast;
    { float q2 = wmax[0];
#pragma unroll
      for (int i = 1; i < 8; ++i) q2 = fmaxf(q2, wmax[i]);
      const float k2 = __uint_as_float(F.wsp<unsigned>(WS_SYNC)[KMAX_OFF_WORDS + l * 48 + b * NKH + kh]);
      fast = q2 * k2 < 3600.f; }
    if (!fast) return false;
    const float lam = F.wsp<float>(WS_LAM)[l * 2], li = F.wsp<float>(WS_LAM)[l * 2 + 1];
#pragma unroll 1
    for (int half = 0; half < 2; ++half) {
        f32x16 o[2]; float ls;
        if (half) { asm volatile("s_waitcnt lgkmcnt(0)" ::: "memory"); __builtin_amdgcn_s_barrier(); asm volatile("" ::: "memory"); }
        bf16x8 qh[2]; qh[0] = *(const bf16x8*)(qsrc + (size_t)half * 128 * 1024); qh[1] = *(const bf16x8*)(qsrc + (size_t)half * 128 * 1024 + 16);
        attn_stream_core<2>(lds, w, lane, KP, VT, qh, stream * 4, o, ls);
        ls = xhalf_sum(ls);
        if (stream == 1) { const float c2 = lam / ls;
#pragma unroll
            for (int ds = 0; ds < 2; ++ds)
#pragma unroll
                for (int i = 0; i < 16; ++i) exch[(qw * 32 + ds * 16 + i) * 64 + lane] = o[ds][i] * c2; }
        f32x4 subv[2][4];
        if (stream == 0) { const float* sub = gin(Pp, 15) + l * 64 + 4 * h;
#pragma unroll
            for (int ds = 0; ds < 2; ++ds)
#pragma unroll
                for (int g = 0; g < 4; ++g) subv[ds][g] = *(const f32x4*)(sub + 32 * ds + 8 * g); }
        __syncthreads();
        if (stream == 0) { const float inv = 1.f / ls; float ss = 0.f;
#pragma unroll
            for (int ds = 0; ds < 2; ++ds)
#pragma unroll
                for (int i = 0; i < 16; ++i) { const float v = o[ds][i] * inv - exch[(qw * 32 + ds * 16 + i) * 64 + lane]; o[ds][i] = v; ss += v * v; }
            ss = xhalf_sum(ss);
            const float rstd = rsqrtf(ss * (1.f / 64) + 1e-6f) * (1.f - li);
#pragma unroll
            for (int ds = 0; ds < 2; ++ds)
#pragma unroll
                for (int i = 0; i < 16; ++i) o[ds][i] = o[ds][i] * rstd * subv[ds][i >> 2][i & 3];
            store_o64(lds + OSTG_OFF + w * 4096, F.wsp<bf16_t>(WS_ACT) + (size_t)(b * SEQ + qblk * 256 + half * 128 + qw * 32) * D + 384 + head * 64, o, lane); }
    }
    return true;
}
DI void attn_na_fast_unit(const Frame& F, int l, int b, int head, int qblk) {
    const KParams Pp = F.p;
    LAS unsigned char* lds = (LAS unsigned char*)F.lds;
    LAS float* rpb = (LAS float*)(lds + 65536);
    const int lane = F.lane, r = lane & 31, h = lane >> 5, w = F.wid;
    const bf16_t* KP = F.wsp<bf16_t>(WS_BIG + BIG_KPOST) + (size_t)(b * NKH + head) * KEYS * 64;
    const bf16_t* VT = F.wsp<bf16_t>(WS_BIG + BIG_VT) + (size_t)(b * NKH + head) * 64 * KEYS;
    const int sq = qblk * 256 + w * 32 + r, qcol = sq & 63;
    __syncthreads();
    for (int i = F.tid; i < 15 * 31; i += NWG_THREADS) rpb[i] = gin(Pp, 10)[((size_t)l * 6 + head) * 465 + i] * LOG2E;
    bf16x8 qf[4];
    { const bf16_t* src = F.wsp<bf16_t>(WS_BIG + BIG_PROJ) + (size_t)(b * SEQ + sq) * 1024 + head * 64 + 8 * h;
#pragma unroll
      for (int ks = 0; ks < 4; ++ks) qf[ks] = *(const bf16x8*)(src + 16 * ks); }
    const int R0 = qblk * 4, rlo = clampi(R0 - 4, 0, 120), rhi = clampi(R0 + 3 - 4, 0, 120) + 7, ntile = 4 + (rhi - rlo + 1);
    const int wrow = (qblk * 256 + w * 32) >> 6, r0w = clampi(wrow - 4, 0, 120), c0 = clampi(qcol - 8, 0, 48);
    const int tbase = 8 * h - c0;
    const int drow = 8 * w + (lane >> 3), dch = (lane & 7) ^ ((drow >> 1) & 7);
    const bf16_t* kg = KP + (size_t)drow * 64 + dch * 8;
    const bf16_t* vg = VT + (size_t)drow * KEYS + dch * 8;
    LAS unsigned char* kdst = lds + w * 1024; LAS unsigned char* vdst = lds + 32768 + w * 1024;
#define NA_KEY0(ti) ((ti) >= 4 ? CTXL + (rlo + (ti) - 4) * 64 : (ti) * 64)
#define NA_DMA(ti) do { const int k0_ = NA_KEY0(ti); __builtin_amdgcn_global_load_lds((const unsigned*)(kg + (size_t)k0_ * 64), (LAS unsigned*)(kdst + ((ti) & 3) * 8192), 16, 0, 0); \
                         __builtin_amdgcn_global_load_lds((const unsigned*)(vg + k0_), (LAS unsigned*)(vdst + ((ti) & 3) * 8192), 16, 0, 0); } while (0)
    const unsigned krd = (unsigned)(swap23(r) * 128), vrd = (unsigned)(r * 128);
    const int kswz = (swap23(r) >> 1) & 7, vswz = (r >> 1) & 7;
    const f32x16 zero16 = {0.f, 0.f, 0.f, 0.f, 0.f, 0.f, 0.f, 0.f, 0.f, 0.f, 0.f, 0.f, 0.f, 0.f, 0.f, 0.f};
    f32x16 o[2] = {zero16, zero16};
    float ps0 = 0.f, ps1 = 0.f;
    NA_DMA(0); NA_DMA(1); NA_DMA(2);
    asm volatile("s_waitcnt vmcnt(4) lgkmcnt(0)" ::: "memory");
    __builtin_amdgcn_s_barrier(); asm volatile("" ::: "memory");
#pragma unroll 1
    for (int ti = 0; ti < ntile; ++ti) {
        if (ti + 3 < ntile) NA_DMA(ti + 3);
        const int krow = rlo + ti - 4;
        const bool relevant = ti < 4 || (krow >= r0w && krow < r0w + 8);
        if (relevant) {
            LAS unsigned char* kb = lds + (ti & 3) * 8192; LAS unsigned char* vb = lds + 32768 + (ti & 3) * 8192;
            f32x16 st[2];
#pragma unroll
            for (int s_ = 0; s_ < 2; ++s_) { st[s_] = MFMA32(*(const LAS bf16x8*)(kb + s_ * 4096 + krd + (((0 + h) ^ kswz) << 4)), qf[0], zero16);
#pragma unroll
                for (int ks = 1; ks < 4; ++ks) st[s_] = MFMA32(*(const LAS bf16x8*)(kb + s_ * 4096 + krd + (((2 * ks + h) ^ kswz) << 4)), qf[ks], st[s_]); }
            if (ti >= 4) { LAS const float* brow = rpb + (krow - wrow + 7) * 31 + (8 * h - qcol + 15);
                float bv[2][16];
#pragma unroll
                for (int s_ = 0; s_ < 2; ++s_)
#pragma unroll
                    for (int i = 0; i < 16; ++i) { bv[s_][i] = brow[s_ * 32 + 16 * (i >> 3) + (i & 7)]; }
#pragma unroll
                for (int s_ = 0; s_ < 2; ++s_)
#pragma unroll
                    for (int i = 0; i < 16; ++i) asm volatile("" : "+v"(bv[s_][i]));
#pragma unroll
                for (int s_ = 0; s_ < 2; ++s_)
#pragma unroll
                    for (int i = 0; i < 16; ++i) { const int kcc = s_ * 32 + 16 * (i >> 3) + (i & 7); const bool valid = (unsigned)(kcc + tbase) < 16u; st[s_][i] = valid ? st[s_][i] + bv[s_][i] : -3e38f; }
            } else asm volatile("s_nop 7\n\ts_nop 7" ::: "memory");
            u32x4 pw[2][2];
#pragma unroll
            for (int s_ = 0; s_ < 2; ++s_)
#pragma unroll
                for (int g = 0; g < 8; ++g) pw[s_][g >> 2][g & 3] = exp2_acc_pack(st[s_][2 * g], st[s_][2 * g + 1], ps0, ps1);
            asm volatile("s_nop 1" ::: "memory");
#pragma unroll
            for (int ds = 0; ds < 2; ++ds)
#pragma unroll
                for (int s_ = 0; s_ < 2; ++s_)
#pragma unroll
                    for (int k = 0; k < 2; ++k) o[ds] = MFMA32(*(const LAS bf16x8*)(vb + ds * 4096 + vrd + (((4 * s_ + 2 * k + h) ^ vswz) << 4)), __builtin_bit_cast(bf16x8, pw[s_][k]), o[ds]);
        }
        if (ti + 3 < ntile) asm volatile("s_waitcnt vmcnt(4) lgkmcnt(0)" ::: "memory"); else asm volatile("s_waitcnt vmcnt(0) lgkmcnt(0)" ::: "memory");
        __builtin_amdgcn_s_barrier(); asm volatile("" ::: "memory");
    }
#undef NA_DMA
#undef NA_KEY0
    const float ls = xhalf_sum(ps0 + ps1), inv = 1.f / ls;
#pragma unroll
    for (int ds = 0; ds < 2; ++ds)
#pragma unroll
        for (int i = 0; i < 16; ++i) o[ds][i] *= inv;
    store_o64(lds + OSTG_OFF + w * 4096, F.wsp<bf16_t>(WS_ACT) + (size_t)(b * SEQ + qblk * 256 + w * 32) * D + head * 64, o, lane);
}
DI bool na_fast_ok(const Frame& F, int l, int b, int head) {
    const float q2 = __uint_as_float(F.wsp<unsigned>(WS_SYNC)[QMAX_OFF_WORDS + l * 64 + b * 16 + head]), k2 = __uint_as_float(F.wsp<unsigned>(WS_SYNC)[KMAX_OFF_WORDS + l * 48 + b * NKH + head]);
    const float bm = F.wsp<float>(WS_LAM)[16 + l * 6 + head];
    return sqrtf(q2 * k2) * 1.01f + bm < 60.f;
}
DI Frame relaunder(const Frame& F0) {
    Frame F = F0; int tid = F0.tid; asm volatile("" : "+v"(tid)); asm volatile("" : "+s"(F.ws), "+s"(F.p));
    F.tid = tid; F.wid = __builtin_amdgcn_readfirstlane(tid >> 6); F.lane = tid & 63; return F;
}
DI void phase_attn_mfma(const Frame& F0, int l) {
    unsigned slow_b = 0u, slow_c = 0u;
    { const Frame F = relaunder(F0); int it = 0;
      for (int u = F.wg; u < 512; u += F.nwg, ++it) { const int xs = u & 7, idx = u >> 3, pr = xs * 2 + (idx >> 5); if (!attn_fast_unit_b(F, l, pr >> 2, pr & 3, idx & 31)) slow_b |= 1u << it; } }
    if (slow_b) { const Frame F = relaunder(F0); int it = 0;
      for (int u = F.wg; u < 512; u += F.nwg, ++it) { const int xs = u & 7, idx = u >> 3, pr = xs * 2 + (idx >> 5); if (slow_b >> it & 1u) attn_mfma_unit<1, false>(F, l, pr >> 2, pr & 3, idx & 31); } }
    { const Frame F = relaunder(F0); int it = 0;
      const bool okc = gqa_fast_ok(F, l, (F.wg & 7) >> 1, F.wg & 1);
      for (int u = F.wg; u < 768; u += F.nwg, ++it) { const int xs = u & 7, idx = u >> 3; if ((F.nwg & 7) == 0 ? okc : gqa_fast_ok(F, l, xs >> 1, xs & 1)) attn_fast_unit_c(F, l, xs >> 1, (xs & 1) * 3 + (idx >> 5), idx & 31); else slow_c |= 1u << it; } }
    if (slow_c) { const Frame F = relaunder(F0); int it = 0;
      for (int u = F.wg; u < 768; u += F.nwg, ++it) { const int xs = u & 7, idx = u >> 3; if (slow_c >> it & 1u) attn_mfma_unit<2, false>(F, l, xs >> 1, (xs & 1) * 3 + (idx >> 5), idx & 31); } }
    unsigned slow_a = 0u;
    { const Frame F = relaunder(F0); int it = 0;
      unsigned oka = 0u;
      { int j = 0; for (int u = F.wg; u < 768 && j < 8; u += F.nwg, ++j) { const int pr = (u & 7) * 3 + ((u >> 3) >> 5); oka |= (na_fast_ok(F, l, pr / 6, pr % 6) ? 1u : 0u) << j; } }
      for (int u = F.wg; u < 768; u += F.nwg, ++it) { const int xs = u & 7, idx = u >> 3, pr = xs * 3 + (idx >> 5); if (it < 8 ? (oka >> it & 1u) != 0u : na_fast_ok(F, l, pr / 6, pr % 6)) attn_na_fast_unit(F, l, pr / 6, pr % 6, idx & 31); else slow_a |= 1u << it; } }
    if (slow_a) { const Frame F = relaunder(F0); int it = 0;
      for (int u = F.wg; u < 768; u += F.nwg, ++it) { const int xs = u & 7, idx = u >> 3, pr = xs * 3 + (idx >> 5); if (slow_a >> it & 1u) attn_mfma_unit<0, false>(F, l, pr / 6, pr % 6, idx & 31); } }
    if (l == 0) {
        { const Frame F = relaunder(F0); for (int u = F.wg; u < 24; u += F.nwg) attn_mfma_unit<0, true>(F, l, u / 6, u % 6, 0); }
        { const Frame F = relaunder(F0); for (int u = F.wg - 24; u >= 0 && u < 16; u += F.nwg) attn_mfma_unit<1, true>(F, l, u / 4, u % 4, 0); }
        { const Frame F = relaunder(F0); for (int u = F.wg - 40; u >= 0 && u < 24; u += F.nwg) attn_mfma_unit<2, true>(F, l, u / 6, u % 6, 0); }
    }
}

DI void phase_norm2(const Frame& F, int l) {
    const KParams Pp = F.p;
    const int M = l == 0 ? NT : NLAT;
    float* rw = F.lds;
    __syncthreads();
    for (int i = F.tid; i < 1024 * 20 / 4; i += NWG_THREADS) *(f32x4*)(rw + 4 * i) = *(const f32x4*)(F.wsp<float>(WS_RWT) + (size_t)l * 20480 + 4 * i);
    __syncthreads();
    int* sp_tok = F.wsp<int>(WS_SPTOK); float* sp_w = F.wsp<float>(WS_SPW);
    const float* gain = gin(Pp, 7) + l * D;
    bf16_t* act = F.wsp<bf16_t>(WS_ACT);
    const bf16_t* tmp16 = F.wsp<bf16_t>(WS_BIG);
    unsigned* cnt = F.wsp<unsigned>(WS_SYNC) + CNT_OFF_WORDS + l * 32;
    int4* tokinfo = F.wsp<int4>(WS_TOKINFO);
    const int stride = F.nwg * 8;
    float* lgs = rw + 20 * 1024 + F.wid * 1280;
    int nrow = 0;
    for (int t0 = 2 * (F.wg * 8 + F.wid); t0 < M; t0 += 2 * stride) {
      const int tt[2] = {t0, t0 + 1};
      const float* m = mod_row(F, l, tok_modrow(t0));
      f32x4 g1v[4], rxf[2][4]; u32x2 rxb[2][4], rtr[2][4];
#pragma unroll
      for (int i = 0; i < 4; ++i) g1v[i] = *(const f32x4*)(m + 2048 + (i * 64 + F.lane) * 4);
#pragma unroll
      for (int r = 0; r < 2; ++r) { const int t = tt[r]; const float* xs = xin_row(F, t); const bf16_t* xq = xres_row(F, t); const bf16_t* tr = tmp16 + (size_t)t * D;
#pragma unroll
          for (int i = 0; i < 4; ++i) { const int k = (i * 64 + F.lane) * 4;
              if (l == 0) rxf[r][i] = *(const f32x4*)(xs + k); else rxb[r][i] = *(const u32x2*)(xq + k);
              rtr[r][i] = *(const u32x2*)(tr + k); } }
      f32x4 gsv[4], shv[4];
#pragma unroll
      for (int i = 0; i < 4; ++i) { const int k = (i * 64 + F.lane) * 4; gsv[i] = *(const f32x4*)(gain + k); shv[i] = *(const f32x4*)(m + 3072 + k); }
      f32x4 scv[4];
#pragma unroll
      for (int i = 0; i < 4; ++i) scv[i] = *(const f32x4*)(m + 4096 + (i * 64 + F.lane) * 4);
      f32x4 vv[2][4]; float ssq[2] = {0.f, 0.f};
#pragma unroll
      for (int r = 0; r < 2; ++r) { bf16_t* xd = xres_row(F, tt[r]);
#pragma unroll
          for (int i = 0; i < 4; ++i) { const int k = (i * 64 + F.lane) * 4;
              const f32x4 xv = l == 0 ? rxf[r][i] : bf4_to_f32(rxb[r][i]);
              vv[r][i] = xv + g1v[i] * bf4_to_f32(rtr[r][i]);
              { u32x2 xo; xo[0] = cvtpk_rne(vv[r][i][0], vv[r][i][1]); xo[1] = cvtpk_rne(vv[r][i][2], vv[r][i][3]); *(u32x2*)(xd + k) = xo; }
              ssq[r] += vv[r][i][0] * vv[r][i][0] + vv[r][i][1] * vv[r][i][1] + vv[r][i][2] * vv[r][i][2] + vv[r][i][3] * vv[r][i][3]; } }
#pragma unroll
      for (int i = 0; i < 4; ++i) gsv[i] = gsv[i] * (scv[i] + 1.f);
      ssq[0] = wave_sum(ssq[0]); ssq[1] = wave_sum(ssq[1]);
#pragma unroll
      for (int r = 0; r < 2; ++r) {
        const int t = tt[r];
        const float rstd = rsqrtf(ssq[r] * (1.f / D) + 1e-6f);
        float lg[20];
        f32x2 lgp[20];
#pragma unroll
        for (int j = 0; j < 20; ++j) lgp[j] = (f32x2){0.f, 0.f};
#pragma unroll
        for (int i = 0; i < 4; ++i) { const int k = (i * 64 + F.lane) * 4;
            const f32x4 h = vv[r][i] * rstd * gsv[i] + shv[i];
            u32x2 o; o[0] = cvtpk_rne(h[0], h[1]); o[1] = cvtpk_rne(h[2], h[3]);
            *(u32x2*)(act + (size_t)t * D + k) = o;
            const f32x2 h01 = {h[0], h[1]}, h23 = {h[2], h[3]};
#pragma unroll
            for (int j = 0; j < 20; ++j) { const f32x4 w = *(const f32x4*)(rw + j * 1024 + k);
                lgp[j] = __builtin_elementwise_fma(h01, (f32x2){w[0], w[1]}, lgp[j]); lgp[j] = __builtin_elementwise_fma(h23, (f32x2){w[2], w[3]}, lgp[j]); }
            __builtin_amdgcn_sched_barrier(0); }
#pragma unroll
        for (int j = 0; j < 20; ++j) lg[j] = lgp[j][0] + lgp[j][1];
        float ra[10], rb[5];
#pragma unroll
        for (int j = 0; j < 10; ++j) ra[j] = swap32_sum(lg[j], lg[j + 10]);
#pragma unroll
        for (int j = 0; j < 5; ++j) rb[j] = dpp_row_sum(swap16_sum(ra[j], ra[j + 5]));
        if ((F.lane & 15) == 0) {
#pragma unroll
            for (int j = 0; j < 5; ++j) lgs[nrow * 20 + 5 * (F.lane >> 4) + j] = rb[j]; }
        ++nrow;
      }
    }
    if (F.lane < nrow) {
        const int t = 2 * (F.wg * 8 + F.wid) + (F.lane >> 1) * 2 * stride + (F.lane & 1);
        float lg[20];
#pragma unroll
        for (int q = 0; q < 5; ++q) { const f32x4 v = *(const f32x4*)(lgs + F.lane * 20 + 4 * q); lg[4 * q] = v[0]; lg[4 * q + 1] = v[1]; lg[4 * q + 2] = v[2]; lg[4 * q + 3] = v[3]; }
        {
            float bge[20];
#pragma unroll
            for (int j = 0; j < 4; ++j) bge[j] = gin(Pp, 19)[l * 4 + j];
#pragma unroll
            for (int j = 0; j < 16; ++j) bge[4 + j] = gin(Pp, 21)[l * 16 + j];
#pragma unroll
            for (int j = 0; j < 20; ++j) asm volatile("" : "+v"(bge[j]));
            float gl[4];
#pragma unroll
            for (int j = 0; j < 4; ++j) gl[j] = lg[j] + bge[j];
            int gs = 0; float gmax = gl[0];
#pragma unroll
            for (int j = 1; j < 4; ++j) if (gl[j] > gmax) { gmax = gl[j]; gs = j; }
            float den = 0.f;
#pragma unroll
            for (int j = 0; j < 4; ++j) den += expf(gl[j] - gmax);
            const float pg = 1.f / den;
            float ev[4];
#pragma unroll
            for (int j = 0; j < 4; ++j) { float x = 0.f;
#pragma unroll
                for (int g2 = 0; g2 < 4; ++g2) x = (g2 == gs) ? lg[4 + g2 * 4 + j] + bge[4 + g2 * 4 + j] : x;
                ev[j] = x; }
            int i1 = 0; float v1 = ev[0];
#pragma unroll
            for (int j = 1; j < 4; ++j) if (ev[j] > v1) { v1 = ev[j]; i1 = j; }
            int i2 = -1; float v2 = 0.f;
#pragma unroll
            for (int j = 0; j < 4; ++j) if (j != i1 && (i2 < 0 || ev[j] > v2)) { v2 = ev[j]; i2 = j; }
            const float w1 = 1.f / (1.f + expf(v2 - v1)), w2 = 1.f - w1;
            const int lo = i1 < i2 ? i1 : i2, hi = i1 < i2 ? i2 : i1;
            const float wlo = (i1 < i2 ? w1 : w2) * pg, whi = (i1 < i2 ? w2 : w1) * pg;
            const int pr = lo == 0 ? hi - 1 : (lo == 1 ? hi + 1 : 5);
            const int bucket = gs * 6 + pr;
            const unsigned rank = atomicAdd(&cnt[bucket], 1u);
            tokinfo[t] = make_int4(bucket, (int)rank, __float_as_int(wlo), __float_as_int(whi));
            { const size_t sp = (size_t)bucket * SPCAP + rank; sp_tok[sp] = t; *(float2*)(sp_w + 2 * sp) = make_float2(wlo, whi); }
        }
    }
}

DI void phase_scatter(const Frame& F, int l) {
    const int M = l == 0 ? NT : NLAT;
    int* tile_bucket = (int*)F.lds; int* boff = tile_bucket + MAXTILES;
    build_tiles(F, l, tile_bucket, boff);
    const int4* tokinfo = F.wsp<int4>(WS_TOKINFO);
    int* slot_tok = F.wsp<int>(WS_SLOTTOK); int* tok_slot = F.wsp<int>(WS_TOKSLOT); float* slot_w = F.wsp<float>(WS_SLOTW);
    for (int t = F.wg * NWG_THREADS + F.tid; t < M; t += F.nwg * NWG_THREADS) {
        const int4 ti = tokinfo[t];
        const int slot = boff[ti.x] * 256 + ti.y;
        slot_tok[slot] = t; tok_slot[t] = slot; slot_w[slot * 2] = __int_as_float(ti.z); slot_w[slot * 2 + 1] = __int_as_float(ti.w);
    }
}

constexpr int TAB_OFF = pg8::STAGE_BYTES;
struct InSched {
    static constexpr bool GATHER = false; static constexpr int NSEG = 1;
    const char* act; const char* W; int G, c;
    DI bool next(int i, pg8::Unit& u) const { const int L = i * G + c; if (L >= 1320) return false;
        const int grp = L / 80, rem = L % 80, fm = grp * 8, gsz = (132 - fm) < 8 ? (132 - fm) : 8, panel = fm + rem % gsz, slot = rem / gsz;
        if (slot < 7) { u.pm = panel; u.pn = slot; u.aux = 0; } else { u.pm = slot - 7; u.pn = panel; u.aux = 1; }
        return true; }
    DI const char* a_base(const pg8::Unit& u) const { return u.aux == 0 ? act + (size_t)u.pm * 256 * D * 2 : W + (size_t)(QKW + u.pm * 256) * D * 2; }
    DI const char* b_base(const pg8::Unit& u, int) const { return u.aux == 0 ? W + (size_t)u.pn * 256 * D * 2 : act + (size_t)u.pn * 256 * D * 2; }
    DI void a_rows(const pg8::Unit&, int&, int&) const {}
    DI const int* rows_ptr(const pg8::Unit&) const { return nullptr; }
    DI int rows_lim(const pg8::Unit&) const { return 0; }
};
struct InEpi {
    static constexpr bool PERM = true;
    bf16_t* qpost; bf16_t* kpost; bf16_t* VT; LAS const float* ropeB; LAS const float* ropeC; LAS const float* qn; LAS const float* kn; LAS unsigned* lmax;
    static constexpr bool WTAB = false;
    DI const float* w_ptr(const pg8::Unit&) const { return nullptr; }
    DI void pre_lds(const pg8::Unit&, int, int, const LAS float*, float (&)[8]) const {}
    DI void operator()(const f32x4 (&acc)[2][2][4][2], const pg8::Unit& u, int wr, int wc, int fr, int fq, const float (&epre)[8]) const {
        if (u.aux != 0) { pg8::EpiBf16 e{VT, KEYS, 1}; e(acc, u, wr, wc, fr, fq, epre); return; }
        const int hs = 4 * u.pn + wc;
        const bool isq = hs < 6 || (hs >= 12 && hs < 16) || (hs >= 20 && hs < 26), isb = hs >= 12 && hs < 20, isc = hs >= 20;
        const int hh = hs < 6 ? hs : (hs < 12 ? hs - 6 : (hs < 16 ? hs - 12 : (hs < 20 ? hs - 16 : (hs < 26 ? hs - 20 : hs - 26))));
        const int hidx = (isb ? 6 : (isc ? 10 : 0)) + hh;
        const int t0 = u.pm * 256; const bool lat = t0 < NLAT; const int b = lat ? (t0 >> 13) : ((t0 - NLAT) >> 8);
        const int elo = isb ? 32 * (fq >> 1) + 8 * (fq & 1) : 8 * fq, ehi = isb ? elo + 16 : elo + 32;
        f32x4 glo[2], ghi[2];
        if (isc) { LAS const float* g = isq ? qn : kn; glo[0] = *(LAS const f32x4*)(g + elo); glo[1] = *(LAS const f32x4*)(g + elo + 4); ghi[0] = *(LAS const f32x4*)(g + ehi); ghi[1] = *(LAS const f32x4*)(g + ehi + 4); }
        const float qscale = (isb ? 0.17677669529663689f : 0.125f) * LOG2E;
        float kmx = 0.f;
#pragma unroll
        for (int ai = 0; ai < 2; ++ai)
#pragma unroll
            for (int m = 0; m < 4; ++m) {
                const int t = t0 + 128 * ai + 64 * wr + 16 * m + fr, sp = t & (SEQ - 1), grow = sp >> 6, gcol = sp & 63;
                f32x4 lo[2] = {acc[ai][0][m][0], acc[ai][0][m][1]}, hi[2] = {acc[ai][1][m][0], acc[ai][1][m][1]};
                if (isc) { float ss = 0.f;
#pragma unroll
                    for (int q = 0; q < 2; ++q) ss += lo[q][0] * lo[q][0] + lo[q][1] * lo[q][1] + lo[q][2] * lo[q][2] + lo[q][3] * lo[q][3] + hi[q][0] * hi[q][0] + hi[q][1] * hi[q][1] + hi[q][2] * hi[q][2] + hi[q][3] * hi[q][3];
                    ss = swap16_sum(ss, ss); ss = swap32_sum(ss, ss);
                    const float rstd = rsqrtf(ss * (1.f / 64) + 1e-6f);
#pragma unroll
                    for (int q = 0; q < 2; ++q) { lo[q] = lo[q] * rstd * glo[q]; hi[q] = hi[q] * rstd * ghi[q]; } }
                if ((isb || isc) && lat) {
                    LAS const float* tab = isb ? ropeB + (((fq & 1) == 0 ? grow : gcol) * 8) * 2 : ropeC + ((fq < 2 ? grow : gcol) * 16 + 8 * (fq & 1)) * 2;
#pragma unroll
                    for (int q = 0; q < 2; ++q) { const f32x4 c0 = *(LAS const f32x4*)(tab + 8 * q), c1 = *(LAS const f32x4*)(tab + 8 * q + 4);
                        const f32x4 x1 = lo[q], x2 = hi[q];
                        lo[q] = (f32x4){x1[0] * c0[0] - x2[0] * c0[1], x1[1] * c0[2] - x2[1] * c0[3], x1[2] * c1[0] - x2[2] * c1[1], x1[3] * c1[2] - x2[3] * c1[3]};
                        hi[q] = (f32x4){x2[0] * c0[0] + x1[0] * c0[1], x2[1] * c0[2] + x1[1] * c0[3], x2[2] * c1[0] + x1[2] * c1[1], x2[3] * c1[2] + x1[3] * c1[3]}; } }
                if (isq) {
#pragma unroll
                    for (int q = 0; q < 2; ++q) { lo[q] = lo[q] * qscale; hi[q] = hi[q] * qscale; } }
                u32x4 wl, wh;
                wl[0] = cvtpk(lo[0][0], lo[0][1]); wl[1] = cvtpk(lo[0][2], lo[0][3]); wl[2] = cvtpk(lo[1][0], lo[1][1]); wl[3] = cvtpk(lo[1][2], lo[1][3]);
                wh[0] = cvtpk(hi[0][0], hi[0][1]); wh[1] = cvtpk(hi[0][2], hi[0][3]); wh[2] = cvtpk(hi[1][0], hi[1][1]); wh[3] = cvtpk(hi[1][2], hi[1][3]);
                bf16_t* dst;
                if (isq) dst = qpost + (size_t)t * 1024 + hidx * 64;
                else { const int key = lat ? CTXL + sp : ((t - NLAT) & (CTXL - 1)); dst = kpost + ((size_t)(b * NKH + hidx) * KEYS + key) * 64; }
                *(u32x4*)(dst + elo) = wl; *(u32x4*)(dst + ehi) = wh;
                { float n2 = 0.f;
#pragma unroll
                    for (int q = 0; q < 4; ++q) { const float a0 = __uint_as_float(wl[q] << 16), a1 = __uint_as_float(wl[q] & 0xffff0000u), b0 = __uint_as_float(wh[q] << 16), b1 = __uint_as_float(wh[q] & 0xffff0000u); n2 += a0 * a0 + a1 * a1 + b0 * b0 + b1 * b1; }
                    n2 = swap16_sum(n2, n2);
                    if (!isb) n2 = swap32_sum(n2, n2);
                    kmx = fmaxf(kmx, n2); }
            }
        {
#pragma unroll
            for (int of = 32; of; of >>= 1) kmx = fmaxf(kmx, __shfl_xor(kmx, of));
            if (fr == 0 && fq == 0) __hip_atomic_fetch_max(isq ? lmax + 48 + b * 16 + hidx : lmax + b * NKH + hidx, __float_as_uint(kmx), __ATOMIC_RELAXED, __HIP_MEMORY_SCOPE_WORKGROUP); }
    }
};
DI void phase_gemm_in_mfma(const Frame& F, int l) {
    const char* act = (const char*)F.wsp<bf16_t>(WS_ACT);
    const char* W = (const char*)(F.wsp<bf16_t>(WS_WINT) + (size_t)l * INW * D);
    InSched S{act, W, F.nwg, F.wg};
    LAS float* rl = (LAS float*)((LAS char*)F.lds + TAB_OFF);
    __syncthreads();
    static_assert(WS_ROPEC == WS_ROPEB + 2048 * 4, "rope tables contiguous");
    for (int i = F.tid; i < (2048 + 4096) / 4; i += NWG_THREADS) *(LAS f32x4*)(rl + 4 * i) = *(const f32x4*)(F.wsp<float>(WS_ROPEB) + 4 * i);
    if (F.tid < 128) rl[6144 + 112 + F.tid] = F.tid < 64 ? gin(F.p, 16)[l * 64 + F.tid] : gin(F.p, 17)[l * 64 + F.tid - 64];
    LAS unsigned* lmax = (LAS unsigned*)(rl + 6144);
    if (F.tid < 112) lmax[F.tid] = 0u;
    __syncthreads();
    InEpi E{F.wsp<bf16_t>(WS_BIG + BIG_PROJ), F.wsp<bf16_t>(WS_BIG + BIG_KPOST), F.wsp<bf16_t>(WS_BIG + BIG_VT), rl, rl + 2048, rl + 6144 + 112, rl + 6144 + 112 + 64, lmax};
    pg8::gemm_phase((LAS unsigned char*)F.lds, D, D, D, S, E);
    __syncthreads();
    if (F.tid < 112) { const unsigned v = lmax[F.tid];
        if (v != 0u) atomicMax(F.tid < 48 ? F.wsp<unsigned>(WS_SYNC) + KMAX_OFF_WORDS + l * 48 + F.tid : F.wsp<unsigned>(WS_SYNC) + QMAX_OFF_WORDS + l * 64 + (F.tid - 48), v); }
}
DI void phase_gemm_out_mfma(const Frame& F, int l) {
    const int M = l == 0 ? NT : NLAT;
    pg8::DenseSched S{(const char*)F.wsp<bf16_t>(WS_ACT), (const char*)(F.wsp<bf16_t>(WS_WOUTT) + (size_t)l * D * D), D, D, M / 256, 4, F.nwg, F.wg};
    pg8::EpiBf16 E{F.wsp<bf16_t>(WS_BIG), D, 0};
    pg8::gemm_phase((LAS unsigned char*)F.lds, D, D, D, S, E);
}
struct EpiMoe1 {
    static constexpr bool PERM = true;
    bf16_t* hid; const float* sp_w; const int* boff;
    static constexpr bool WTAB = true;
    DI const float* w_ptr(const pg8::Unit& u) const { const int b = u.aux; return sp_w + ((size_t)b * SPCAP + (size_t)(u.pm - boff[b]) * 256) * 2; }
    DI void pre_lds(const pg8::Unit& u, int wr, int fr, const LAS float* tab, float (&epre)[8]) const {
        const int b = u.aux, lim = boff[NBUCKET + 1 + NBUCKET + b] - 1 - (u.pm - boff[b]) * 256, j = u.pn >> 2, r = wr * 64 + fr;
#pragma unroll
        for (int ai = 0; ai < 2; ++ai)
#pragma unroll
            for (int m = 0; m < 4; ++m) { const int i_ = r + ai * 128 + m * 16; const float w_ = tab[(i_ < lim ? i_ : lim) * 2 + j]; epre[ai * 4 + m] = i_ <= lim ? w_ : 0.f; } }
    DI void operator()(const f32x4 (&acc)[2][2][4][2], const pg8::Unit& u, int wr, int wc, int fr, int fq, const float (&epre)[8]) const {
        const int row0 = u.pm * 256 + wr * 64 + fr, j = u.pn >> 2, colb = j * 512 + (u.pn & 3) * 128 + 16 * wc + 4 * fq;
#pragma unroll
        for (int ai = 0; ai < 2; ++ai)
#pragma unroll
            for (int m = 0; m < 4; ++m) { const int slot = row0 + ai * 128 + m * 16; const float w = epre[ai * 4 + m];
#pragma unroll
                for (int bj = 0; bj < 2; ++bj) { const f32x4 v0 = acc[ai][bj][m][0], v1 = acc[ai][bj][m][1];
                    const float h0 = v0[0] * __builtin_amdgcn_rcpf(1.f + __builtin_amdgcn_exp2f(-v0[0] * LOG2E)) * v0[1] * w, h1 = v0[2] * __builtin_amdgcn_rcpf(1.f + __builtin_amdgcn_exp2f(-v0[2] * LOG2E)) * v0[3] * w;
                    const float h2 = v1[0] * __builtin_amdgcn_rcpf(1.f + __builtin_amdgcn_exp2f(-v1[0] * LOG2E)) * v1[1] * w, h3 = v1[2] * __builtin_amdgcn_rcpf(1.f + __builtin_amdgcn_exp2f(-v1[2] * LOG2E)) * v1[3] * w;
                    u32x2 o; o[0] = pg8::cvt_pk_bf16(h0, h1); o[1] = pg8::cvt_pk_bf16(h2, h3);
                    *(u32x2*)(hid + (size_t)slot * D + colb + 64 * bj) = o; } }
    }
};
struct Moe1Sched {
    static constexpr bool GATHER = true; static constexpr int NSEG = 1;
    const char* act; const char* W; const int* sp_tok; const int* tile_bucket; const int* boff; int ntiles, G, c;
    DI bool next(int i, pg8::Unit& u) const { const int U = ntiles * 8, x = c & 7, nper = (G - 1 - x) / 8 + 1, lo = (x * U) >> 3, hi = ((x + 1) * U) >> 3, j = lo + i * nper + (c >> 3);
        if (j >= hi) return false; u.pm = j >> 3; u.pn = j & 7; u.aux = tile_bucket[u.pm]; return true; }
    DI const char* a_base(const pg8::Unit&) const { return act; }
    DI const char* b_base(const pg8::Unit& u, int) const { int elo, ehi; bucket_experts(u.aux, elo, ehi); const int e = u.pn < 4 ? elo : ehi; return W + ((size_t)e * 1024 + (u.pn & 3) * 256) * D * 2; }
    DI const int* rows_ptr(const pg8::Unit& u) const { const int b = u.aux; return sp_tok + (size_t)b * SPCAP + (size_t)(u.pm - boff[b]) * 256; }
    DI int rows_lim(const pg8::Unit& u) const { const int b = u.aux; return boff[NBUCKET + 1 + NBUCKET + b] - 1 - (u.pm - boff[b]) * 256; }
    DI void a_rows(const pg8::Unit& u, int& r0, int& r1) const { const int b = u.aux, base = (u.pm - boff[b]) * 256, cm = boff[NBUCKET + 1 + NBUCKET + b] - 1; const int* st = sp_tok + (size_t)b * SPCAP;
        const int i0 = base + r0, i1 = base + r1; r0 = st[i0 < cm ? i0 : cm]; r1 = st[i1 < cm ? i1 : cm]; }
};
struct Moe2Sched {
    static constexpr bool GATHER = false; static constexpr int NSEG = 2;
    const char* hid; const char* W; const int* tile_bucket; int ntiles, G, c;
    DI bool next(int i, pg8::Unit& u) const { const int U = ntiles * 4, x = c & 7, nper = (G - 1 - x) / 8 + 1, lo = (x * U) >> 3, hi = ((x + 1) * U) >> 3, j = lo + i * nper + (c >> 3);
        if (j >= hi) return false; u.pm = j >> 2; u.pn = j & 3; u.aux = tile_bucket[u.pm]; return true; }
    DI const char* a_base(const pg8::Unit& u) const { return hid + (size_t)u.pm * 256 * D * 2; }
    DI const char* b_base(const pg8::Unit& u, int seg) const { int elo, ehi; bucket_experts(u.aux, elo, ehi); return W + ((size_t)(seg == 0 ? elo : ehi) * 1024 + u.pn * 256) * 512 * 2; }
    DI void a_rows(const pg8::Unit&, int&, int&) const {}
    DI const int* rows_ptr(const pg8::Unit&) const { return nullptr; }
    DI int rows_lim(const pg8::Unit&) const { return 0; }
};
DI void phase_gemm1_mfma(const Frame& F, int l) {
    int* tile_bucket = (int*)((char*)F.lds + TAB_OFF); int* boff = tile_bucket + MAXTILES;
    const int ntiles = build_tiles(F, l, tile_bucket, boff);
    Moe1Sched S{(const char*)F.wsp<bf16_t>(WS_ACT), (const char*)(F.wsp<bf16_t>(WS_WGU) + (size_t)l * 16 * 1024 * 1024), F.wsp<int>(WS_SPTOK), tile_bucket, boff, ntiles, F.nwg, F.wg};
    EpiMoe1 E{F.wsp<bf16_t>(WS_BIG), F.wsp<float>(WS_SPW), boff};
    pg8::gemm_phase((LAS unsigned char*)F.lds, D, D, D, S, E);
}
DI void phase_gemm2_mfma(const Frame& F, int l) {
    int* tile_bucket = (int*)((char*)F.lds + TAB_OFF); int* boff = tile_bucket + MAXTILES;
    const int ntiles = build_tiles(F, l, tile_bucket, boff);
    Moe2Sched S{(const char*)F.wsp<bf16_t>(WS_BIG), (const char*)(F.wsp<bf16_t>(WS_WDT) + (size_t)l * 16 * 1024 * 512), tile_bucket, ntiles, F.nwg, F.wg};
    pg8::EpiBf16 E{F.wsp<bf16_t>(WS_BIG + BIG_Y16), D, 0};
    pg8::gemm_phase((LAS unsigned char*)F.lds, D, D, 512, S, E);
}

DI void phase_final(const Frame& F) {
    const KParams Pp = F.p;
    const bf16_t* y16 = F.wsp<bf16_t>(WS_BIG + BIG_Y16); const int4* tokinfo = F.wsp<int4>(WS_TOKINFO);
    int* tile_bucket = (int*)F.lds; int* boff = tile_bucket + MAXTILES;
    build_tiles(F, 1, tile_bucket, boff);
    const int stride = F.nwg * 8;
    u32x2 rxb[2][4], ryb[2][4]; int nsl[2] = {0, 0};
#pragma unroll
    for (int r = 0; r < 2; ++r)
#pragma unroll
        for (int i = 0; i < 4; ++i) { rxb[r][i] = (u32x2){0u, 0u}; ryb[r][i] = (u32x2){0u, 0u}; }
#define FN_SLOTS(T0) if ((T0) < NLAT) { const int2 i0_ = *(const int2*)(tokinfo + (T0)), i1_ = *(const int2*)(tokinfo + (T0) + 1); nsl[0] = boff[i0_.x] * 256 + i0_.y; nsl[1] = boff[i1_.x] * 256 + i1_.y; }
#define FN_ISSUE(T0) if ((T0) < NLAT) { \
        _Pragma("unroll") for (int r = 0; r < 2; ++r) { const bf16_t* s_ = xres_row(F, (T0) + r); const bf16_t* yr_ = y16 + (size_t)nsl[r] * D; \
            _Pragma("unroll") for (int i = 0; i < 4; ++i) { const int k = (i * 64 + F.lane) * 4; rxb[r][i] = *(const u32x2*)(s_ + k); ryb[r][i] = *(const u32x2*)(yr_ + k); } } }
    const int tfirst = 2 * (F.wg * 8 + F.wid);
    FN_SLOTS(tfirst)
    FN_ISSUE(tfirst)
    FN_SLOTS(tfirst + 2 * stride)
    f32x4 gf[4];
#pragma unroll
    for (int i = 0; i < 4; ++i) gf[i] = *(const f32x4*)(gin(Pp, 25) + (i * 64 + F.lane) * 4);
    for (int t0 = tfirst; t0 < NLAT; t0 += 2 * stride) {
        const int tt[2] = {t0, t0 + 1};
        const float* g2 = mod_row(F, 1, t0 >> 13) + 5120;
        f32x4 g2v[4];
#pragma unroll
        for (int i = 0; i < 4; ++i) g2v[i] = *(const f32x4*)(g2 + (i * 64 + F.lane) * 4);
        f32x4 v[2][4]; float ss[2] = {0.f, 0.f};
#pragma unroll
        for (int r = 0; r < 2; ++r)
#pragma unroll
            for (int i = 0; i < 4; ++i) { v[r][i] = bf4_to_f32(rxb[r][i]) + g2v[i] * bf4_to_f32(ryb[r][i]);
                ss[r] += v[r][i][0] * v[r][i][0] + v[r][i][1] * v[r][i][1] + v[r][i][2] * v[r][i][2] + v[r][i][3] * v[r][i][3]; }
        __builtin_amdgcn_sched_barrier(0);
        FN_ISSUE(t0 + 2 * stride)
        FN_SLOTS(t0 + 4 * stride)
        __builtin_amdgcn_sched_barrier(0);
        ss[0] = wave_sum(ss[0]); ss[1] = wave_sum(ss[1]);
#pragma unroll
        for (int r = 0; r < 2; ++r) { float* s = gout(Pp) + (size_t)tt[r] * D;
            const float rstd = rsqrtf(ss[r] * (1.f / D) + 1e-6f);
#pragma unroll
            for (int i = 0; i < 4; ++i) { const int k = (i * 64 + F.lane) * 4; *(f32x4*)(s + k) = v[r][i] * rstd * gf[i]; } }
    }
#undef FN_ISSUE
#undef FN_SLOTS
}

template <int PH> DI void run_phase(unsigned char* lds_raw, int l) {
    KParams kp = (KParams)__builtin_amdgcn_kernarg_segment_ptr();
    asm volatile("" : "+s"(kp));
    GAS unsigned char* ws = (GAS unsigned char*)kp->ws;
    asm volatile("" : "+s"(ws));
    int tid = threadIdx.x; asm volatile("" : "+v"(tid));
    Frame F; F.p = kp; F.ws = ws; F.lds = (float*)(lds_raw + 16); F.tid = tid; F.wid = __builtin_amdgcn_readfirstlane(tid >> 6); F.lane = tid & 63; F.wg = blockIdx.x; F.nwg = gridDim.x;
    if (PH == 0) phase_prologue(F);
    if (PH == 1) phase_norm1(F, l);
    if (PH == 2) phase_gemm_in_mfma(F, l);
    if (PH == 4) phase_attn_mfma(F, l);
    if (PH == 5) phase_gemm_out_mfma(F, l);
    if (PH == 6) phase_norm2(F, l);
    if (PH == 7) phase_scatter(F, l);
    if (PH == 8) phase_gemm1_mfma(F, l);
    if (PH == 9) phase_gemm2_mfma(F, l);
    if (PH == 10) phase_final(F);
}
DI void grid_sync(unsigned char* lds_raw) {
    KParams kp = (KParams)__builtin_amdgcn_kernarg_segment_ptr();
    asm volatile("" : "+s"(kp));
    XcdBarrier b; b.bar = (unsigned*)kp->ws; b.x = xb_xcc_id(); b.st = (volatile LAS unsigned*)lds_raw;
    xcd_barrier(b);
}
__global__ void __launch_bounds__(NWG_THREADS, 2) fwd_kernel(Params p) {
    extern __shared__ __attribute__((aligned(16))) unsigned char lds_raw[];
    if (threadIdx.x == 0) *(uint4*)lds_raw = make_uint4(0u, 0u, 0u, 0u);
    __syncthreads();
    (void)xcd_barrier_post((unsigned*)p.ws, (volatile LAS unsigned*)lds_raw);
#define RUN(PH, l) run_phase<PH>(lds_raw, l); grid_sync(lds_raw); if (DUP_PH == PH && DUP_L == l) { run_phase<PH>(lds_raw, l); grid_sync(lds_raw); }
    RUN(0, 0)
    RUN(1, 0) RUN(2, 0) RUN(4, 0) RUN(5, 0) RUN(6, 0) RUN(8, 0) RUN(9, 0)
    RUN(1, 1) RUN(2, 1) RUN(4, 1) RUN(5, 1) RUN(6, 1) RUN(8, 1) RUN(9, 1)
    run_phase<10>(lds_raw, 0);
#undef RUN
}

extern "C" void kernel_launch(void* const* d_in, const int* in_sizes, int n_in, void* d_out, int out_size, void* d_ws, size_t ws_size, hipStream_t stream) {
    static int grid = 0;
    if (grid == 0) {
        if (n_in != 26 || out_size != NLAT * D || ws_size < WS_END2) { fprintf(stderr, "kernel_launch: unexpected shapes n_in %d out %d ws %zu (need %zu)\n", n_in, out_size, ws_size, (size_t)WS_END2); grid = -1; return; }
        int dev = 0, cus = 0, per_cu = 0;
        if (hipGetDevice(&dev) != hipSuccess || hipDeviceGetAttribute(&cus, hipDeviceAttributeMultiprocessorCount, dev) != hipSuccess) { grid = -1; return; }
        if (hipFuncSetAttribute((const void*)fwd_kernel, hipFuncAttributeMaxDynamicSharedMemorySize, LDS_BYTES) != hipSuccess) { fprintf(stderr, "kernel_launch: hipFuncSetAttribute failed\n"); grid = -1; return; }
        if (hipOccupancyMaxActiveBlocksPerMultiprocessor(&per_cu, (const void*)fwd_kernel, NWG_THREADS, LDS_BYTES) != hipSuccess || per_cu < 1) fprintf(stderr, "kernel_launch: occupancy query reports %d\n", per_cu);
        (void)hipGetLastError();
        if (cus < 64) { fprintf(stderr, "kernel_launch: %d CUs, need at least 64\n", cus); grid = -1; return; }
        grid = cus;
    }
    if (grid < 0) return;
    (void)hipMemsetAsync((char*)d_ws + WS_SYNC, 0, SYNC_BYTES, stream);
    Params p{};
    for (int i = 0; i < 26; ++i) p.in[i] = (const float*)d_in[i];
    p.out = (float*)d_out; p.ws = (unsigned char*)d_ws; p.ph_lo = 0; p.ph_hi = 0;
    hipLaunchKernelGGL(fwd_kernel, dim3(grid), dim3(NWG_THREADS), LDS_BYTES, stream, p);
}
```
